# Optimizing an MI355X kernel written in HIP

```python
import math
import jax, jax.numpy as jnp
from jax import lax
import numpy as np

D_MODEL = 1024
BATCH = 16
SEQ = 256
DEPTH = 4
DEC_BATCH = 2
DEC_SEQ = 2048
PAST_LEN = 256

GRID_W = 64
N_MIXERS = 2
N_DIFF_LAYERS = (DEPTH + 1) // 2
N_GQA_LAYERS = DEPTH // 2
DIFF_HEADS = 8
DIFF_HEAD_DIM = 64
DIFF_WIDTH = DIFF_HEADS * 2 * DIFF_HEAD_DIM
GQA_HEADS = 16
GQA_KV_HEADS = 4
GQA_GROUP = GQA_HEADS // GQA_KV_HEADS
GQA_HEAD_DIM = 64
GQA_Q_WIDTH = GQA_HEADS * GQA_HEAD_DIM
GQA_KV_WIDTH = GQA_KV_HEADS * GQA_HEAD_DIM
ROPE_DIM = 64
ROPE_THETA = 10000.0
D_FF = 2816
CONV_WIDTH = 3
Q_BLOCK = 128
NORM_EPS = 1e-6
N_MOD = 6

kernel_name = "hybrid_diffattn_gqa_convffn_dit_step"


def rms_norm(x, w):
    xf = x.astype(jnp.float32)
    y = xf * lax.rsqrt(jnp.mean(xf * xf, axis=-1, keepdims=True) + NORM_EPS)
    return (y * w.astype(jnp.float32)).astype(x.dtype)


def axial_rope_tables(n_tokens, dtype):
    n_rows = n_tokens // GRID_W
    row, col = jnp.meshgrid(jnp.arange(n_rows, dtype=jnp.float32),
                            jnp.arange(GRID_W, dtype=jnp.float32), indexing="ij")
    row, col = row.reshape(-1), col.reshape(-1)
    axis_dim = ROPE_DIM // 2
    inv_freq = ROPE_THETA ** (-jnp.arange(0, axis_dim, 2, dtype=jnp.float32) / axis_dim)
    ang_r = row[:, None] * inv_freq
    ang_c = col[:, None] * inv_freq
    ang = jnp.concatenate([ang_r, ang_r, ang_c, ang_c], axis=-1)
    return jnp.cos(ang).astype(dtype), jnp.sin(ang).astype(dtype)


def rotate_half_axial(x):
    a = ROPE_DIM // 2
    h = a // 2
    xr, xc = x[..., :a], x[..., a:]
    rh = lambda u: jnp.concatenate([-u[..., h:], u[..., :h]], axis=-1)
    return jnp.concatenate([rh(xr), rh(xc)], axis=-1)


def apply_rope(x, cos, sin):
    return x * cos + rotate_half_axial(x) * sin


def sweep_query_blocks(block_fn, q):
    *lead, s, d = q.shape
    nb = s // Q_BLOCK
    qb = jnp.moveaxis(q.reshape(*lead, nb, Q_BLOCK, d), -3, 0)
    out = lax.map(block_fn, qb)
    out = jnp.moveaxis(out, 0, -3)
    return out.reshape(*out.shape[:-3], s, out.shape[-1])


def diff_qkv(h, w_qkv, rope):
    b, s, _ = h.shape
    q, k, v = jnp.split(h @ w_qkv, 3, axis=-1)
    heads = lambda t: t.reshape(b, s, DIFF_HEADS, 2 * DIFF_HEAD_DIM).transpose(0, 2, 1, 3)
    q, k, v = heads(q), heads(k), heads(v)
    if rope is not None:
        cos, sin = rope
        def rot(t):
            t5 = t.reshape(b, DIFF_HEADS, s, 2, DIFF_HEAD_DIM)
            return apply_rope(t5, cos[:, None], sin[:, None]).reshape(t.shape)
        q, k = rot(q), rot(k)
    return q, k, v


def diff_attend(q, k, v, lam_params, lam_init, subln_w):
    lp = lam_params.astype(jnp.float32)
    lam = jnp.exp(jnp.sum(lp[0] * lp[1])) - jnp.exp(jnp.sum(lp[2] * lp[3])) + lam_init
    k1, k2 = k[..., :DIFF_HEAD_DIM], k[..., DIFF_HEAD_DIM:]
    scale = DIFF_HEAD_DIM ** -0.5

    def block(qb):
        q1, q2 = qb[..., :DIFF_HEAD_DIM], qb[..., DIFF_HEAD_DIM:]
        p1 = jax.nn.softmax(jnp.einsum("bhqd,bhkd->bhqk", q1, k1).astype(jnp.float32) * scale, axis=-1)
        p2 = jax.nn.softmax(jnp.einsum("bhqd,bhkd->bhqk", q2, k2).astype(jnp.float32) * scale, axis=-1)
        a = (p1 - lam * p2).astype(v.dtype)
        return jnp.einsum("bhqk,bhkd->bhqd", a, v)

    o = sweep_query_blocks(block, q)
    o = rms_norm(o, subln_w) * (1.0 - lam_init)
    b, nh, s, dv = o.shape
    return o.transpose(0, 2, 1, 3).reshape(b, s, nh * dv)


def gqa_qkv(h, w_qkv, q_norm_w, k_norm_w, rope):
    b, s, _ = h.shape
    qkv = h @ w_qkv
    q = qkv[..., :GQA_Q_WIDTH].reshape(b, s, GQA_KV_HEADS, GQA_GROUP, GQA_HEAD_DIM).transpose(0, 2, 3, 1, 4)
    k = qkv[..., GQA_Q_WIDTH:GQA_Q_WIDTH + GQA_KV_WIDTH].reshape(b, s, GQA_KV_HEADS, GQA_HEAD_DIM).transpose(0, 2, 1, 3)
    v = qkv[..., GQA_Q_WIDTH + GQA_KV_WIDTH:].reshape(b, s, GQA_KV_HEADS, GQA_HEAD_DIM).transpose(0, 2, 1, 3)
    q, k = rms_norm(q, q_norm_w), rms_norm(k, k_norm_w)
    if rope is not None:
        cos, sin = rope
        q, k = apply_rope(q, cos, sin), apply_rope(k, cos, sin)
    return q, k, v


def gqa_attend(q, k, v):
    scale = GQA_HEAD_DIM ** -0.5

    def block(qb):
        p = jax.nn.softmax(jnp.einsum("bhgqd,bhkd->bhgqk", qb, k).astype(jnp.float32) * scale, axis=-1)
        return jnp.einsum("bhgqk,bhkd->bhgqd", p.astype(v.dtype), v)

    o = sweep_query_blocks(block, q)
    b, hk, g, s, d = o.shape
    return o.transpose(0, 3, 1, 2, 4).reshape(b, s, hk * g * d)


def conv_ffn(h, w_up, conv_w, conv_b, w_down):
    u = h @ w_up
    s = u.shape[1]
    up = jnp.pad(u, ((0, 0), (1, 1), (0, 0)))
    u = up[:, :s] * conv_w[0] + up[:, 1:s + 1] * conv_w[1] + up[:, 2:s + 2] * conv_w[2] + conv_b
    g, val = jnp.split(u, 2, axis=-1)
    return (jax.nn.silu(g) * val) @ w_down


def adaln_params(cond, mod_w, mod_b):
    m = jax.nn.silu(cond) @ mod_w + mod_b
    return jnp.split(m[:, None, :], N_MOD, axis=-1)


def modulate(x, norm_w, shift, scale):
    return rms_norm(x, norm_w) * (1.0 + scale) + shift


def lambda_init(layer_idx):
    return 0.8 - 0.6 * math.exp(-0.3 * layer_idx)


def setup_inputs(seed: int = 0) -> dict:
    key = jax.random.key(seed)
    ks = jax.random.split(key, 25)
    nrm = lambda k, shape: jax.random.normal(k, shape, jnp.float32)
    dh2 = 2 * DIFF_HEAD_DIM
    return {
        "x_prompt": nrm(ks[0], (BATCH, SEQ, D_MODEL)),
        "x_sample": nrm(ks[1], (DEC_BATCH, DEC_SEQ, D_MODEL)),
        "cache_k_diff": nrm(ks[2], (DEC_BATCH, N_DIFF_LAYERS, DIFF_HEADS, PAST_LEN, dh2)),
        "cache_v_diff": nrm(ks[3], (DEC_BATCH, N_DIFF_LAYERS, DIFF_HEADS, PAST_LEN, dh2)),
        "cache_k_gqa": nrm(ks[4], (DEC_BATCH, N_GQA_LAYERS, GQA_KV_HEADS, PAST_LEN, GQA_HEAD_DIM)),
        "cache_v_gqa": nrm(ks[5], (DEC_BATCH, N_GQA_LAYERS, GQA_KV_HEADS, PAST_LEN, GQA_HEAD_DIM)),
        "c": nrm(ks[6], (DEC_BATCH, D_MODEL)),
        "c_ctx": nrm(ks[7], (D_MODEL,)),
        "mod_w": nrm(ks[8], (DEPTH, D_MODEL, N_MOD * D_MODEL)) * D_MODEL ** -0.5,
        "mod_b": nrm(ks[9], (DEPTH, N_MOD * D_MODEL)) * 0.02,
        "norm_attn": 1.0 + 0.05 * nrm(ks[10], (DEPTH, D_MODEL)),
        "norm_ffn": 1.0 + 0.05 * nrm(ks[11], (DEPTH, D_MODEL)),
        "w_qkv_diff": nrm(ks[12], (N_DIFF_LAYERS, D_MODEL, 3 * DIFF_WIDTH)) * D_MODEL ** -0.5,
        "w_o_diff": nrm(ks[13], (N_DIFF_LAYERS, DIFF_WIDTH, D_MODEL)) * DIFF_WIDTH ** -0.5,
        "lambda_diff": 0.1 * nrm(ks[14], (N_DIFF_LAYERS, 4, DIFF_HEAD_DIM)),
        "subln_diff": 1.0 + 0.05 * nrm(ks[15], (N_DIFF_LAYERS, dh2)),
        "w_qkv_gqa": nrm(ks[16], (N_GQA_LAYERS, D_MODEL, GQA_Q_WIDTH + 2 * GQA_KV_WIDTH)) * D_MODEL ** -0.5,
        "w_o_gqa": nrm(ks[17], (N_GQA_LAYERS, GQA_Q_WIDTH, D_MODEL)) * GQA_Q_WIDTH ** -0.5,
        "q_norm_gqa": 1.0 + 0.05 * nrm(ks[18], (N_GQA_LAYERS, GQA_HEAD_DIM)),
        "k_norm_gqa": 1.0 + 0.05 * nrm(ks[19], (N_GQA_LAYERS, GQA_HEAD_DIM)),
        "w_up": nrm(ks[20], (DEPTH, D_MODEL, 2 * D_FF)) * D_MODEL ** -0.5,
        "conv_w": nrm(ks[21], (DEPTH, CONV_WIDTH, 2 * D_FF)) * CONV_WIDTH ** -0.5,
        "conv_b": nrm(ks[22], (DEPTH, 2 * D_FF)) * 0.02,
        "w_down": nrm(ks[23], (DEPTH, D_FF, D_MODEL)) * D_FF ** -0.5,
        "final_norm": 1.0 + 0.05 * nrm(ks[24], (D_MODEL,)),
    }


def reference(x_prompt, x_sample, cache_k_diff, cache_v_diff, cache_k_gqa, cache_v_gqa, c, c_ctx,
              mod_w, mod_b, norm_attn, norm_ffn, w_qkv_diff, w_o_diff, lambda_diff, subln_diff,
              w_qkv_gqa, w_o_gqa, q_norm_gqa, k_norm_gqa, w_up, conv_w, conv_b, w_down, final_norm):

    def token_mixer(h, l, rope, ctx_kv):
        j = l // N_MIXERS
        if l % N_MIXERS == 0:
            q, k, v = diff_qkv(h, w_qkv_diff[j], rope)
            kk, vv = (k, v) if ctx_kv is None else (jnp.concatenate([ctx_kv[0], k], axis=2),
                                                     jnp.concatenate([ctx_kv[1], v], axis=2))
            o = diff_attend(q, kk, vv, lambda_diff[j], lambda_init(l), subln_diff[j])
            return o @ w_o_diff[j], k, v
        q, k, v = gqa_qkv(h, w_qkv_gqa[j], q_norm_gqa[j], k_norm_gqa[j], rope)
        kk, vv = (k, v) if ctx_kv is None else (jnp.concatenate([ctx_kv[0], k], axis=2),
                                                 jnp.concatenate([ctx_kv[1], v], axis=2))
        o = gqa_attend(q, kk, vv)
        return o @ w_o_gqa[j], k, v

    def layer(x, cond, l, rope, ctx_kv):
        sh_a, sc_a, g_a, sh_f, sc_f, g_f = adaln_params(cond, mod_w[l], mod_b[l])
        o, k, v = token_mixer(modulate(x, norm_attn[l], sh_a, sc_a), l, rope, ctx_kv)
        x = x + g_a * o
        f = conv_ffn(modulate(x, norm_ffn[l], sh_f, sc_f), w_up[l], conv_w[l], conv_b[l], w_down[l])
        return x + g_f * f, k, v

    xp = x_prompt
    kd, vd, kg, vg = [], [], [], []
    for l in range(DEPTH):
        xp, k, v = layer(xp, c_ctx[None, :], l, None, None)
        if l % N_MIXERS == 0:
            kd.append(k); vd.append(v)
        else:
            kg.append(k); vg.append(v)
    y_prompt = rms_norm(xp, final_norm)
    new_k_diff = jnp.stack(kd, axis=1)
    new_v_diff = jnp.stack(vd, axis=1)
    new_k_gqa = jnp.stack(kg, axis=1)
    new_v_gqa = jnp.stack(vg, axis=1)

    xs = x_sample
    rope = axial_rope_tables(xs.shape[1], xs.dtype)
    for l in range(DEPTH):
        j = l // N_MIXERS
        if l % N_MIXERS == 0:
            ctx_kv = (cache_k_diff[:, j], cache_v_diff[:, j])
        else:
            ctx_kv = (cache_k_gqa[:, j], cache_v_gqa[:, j])
        xs, _, _ = layer(xs, c, l, rope, ctx_kv)
    y_sample = rms_norm(xs, final_norm)

    return (y_prompt, y_sample, new_k_diff, new_v_diff, new_k_gqa, new_v_gqa)
```

```cpp
#include <hip/hip_runtime.h>
#include <hip/hip_bf16.h>
#include <cstdio>
#include <cstdint>
#include <cmath>
#define MK_MULTI 1
namespace pg8 {
#define PG8_LAS __attribute__((address_space(3)))
typedef unsigned short bf16_t;
typedef short bf16x8 __attribute__((ext_vector_type(8)));
typedef float f32x4 __attribute__((ext_vector_type(4)));
typedef unsigned u32x4 __attribute__((ext_vector_type(4)));
constexpr int BM = 256, BK = 64, HALF = 128, HTB = HALF * BK * 2  , STAGE_BYTES = 8 * HTB, NXCD = 8, WGM = 8;

__host__ __device__ __forceinline__ int lds_byte(int r, int c) { const int st = (r >> 4) * 2 + (c >> 5), rr = r & 15, cc = c & 31, ob = rr * 64 + cc * 2; return st * 1024 + (ob ^ (((ob >> 9) & 1) << 5)); }
__host__ __device__ __forceinline__ void stage_rc(int b, int& R, int& C) { const int st = b / 1024, sb = b % 1024, swz = sb ^ (((sb >> 9) & 1) << 5); R = (st >> 1) * 16 + swz / 64; C = (st & 1) * 32 + (swz % 64) / 2; }
__host__ __device__ __forceinline__ int perm32(int rho) { const int n = rho >> 4, i = rho & 15; return 8 * (i >> 2) + 4 * n + (i & 3); }

struct Unit { int pm, pn, idx; };
struct Gemm { const bf16_t* A; const bf16_t* Bt; int M, N, K; };

struct StaticOrder {
    int nM, nN, nwg, G, c;
    __host__ __device__ void init(int M, int N, int G_, int c_) { nM = M / BM; nN = N / BM; nwg = nM * nN; G = G_; c = c_; }
    __host__ __device__ bool next(int i, Unit& u) const {
        const long L = (long)i * G + c; if (L >= nwg) return false;
        int wgid = (int)L; { const int q = nwg / NXCD, r = nwg % NXCD, xcd = wgid % NXCD, off = wgid / NXCD; wgid = (xcd < r ? xcd * (q + 1) : r * (q + 1) + (xcd - r) * q) + off; }
        const int nig = WGM * nN, gid = wgid / nig, fm = gid * WGM, gsz = (nM - fm) < WGM ? (nM - fm) : WGM;
        u.pm = fm + ((wgid % nig) % gsz); u.pn = (wgid % nig) / gsz; u.idx = i; return true;
    }
    __device__ __forceinline__ void a_ready(const Unit&) const {}
    __device__ __forceinline__ void done(const Unit&) const {}
};

__device__ __forceinline__ unsigned cvt_pk_bf16(float lo, float hi) { unsigned r; asm volatile("v_cvt_pk_bf16_f32 %0, %1, %2" : "=v"(r) : "v"(lo), "v"(hi)); return r; }
typedef float f32x2 __attribute__((ext_vector_type(2)));
template <class Epi, class Sched, bool ALIGN_EPI = false, bool SP2 = false>
__device__ __forceinline__ void gemm_phase(PG8_LAS unsigned char* lds, const Gemm g, const Sched& S, const Epi& E) {
    int tid_ = threadIdx.x; asm volatile("" : "+v"(tid_));
    const int tid = tid_, wid = __builtin_amdgcn_readfirstlane(tid >> 6), lane = tid & 63, wr = wid >> 2, wc = wid & 3, fr = lane & 15, fq = lane >> 4;
    const int K = g.K, nt = K / BK;
    unsigned voffA[2], voffB[2];
#pragma unroll
    for (int i = 0; i < 2; ++i) { int R, C; stage_rc(tid * 16 + i * 8192, R, C); const int Rb = Epi::PERM ? ((R & ~31) + perm32(R & 31)) : R;
        voffA[i] = (unsigned)(R * K + C) * 2u; voffB[i] = (unsigned)(Rb * K + C) * 2u; }
    const size_t kstep = (size_t)(BK * 2);
    const size_t hstep = (size_t)HALF * K * 2;
    const size_t tstep = 2 * hstep;
    const unsigned ldsw = (unsigned)wid * 1024u;
    const int aoff = lds_byte(wr * 64 + fr, fq * 8), boff = lds_byte(wc * 32 + fr, fq * 8);
#define PG8_SA(b, h) (((b) * 2 + (h)) * HTB)
#define PG8_SB(b, h) ((4 + (b) * 2 + (h)) * HTB)
#define PG8_STAGE(bufoff, gbase, voff) do { _Pragma("unroll") for (int _i = 0; _i < 2; ++_i) \
        __builtin_amdgcn_global_load_lds((const unsigned*)((const char*)(gbase) + (voff)[_i]), (PG8_LAS unsigned*)(lds + (bufoff) + ldsw + _i * 8192), 16, 0, 0); } while (0)
#define PG8_LDA(dst, b, h) do { _Pragma("unroll") for (int m = 0; m < 4; ++m) _Pragma("unroll") for (int k = 0; k < 2; ++k) dst[m][k] = *(const PG8_LAS bf16x8*)(lds + PG8_SA(b, h) + aoff + m * 2048 + k * 1024); } while (0)
#define PG8_LDB(dst, b, h) do { _Pragma("unroll") for (int n = 0; n < 2; ++n) _Pragma("unroll") for (int k = 0; k < 2; ++k) dst[n][k] = *(const PG8_LAS bf16x8*)(lds + PG8_SB(b, h) + boff + n * 2048 + k * 1024); } while (0)
#define PG8_MMA(ai, bj, At, Bt) do { __builtin_amdgcn_s_setprio(1); _Pragma("unroll") for (int m = 0; m < 4; ++m) _Pragma("unroll") for (int n = 0; n < 2; ++n) _Pragma("unroll") for (int k = 0; k < 2; ++k) \
        acc[ai][bj][m][n] = __builtin_amdgcn_mfma_f32_16x16x32_bf16(Bt[n][k], At[m][k], acc[ai][bj][m][n], 0, 0, 0); __builtin_amdgcn_s_setprio(0); } while (0)
#define PG8_WAIT_V(n) asm volatile("s_waitcnt vmcnt(" #n ")" ::: "memory")
#define PG8_WAIT_L(n) asm volatile("s_waitcnt lgkmcnt(" #n ")" ::: "memory")
#define PG8_BAR __builtin_amdgcn_s_barrier()
#define PG8_SCHED __builtin_amdgcn_sched_barrier(0)
    Unit cur, nxt; int ui = 0;
    if (!S.next(0, cur)) return;
    f32x4 acc[2][2][4][2];
#pragma unroll
    for (int a = 0; a < 2; ++a)
#pragma unroll
        for (int b = 0; b < 2; ++b)
#pragma unroll
            for (int m = 0; m < 4; ++m)
#pragma unroll
                for (int n = 0; n < 2; ++n) acc[a][b][m][n] = (f32x4){0.f, 0.f, 0.f, 0.f};
    bf16x8 At[4][2], B0[2][2], B1[2][2];
    const char* cA = (const char*)g.A + (size_t)cur.pm * tstep; const char* cB = (const char*)g.Bt + (size_t)cur.pn * tstep;
    S.a_ready(cur);
    if constexpr (SP2) {
        PG8_STAGE(PG8_SB(0, 0), cB, voffB); PG8_STAGE(PG8_SB(0, 1), cB + hstep, voffB); PG8_STAGE(PG8_SA(0, 0), cA, voffA); PG8_STAGE(PG8_SA(0, 1), cA + hstep, voffA);
        if (wr == 1) PG8_BAR;
        PG8_WAIT_V(2); PG8_BAR;
        PG8_STAGE(PG8_SB(1, 0), cB + kstep, voffB); PG8_STAGE(PG8_SA(1, 0), cA + kstep, voffA); PG8_STAGE(PG8_SB(1, 1), cB + hstep + kstep, voffB);
        PG8_WAIT_V(6); PG8_BAR;
    } else {
        PG8_STAGE(PG8_SB(0, 0), cB, voffB); PG8_STAGE(PG8_SA(0, 0), cA, voffA); PG8_STAGE(PG8_SB(0, 1), cB + hstep, voffB); PG8_STAGE(PG8_SA(0, 1), cA + hstep, voffA);
        if (wr == 1) PG8_BAR;
        PG8_WAIT_V(4); PG8_BAR;
        PG8_STAGE(PG8_SB(1, 0), cB + kstep, voffB); PG8_STAGE(PG8_SA(1, 0), cA + kstep, voffA); PG8_STAGE(PG8_SB(1, 1), cB + hstep + kstep, voffB);
        PG8_WAIT_V(6); PG8_BAR;
    }
    for (;;) {
        const bool has_next = S.next(ui + 1, nxt);
        const char* nA = has_next ? (const char*)g.A + (size_t)nxt.pm * tstep : cA; const char* nB = has_next ? (const char*)g.Bt + (size_t)nxt.pn * tstep : cB;
        for (int t = 0; t < nt; t += 2) {
            const bool last = (t == nt - 2);
            const char* a1 = cA + (size_t)(t + 1) * kstep;
            const char* a2 = last ? nA : cA + (size_t)(t + 2) * kstep; const char* b2 = last ? nB : cB + (size_t)(t + 2) * kstep;
            const char* a3 = a2 + kstep; const char* b3 = b2 + kstep;
            if (last && has_next) S.a_ready(nxt);
            if constexpr (SP2) {
            PG8_LDB(B0, 0, 0); PG8_LDB(B1, 0, 1); PG8_SCHED; PG8_LDA(At, 0, 0); PG8_STAGE(PG8_SA(1, 1), a1 + hstep, voffA);
            PG8_WAIT_V(8); PG8_WAIT_L(0); PG8_BAR; PG8_MMA(0, 0, At, B0); PG8_MMA(0, 1, At, B1); PG8_BAR; PG8_SCHED;
            PG8_LDA(At, 0, 1); PG8_STAGE(PG8_SB(0, 0), b2, voffB); PG8_STAGE(PG8_SB(0, 1), b2 + hstep, voffB); PG8_STAGE(PG8_SA(0, 0), a2, voffA);
            PG8_WAIT_V(8); PG8_WAIT_L(0); PG8_BAR; PG8_MMA(1, 0, At, B0); PG8_MMA(1, 1, At, B1); PG8_BAR; PG8_SCHED;
            PG8_LDB(B0, 1, 0); PG8_LDB(B1, 1, 1); PG8_SCHED; PG8_LDA(At, 1, 0); PG8_STAGE(PG8_SA(0, 1), a2 + hstep, voffA);
            PG8_WAIT_V(8); PG8_WAIT_L(0); PG8_BAR; PG8_MMA(0, 0, At, B0); PG8_MMA(0, 1, At, B1); PG8_BAR; PG8_SCHED;
            PG8_LDA(At, 1, 1); PG8_STAGE(PG8_SB(1, 0), b3, voffB); PG8_STAGE(PG8_SB(1, 1), b3 + hstep, voffB); PG8_STAGE(PG8_SA(1, 0), a3, voffA);
            PG8_WAIT_V(8); PG8_WAIT_L(0); PG8_BAR; PG8_MMA(1, 0, At, B0); PG8_MMA(1, 1, At, B1); PG8_BAR; PG8_SCHED;
            } else {
            PG8_LDB(B0, 0, 0); PG8_SCHED; PG8_LDA(At, 0, 0); PG8_STAGE(PG8_SA(1, 1), a1 + hstep, voffA);
            PG8_WAIT_L(8); PG8_BAR; PG8_WAIT_L(0); PG8_MMA(0, 0, At, B0); PG8_BAR; PG8_SCHED;
            PG8_LDB(B1, 0, 1); PG8_STAGE(PG8_SB(0, 0), b2, voffB);
            PG8_BAR; PG8_WAIT_L(0); PG8_MMA(0, 1, At, B1); PG8_BAR;
            PG8_LDA(At, 0, 1); PG8_STAGE(PG8_SA(0, 0), a2, voffA);
            PG8_BAR; PG8_WAIT_L(0); PG8_MMA(1, 0, At, B0); PG8_BAR; PG8_SCHED;
            PG8_STAGE(PG8_SB(0, 1), b2 + hstep, voffB);
            PG8_WAIT_V(6); PG8_BAR; PG8_MMA(1, 1, At, B1); PG8_BAR;
            PG8_LDB(B0, 1, 0); PG8_SCHED; PG8_LDA(At, 1, 0); PG8_STAGE(PG8_SA(0, 1), a2 + hstep, voffA);
            PG8_WAIT_L(8); PG8_BAR; PG8_WAIT_L(0); PG8_MMA(0, 0, At, B0); PG8_BAR; PG8_SCHED;
            PG8_LDB(B1, 1, 1); PG8_STAGE(PG8_SB(1, 0), b3, voffB);
            PG8_BAR; PG8_WAIT_L(0); PG8_MMA(0, 1, At, B1); PG8_BAR;
            PG8_LDA(At, 1, 1); PG8_STAGE(PG8_SA(1, 0), a3, voffA);
            PG8_BAR; PG8_WAIT_L(0); PG8_MMA(1, 0, At, B0); PG8_BAR; PG8_SCHED;
            PG8_STAGE(PG8_SB(1, 1), b3 + hstep, voffB);
            PG8_WAIT_V(6); PG8_BAR; PG8_MMA(1, 1, At, B1); PG8_BAR;
            }
        }
        if constexpr (ALIGN_EPI) { if (wr == 0) PG8_BAR; }
        if constexpr (!Epi::AFTER_DRAIN) { E(acc, cur, wr, wc, fr, fq); S.done(cur); }
        if (!has_next) break;
#pragma unroll
        for (int a = 0; a < 2; ++a)
#pragma unroll
            for (int b = 0; b < 2; ++b)
#pragma unroll
                for (int m = 0; m < 4; ++m)
#pragma unroll
                    for (int n = 0; n < 2; ++n) acc[a][b][m][n] = (f32x4){0.f, 0.f, 0.f, 0.f};
        cur = nxt; cA = nA; cB = nB; ++ui;
        if constexpr (ALIGN_EPI) { if (wr == 1) PG8_BAR; }
    }
    PG8_WAIT_V(0);
    if constexpr (!ALIGN_EPI) { if (wr == 0) PG8_BAR; }
    PG8_BAR;
    if constexpr (Epi::AFTER_DRAIN) { E.fused(acc, cur, wr, wc, fr, fq, lds, wid, lane); S.done(cur); }
#undef PG8_SA
#undef PG8_SB
#undef PG8_STAGE
#undef PG8_LDA
#undef PG8_LDB
#undef PG8_MMA
#undef PG8_WAIT_V
#undef PG8_WAIT_L
#undef PG8_BAR
#undef PG8_SCHED
}
}
namespace pg8 {
typedef unsigned u32x2 __attribute__((ext_vector_type(2)));
constexpr int NTOK = 8192, NPROMPT = 4096, DMODEL = 1024, NPART = 16;
constexpr float C2Q = 0.125f * 1.4426950408889634f;
__device__ __forceinline__ u32x2 pack4(const f32x4 v) { u32x2 w; w.x = cvt_pk_bf16(v[0], v[1]); w.y = cvt_pk_bf16(v[2], v[3]); return w; }
__device__ __forceinline__ int mod_index(int pm) { return pm < 16 ? 0 : 1 + ((pm - 16) >> 3); }
__device__ __forceinline__ int kv_row(int m) { return m < NPROMPT ? m : m + 256 * (((m - NPROMPT) >> 11) + 1); }
__device__ __forceinline__ float row_rstd(const float* rowss, int row) {
    float s = 0.f;
#pragma unroll
    for (int p = 0; p < NPART; ++p) s += rowss[p * NTOK + row];
    return __builtin_amdgcn_rsqf(s * (1.0f / DMODEL) + 1e-6f);
}

struct EpiResid {
    static constexpr bool PERM = false, AFTER_DRAIN = false;
    float* X; bf16_t* XG; const float* gate; int gate_ld; const float* gain; float* rowss;
    __device__ __forceinline__ void operator()(const f32x4 (&acc)[2][2][4][2], const Unit& u, int wr, int wc, int fr_, int fq_) const {
        int fr = fr_, fq = fq_; asm volatile("" : "+v"(fr), "+v"(fq));
        const int v = mod_index(u.pm), col0 = u.pn * BM + wc * 32 + 4 * fq;
        f32x4 gt[2][2], gn[2][2];
#pragma unroll
        for (int bj = 0; bj < 2; ++bj)
#pragma unroll
            for (int n = 0; n < 2; ++n) { gt[bj][n] = *(const f32x4*)(gate + v * gate_ld + col0 + bj * HALF + n * 16);
                gn[bj][n] = gain ? *(const f32x4*)(gain + v * DMODEL + col0 + bj * HALF + n * 16) : (f32x4){0.f, 0.f, 0.f, 0.f}; }
#pragma unroll
        for (int ai = 0; ai < 2; ++ai)
#pragma unroll
            for (int m = 0; m < 4; ++m) { const int row = u.pm * BM + ai * HALF + wr * 64 + m * 16 + fr; const size_t off = (size_t)row * DMODEL + col0; float ss = 0.f;
#pragma unroll
                for (int bj = 0; bj < 2; ++bj)
#pragma unroll
                    for (int n = 0; n < 2; ++n) { const f32x4 xo = *(const f32x4*)(X + off + bj * HALF + n * 16); const f32x4 xn = xo + gt[bj][n] * acc[ai][bj][m][n];
                        *(f32x4*)(X + off + bj * HALF + n * 16) = xn; ss += (xn[0] * xn[0] + xn[1] * xn[1]) + (xn[2] * xn[2] + xn[3] * xn[3]);
                        if (gain) *(u32x2*)(XG + off + bj * HALF + n * 16) = pack4(xn * gn[bj][n]); }
                ss += __shfl_xor(ss, 16); ss += __shfl_xor(ss, 32);
                if (fq == 0) rowss[(u.pn * 4 + wc) * NTOK + row] = ss;
                if (m & 1) asm volatile("" ::: "memory"); }
    }
};

struct EpiUp {
    static constexpr bool PERM = false, AFTER_DRAIN = false;
    bf16_t* U; int ldu; const float* bias; const PG8_LAS float* rstd;
    __device__ __forceinline__ void operator()(const f32x4 (&acc)[2][2][4][2], const Unit& u, int wr, int wc, int fr_, int fq_) const {
        int fr = fr_, fq = fq_; asm volatile("" : "+v"(fr), "+v"(fq));
        const int v = mod_index(u.pm), col0 = u.pn * BM + wc * 32 + 4 * fq;
        f32x4 bv[2][2];
#pragma unroll
        for (int bj = 0; bj < 2; ++bj)
#pragma unroll
            for (int n = 0; n < 2; ++n) bv[bj][n] = *(const f32x4*)(bias + (size_t)v * ldu + col0 + bj * HALF + n * 16);
#pragma unroll
        for (int ai = 0; ai < 2; ++ai)
#pragma unroll
            for (int m = 0; m < 4; ++m) { const int trow = ai * HALF + wr * 64 + m * 16 + fr, row = u.pm * BM + trow; const float rs = rstd[(u.idx & 7) * 256 + trow]; bf16_t* rowp = U + (size_t)row * ldu + col0;
#pragma unroll
                for (int bj = 0; bj < 2; ++bj)
#pragma unroll
                    for (int n = 0; n < 2; ++n) *(u32x2*)(rowp + bj * HALF + n * 16) = pack4(acc[ai][bj][m][n] * rs + bv[bj][n]); }
    }
};

struct EpiQkvDiff {
    static constexpr bool PERM = false, AFTER_DRAIN = false;
    bf16_t *Q, *K, *V; const float* bias; const PG8_LAS float* rstd; const float* rope;
    float *newk, *newv;
    __device__ __forceinline__ void operator()(const f32x4 (&acc)[2][2][4][2], const Unit& u, int wr, int wc, int fr_, int fq_) const {
        int fr = fr_, fq = fq_; asm volatile("" : "+v"(fr), "+v"(fq));
        const int v = mod_index(u.pm), sec = u.pn >> 2, cs = (u.pn & 3) * BM + wc * 32 + 4 * fq;
        const bool latent = u.pm >= 16; const int qb = (u.pm - 16) & 7;
        f32x4 bv[2][2];
#pragma unroll
        for (int bj = 0; bj < 2; ++bj)
#pragma unroll
            for (int n = 0; n < 2; ++n) bv[bj][n] = *(const f32x4*)(bias + v * 3072 + sec * 1024 + cs + bj * HALF + n * 16);
#pragma unroll
        for (int ai = 0; ai < 2; ++ai)
#pragma unroll
            for (int m = 0; m < 4; ++m) { const int trow = ai * HALF + wr * 64 + m * 16 + fr, row = u.pm * BM + trow; const float rs = rstd[(u.idx & 7) * 256 + trow];
                f32x4 c4 = (f32x4){1.f, 1.f, 1.f, 1.f}, s4 = (f32x4){0.f, 0.f, 0.f, 0.f};
                if (latent && sec < 2) { const int pos = (wc & 1) ? (trow & 63) : (4 * qb + (trow >> 6));
                    const float* rp = rope + (pos * 16 + 4 * fq) * 2; const f32x4 a = *(const f32x4*)rp, b = *(const f32x4*)(rp + 4);
                    c4 = (f32x4){a[0], a[2], b[0], b[2]}; s4 = (f32x4){a[1], a[3], b[1], b[3]}; }
#pragma unroll
                for (int bj = 0; bj < 2; ++bj) { f32x4 x0 = acc[ai][bj][m][0] * rs + bv[bj][0], x1 = acc[ai][bj][m][1] * rs + bv[bj][1];
                    if (sec == 0) { const f32x4 y0 = (x0 * c4 - x1 * s4) * C2Q, y1 = (x1 * c4 + x0 * s4) * C2Q; bf16_t* p = Q + (size_t)row * DMODEL + cs + bj * HALF;
                        *(u32x2*)p = pack4(y0); *(u32x2*)(p + 16) = pack4(y1); }
                    else { const size_t kr = (size_t)kv_row(row) * DMODEL + cs + bj * HALF;
                        if (!latent) { float* o = (sec == 1 ? newk : newv) + ((size_t)(u.pm * 16 + (u.pn & 3) * 2 + bj) * 256 + trow) * 128 + wc * 32 + 4 * fq; *(f32x4*)o = x0; *(f32x4*)(o + 16) = x1; }
                        if (sec == 1) { const f32x4 y0 = x0 * c4 - x1 * s4, y1 = x1 * c4 + x0 * s4; *(u32x2*)(K + kr) = pack4(y0); *(u32x2*)(K + kr + 16) = pack4(y1); }
                        else { *(u32x2*)(V + kr) = pack4(x0); *(u32x2*)(V + kr + 16) = pack4(x1); } } }
                asm volatile("" ::: "memory"); }
    }
};

struct EpiQkvGqa {
    static constexpr bool PERM = false, AFTER_DRAIN = false;
    bf16_t *Q, *K, *V; const float* bias; const PG8_LAS float* rstd; const float* rope; const float *qnw, *knw;
    float *newk, *newv;
    __device__ __forceinline__ void operator()(const f32x4 (&acc)[2][2][4][2], const Unit& u, int wr, int wc, int fr_, int fq_) const {
        int fr = fr_, fq = fq_; asm volatile("" : "+v"(fr), "+v"(fq));
        const int v = mod_index(u.pm), sec = u.pn < 4 ? 0 : u.pn - 3;
        const bool latent = u.pm >= 16; const int qb = (u.pm - 16) & 7;
        const float* biasp = bias + v * 1536 + u.pn * BM + wc * 32 + 4 * fq; const float* nwp = (sec == 0 ? qnw : knw) + 4 * fq;
#pragma unroll
        for (int ai = 0; ai < 2; ++ai)
#pragma unroll
            for (int m = 0; m < 4; ++m) { const int trow = ai * HALF + wr * 64 + m * 16 + fr, row = u.pm * BM + trow; const float rs = rstd[(u.idx & 7) * 256 + trow];
                f32x4 x[2][2]; float ss = 0.f;
#pragma unroll
                for (int bj = 0; bj < 2; ++bj)
#pragma unroll
                    for (int n = 0; n < 2; ++n) { x[bj][n] = acc[ai][bj][m][n] * rs + *(const f32x4*)(biasp + bj * HALF + n * 16); const f32x4 t = x[bj][n]; ss += (t[0] * t[0] + t[1] * t[1]) + (t[2] * t[2] + t[3] * t[3]); }
                if (sec < 2) { ss += __shfl_xor(ss, 16); ss += __shfl_xor(ss, 32); const float hr = __builtin_amdgcn_rsqf(ss * (1.0f / 64.0f) + 1e-6f);
#pragma unroll
                    for (int bj = 0; bj < 2; ++bj)
#pragma unroll
                        for (int n = 0; n < 2; ++n) x[bj][n] = x[bj][n] * hr * *(const f32x4*)(nwp + 32 * bj + 16 * n); }
                if (sec == 0) {
#pragma unroll
                    for (int bj = 0; bj < 2; ++bj) { f32x4 y0 = x[bj][0], y1 = x[bj][1];
                        if (latent) { const int pos = bj ? (trow & 63) : (4 * qb + (trow >> 6)); const float* rp = rope + (pos * 16 + 4 * fq) * 2; const f32x4 a = *(const f32x4*)rp, b = *(const f32x4*)(rp + 4);
                            const f32x4 c4 = (f32x4){a[0], a[2], b[0], b[2]}, s4 = (f32x4){a[1], a[3], b[1], b[3]}; y0 = x[bj][0] * c4 - x[bj][1] * s4; y1 = x[bj][1] * c4 + x[bj][0] * s4; }
                        bf16_t* p = Q + (size_t)row * DMODEL + (u.pn * 4 + wc) * 64 + 32 * bj + 4 * fq; *(u32x2*)p = pack4(y0 * C2Q); *(u32x2*)(p + 16) = pack4(y1 * C2Q); }
                } else {
                    const size_t kr = (size_t)kv_row(row) * 256 + wc * 64 + 4 * fq;
                    if (!latent) { float* o = (sec == 1 ? newk : newv) + ((size_t)(u.pm * 8 + wc) * 256 + trow) * 64 + 4 * fq;
#pragma unroll
                        for (int bj = 0; bj < 2; ++bj) { *(f32x4*)(o + 32 * bj) = x[bj][0]; *(f32x4*)(o + 32 * bj + 16) = x[bj][1]; } }
#pragma unroll
                    for (int bj = 0; bj < 2; ++bj) { f32x4 y0 = x[bj][0], y1 = x[bj][1];
                        if (latent && sec == 1) { const int pos = bj ? (trow & 63) : (4 * qb + (trow >> 6)); const float* rp = rope + (pos * 16 + 4 * fq) * 2; const f32x4 a = *(const f32x4*)rp, b = *(const f32x4*)(rp + 4);
                            const f32x4 c4 = (f32x4){a[0], a[2], b[0], b[2]}, s4 = (f32x4){a[1], a[3], b[1], b[3]}; y0 = x[bj][0] * c4 - x[bj][1] * s4; y1 = x[bj][1] * c4 + x[bj][0] * s4; }
                        bf16_t* p = (sec == 1 ? K : V) + kr + 32 * bj; *(u32x2*)p = pack4(y0); *(u32x2*)(p + 16) = pack4(y1); } }
                asm volatile("" ::: "memory");
            }
    }
};
}
namespace attn_body {
using bf16=__hip_bfloat16;
using bf16x8=__attribute__((ext_vector_type(8)))short;
using s16x4=__attribute__((ext_vector_type(4)))short;
using f32x16=__attribute__((ext_vector_type(16)))float;
using u32x4=__attribute__((ext_vector_type(4)))unsigned;
constexpr int D=64;
constexpr int NW=8,QBLK=32,QB=QBLK*NW,KVBLK=64;
constexpr int ATTN_UNIT_ROWS=QB;
__device__ __forceinline__ int crow(int r,int hi){return (r&3)+8*(r>>2)+4*hi;}
#define SBAR() __builtin_amdgcn_sched_barrier(0)

constexpr int NSLOT=3, SLOTB=8192;
constexpr int LDS_K=0, LDS_V=NSLOT*SLOTB, LDS_WS=2*NSLOT*SLOTB, LDS_OST=LDS_WS+NW*64*4, LDS_BYTES=LDS_OST+NW*4096;
constexpr float C2=0.125f*1.4426950408889634f;
__device__ __forceinline__ void glds16(const void*gsrc,unsigned lds_dst){unsigned keep;
  asm volatile("s_mov_b32 %0, m0\n\ts_mov_b32 m0, %2\n\ts_nop 0\n\tglobal_load_lds_dwordx4 %1, off\n\ts_mov_b32 m0, %0":"=&s"(keep):"v"(gsrc),"s"(lds_dst):"memory");}
__device__ __forceinline__ float max3f(float a,float b,float c){float r;asm("v_max3_f32 %0, %1, %2, %3":"=v"(r):"v"(a),"v"(b),"v"(c));return r;}
__device__ __forceinline__ float max2f(float a,float b){float r;asm("v_max_f32_e32 %0, %1, %2":"=v"(r):"v"(a),"v"(b));return r;}
__device__ __forceinline__ float fadd_s(float a,float b){float r;asm("v_add_f32_e32 %0, %1, %2":"=v"(r):"v"(a),"v"(b));return r;}
__device__ __forceinline__ float fsub_s(float a,float b){float r;asm("v_sub_f32_e32 %0, %1, %2":"=v"(r):"v"(a),"v"(b));return r;}
typedef float f32x2_t __attribute__((ext_vector_type(2))); typedef __bf16 bf16x2_t __attribute__((ext_vector_type(2)));
__device__ __forceinline__ unsigned cvtpk_s(float lo,float hi){f32x2_t v={lo,hi};bf16x2_t b=__builtin_convertvector(v,bf16x2_t);return __builtin_bit_cast(unsigned,b);}
#define WAIT_BAR(N) asm volatile("s_waitcnt vmcnt(" #N ") lgkmcnt(0)\n\ts_barrier":::"memory")

__device__ __forceinline__ void qkt(f32x16&p0,f32x16&p1,const char*Kslot,const bf16x8*qr,const f32x16&negm,int r32,int hi){
  const char*kb=Kslot+hi*1024+r32*16;
  #pragma unroll
  for(int d0=0;d0<4;++d0){
    const bf16x8 b0=*reinterpret_cast<const bf16x8*>(kb+d0*2048);
    const bf16x8 b1=*reinterpret_cast<const bf16x8*>(kb+d0*2048+512);
    if(d0==0){p0=__builtin_amdgcn_mfma_f32_32x32x16_bf16(b0,qr[0],negm,0,0,0);p1=__builtin_amdgcn_mfma_f32_32x32x16_bf16(b1,qr[0],negm,0,0,0);}
    else{p0=__builtin_amdgcn_mfma_f32_32x32x16_bf16(b0,qr[d0],p0,0,0,0);p1=__builtin_amdgcn_mfma_f32_32x32x16_bf16(b1,qr[d0],p1,0,0,0);}}
}
typedef __attribute__((address_space(3))) const char* lds_cptr;
typedef short v4i16_t __attribute__((ext_vector_type(4)));
__device__ __forceinline__ void kload8(bf16x8*kf,lds_cptr kp){
  kf[0]=*(const __attribute__((address_space(3))) bf16x8*)(kp);      kf[1]=*(const __attribute__((address_space(3))) bf16x8*)(kp+512);
  kf[2]=*(const __attribute__((address_space(3))) bf16x8*)(kp+2048); kf[3]=*(const __attribute__((address_space(3))) bf16x8*)(kp+2560);
  kf[4]=*(const __attribute__((address_space(3))) bf16x8*)(kp+4096); kf[5]=*(const __attribute__((address_space(3))) bf16x8*)(kp+4608);
  kf[6]=*(const __attribute__((address_space(3))) bf16x8*)(kp+6144); kf[7]=*(const __attribute__((address_space(3))) bf16x8*)(kp+6656);
}
__device__ __forceinline__ void kload2(bf16x8*kf,lds_cptr kp,int j){ kf[2*j]=*(const __attribute__((address_space(3))) bf16x8*)(kp+j*2048); kf[2*j+1]=*(const __attribute__((address_space(3))) bf16x8*)(kp+j*2048+512); }
__device__ __forceinline__ s16x4 vtr(lds_cptr p){ return __builtin_bit_cast(s16x4,__builtin_amdgcn_ds_read_tr16_b64_v4i16((__attribute__((address_space(3))) v4i16_t*)p)); }
__device__ __forceinline__ float rowmax(const f32x16&p0,const f32x16&p1){
  float a=max3f(p0[0],p0[1],p1[0]),b=max3f(p0[2],p0[3],p1[1]);a=max3f(a,p1[2],p1[3]);
  #pragma unroll
  for(int r=4;r<16;r+=4){a=max3f(a,p0[r],p0[r+1]);b=max3f(b,p0[r+2],p0[r+3]);a=max3f(a,p1[r],p1[r+1]);b=max3f(b,p1[r+2],p1[r+3]);}
  const float m=max2f(a,b);
  auto rr=__builtin_amdgcn_permlane32_swap(__float_as_uint(m),__float_as_uint(m),false,false);
  return max2f(__uint_as_float(rr[0]),__uint_as_float(rr[1]));
}
__device__ __forceinline__ void pv(f32x16*o,int vb,bf16x8 pa0,bf16x8 pa1,bf16x8 pa2,bf16x8 pa3){
  #pragma unroll
  for(int d0=0;d0<2;++d0){s16x4 lo[4],hi[4];
    #pragma unroll
    for(int ks=0;ks<4;++ks){
      asm volatile("ds_read_b64_tr_b16 %0,%1 offset:%c2":"=&v"(lo[ks]):"v"(vb),"i"(d0*4096+ks*1024):"memory");
      asm volatile("ds_read_b64_tr_b16 %0,%1 offset:%c2":"=&v"(hi[ks]):"v"(vb),"i"(d0*4096+ks*1024+512):"memory");}
    asm volatile("s_waitcnt lgkmcnt(0)":::"memory");SBAR();
    #define PK(k) (bf16x8){lo[k][0],lo[k][1],lo[k][2],lo[k][3],hi[k][0],hi[k][1],hi[k][2],hi[k][3]}
    o[d0]=__builtin_amdgcn_mfma_f32_32x32x16_bf16(pa0,PK(0),o[d0],0,0,0);
    o[d0]=__builtin_amdgcn_mfma_f32_32x32x16_bf16(pa1,PK(1),o[d0],0,0,0);
    o[d0]=__builtin_amdgcn_mfma_f32_32x32x16_bf16(pa2,PK(2),o[d0],0,0,0);
    o[d0]=__builtin_amdgcn_mfma_f32_32x32x16_bf16(pa3,PK(3),o[d0],0,0,0);
    #undef PK
  }
}

#ifndef ATTN_STORE16
#define ATTN_STORE16(p,v) (*(u32x4*)(p)=(v))
#endif
struct AttnJob {
  const bf16* Q; int QP;
  const bf16* K; int KP;
  const bf16* V; int VP;
  bf16* O; int OP;
  int NT;
  int npass;
  float lam;
  float* ss; int ssP;
};
template<int THRL> __device__ __forceinline__ void attn_unit(const AttnJob& J,const int pass,char*shm){
  int tid_=threadIdx.x; asm volatile("":"+v"(tid_));
  const int tid=tid_,lane=tid&63,r32=lane&31,hi=lane>>5; const int wid=__builtin_amdgcn_readfirstlane(tid>>6);
  const int QP=J.QP,KP=J.KP,VP=J.VP,OP=J.OP;
  const bf16*Qw=J.Q+(long)(wid*QBLK)*QP+pass*64;
  const bf16*Kh=J.K+pass*64,*Vh=J.V;
  const unsigned lds0=(unsigned)(uintptr_t)shm;
  float*wsf=(float*)(shm+LDS_WS)+wid*64;
  const bf16*ksrc=Kh+(long)lane*KP+wid*8;
  const bf16*vsrc=Vh+(long)(16*(wid&3)+(lane>>2))*VP+(wid>>2)*32+(lane&3)*8;
  const unsigned kdst=lds0+LDS_K+wid*1024, vdst=lds0+LDS_V+wid*1024;
  #define DMA_K(t,slot) glds16(ksrc+(long)(t)*KVBLK*KP,(unsigned)__builtin_amdgcn_readfirstlane(kdst+(slot)))
  #define DMA_V(t,slot) glds16(vsrc+(long)(t)*KVBLK*VP,(unsigned)__builtin_amdgcn_readfirstlane(vdst+(slot)))
  const int vb0=(int)(lds0+LDS_V)+((lane>>4)&1)*32+(lane&3)*8+(4*hi+((lane&15)>>2))*64;
  const char*Kbase=shm+LDS_K; bf16x8 kf[8];
  const lds_cptr shm3=(lds_cptr)shm; const lds_cptr kp0=shm3+LDS_K+hi*1024+r32*16; const lds_cptr vp0=shm3+LDS_V+((lane>>4)&1)*32+(lane&3)*8+(4*hi+((lane&15)>>2))*64;
  const int NT=J.NT;
  DMA_K(0,0);DMA_V(0,0);DMA_K(1,SLOTB);
  bf16x8 qr[4];
  #pragma unroll
  for(int d0=0;d0<4;++d0)qr[d0]=*reinterpret_cast<const bf16x8*>(&Qw[(long)r32*QP+d0*16+hi*8]);
  float mhat=0.f,l_reg=0.f;f32x16 o[2];o[0]=f32x16{};o[1]=f32x16{};f32x16 negm=f32x16{};asm volatile("":"+v"(negm));
  #define CMASK(P0,P1,t) do{}while(0)
  bool resc=false;
  #define START(P0,P1) do{ const float rm=rowmax(P0,P1); resc=false; \
    { const float dl=rm; mhat=fadd_s(mhat,dl); \
      _Pragma("unroll") for(int r=0;r<16;++r){P0[r]=fsub_s(P0[r],dl);P1[r]=fsub_s(P1[r],dl);} \
      _Pragma("unroll") for(int r=0;r<16;++r)negm[r]=-mhat; asm volatile("":"+v"(negm)); } \
    _Pragma("unroll") for(int r=0;r<16;++r)P0[r]=__builtin_amdgcn_exp2f(P0[r]); }while(0)
  #define RESC() do{ if(resc){ asm volatile("s_waitcnt lgkmcnt(0)":::"memory"); \
      _Pragma("unroll") for(int d_=0;d_<2;++d_) _Pragma("unroll") for(int r=0;r<16;++r)o[d_][r]*=wsf[crow(r,hi)]; } }while(0)
  f32x16 pA0,pA1,pB0,pB1;
  int sl_prev=0,sl_cur=0,sl_next=SLOTB;
  #define ROT() do{sl_prev=sl_cur;sl_cur=sl_next;sl_next=(sl_next==(NSLOT-1)*SLOTB)?0:sl_next+SLOTB;}while(0)
  DMA_K(2,2*SLOTB);
  WAIT_BAR(3);
  qkt(pA0,pA1,Kbase,qr,negm,r32,hi);asm volatile("s_nop 15\n\ts_nop 7":"+v"(pA0),"+v"(pA1));CMASK(pA0,pA1,0);
  START(pA0,pA1);
  _Pragma("unroll") for(int r=0;r<16;++r)pA1[r]=__builtin_amdgcn_exp2f(pA1[r]);
  WAIT_BAR(0);
  DMA_K(3,0);DMA_V(1,SLOTB);
  ROT();
  kload8(kf,kp0+sl_cur);
  WAIT_BAR(2);
  s16x4 vlo[8],vhi[8]; u32x4 pw0,pw1,pw2,pw3;
  #define PKW(P,B) cvtpk_s(P[B],P[B+1])
  #define PAF(k) __builtin_bit_cast(bf16x8,pw##k)
  #define VFR(i) (bf16x8){vlo[i][0],vlo[i][1],vlo[i][2],vlo[i][3],vhi[i][0],vhi[i][1],vhi[i][2],vhi[i][3]}
  #define PIN(x) asm volatile("":"+v"(x))
  #define MX3(a,b,c) __builtin_fmaxf(__builtin_fmaxf((a),(b)),(c))
  #define GAPA(MF,A0,A1,A2,A3,W0,W1,PW) do{ MF; sacc+=A0; sacc+=A1; sacc+=A2; sacc+=A3; PIN(sacc); W0; W1; PIN(PW); SBAR(); }while(0)
  #define EX(v) __builtin_amdgcn_exp2f(v)
  #define GAPB(MF,X,B) do{ MF; X[B]=EX(X[B]); X[B+1]=EX(X[B+1]); X[B+2]=EX(X[B+2]); X[B+3]=EX(X[B+3]); PIN(X); SBAR(); }while(0)
  #define VRD(i) do{ vlo[i]=vtr(vp_+(((i)>>2)*4096+((i)&3)*1024)); vhi[i]=vtr(vp_+(((i)>>2)*4096+((i)&3)*1024+512)); }while(0)
  #define KRD(G,j) do{ if(G){ kload2(kf,kp0+sl_next,j); SBAR(); } }while(0)
  #define STEP(C0,C1,P0,P1,t,GK,GV,GL) do{ SBAR(); \
    const lds_cptr vp_=vp0+sl_prev; \
    VRD(0); SBAR(); float sacc=(P0[0]+P0[1]); \
    GAPA(C0=__builtin_amdgcn_mfma_f32_32x32x16_bf16(kf[0],qr[0],negm,0,0,0), P0[2],P0[3],P0[4],P0[5],     pw0[0]=PKW(P0,0), pw0[1]=PKW(P0,2), pw0); \
    VRD(4); SBAR(); GAPA(C1=__builtin_amdgcn_mfma_f32_32x32x16_bf16(kf[1],qr[0],negm,0,0,0), P0[6],P0[7],P0[8],P0[9],     pw0[2]=PKW(P0,4), pw0[3]=PKW(P0,6), pw0); \
    VRD(1); SBAR(); GAPA(C0=__builtin_amdgcn_mfma_f32_32x32x16_bf16(kf[2],qr[1],C0,0,0,0),   P0[10],P0[11],P0[12],P0[13], pw1[0]=PKW(P0,8), pw1[1]=PKW(P0,10), pw1); \
    VRD(5); SBAR(); GAPA(C1=__builtin_amdgcn_mfma_f32_32x32x16_bf16(kf[3],qr[1],C1,0,0,0),   P0[14],P0[15],P1[0],P1[1],   pw1[2]=PKW(P0,12),pw1[3]=PKW(P0,14), pw1); \
    VRD(2); SBAR(); GAPA(C0=__builtin_amdgcn_mfma_f32_32x32x16_bf16(kf[4],qr[2],C0,0,0,0),   P1[2],P1[3],P1[4],P1[5],     pw2[0]=PKW(P1,0), pw2[1]=PKW(P1,2), pw2); \
    VRD(6); SBAR(); GAPA(C1=__builtin_amdgcn_mfma_f32_32x32x16_bf16(kf[5],qr[2],C1,0,0,0),   P1[6],P1[7],P1[8],P1[9],     pw2[2]=PKW(P1,4), pw2[3]=PKW(P1,6), pw2); \
    VRD(3); SBAR(); GAPA(C0=__builtin_amdgcn_mfma_f32_32x32x16_bf16(kf[6],qr[3],C0,0,0,0),   P1[10],P1[11],P1[12],P1[13], pw3[0]=PKW(P1,8), pw3[1]=PKW(P1,10), pw3); \
    VRD(7); SBAR(); GAPA(C1=__builtin_amdgcn_mfma_f32_32x32x16_bf16(kf[7],qr[3],C1,0,0,0),   P1[14],P1[15],0.f,0.f,       pw3[2]=PKW(P1,12),pw3[3]=PKW(P1,14), pw3); \
    l_reg+=sacc; \
    if(GK){DMA_K((t)+3,sl_cur);} if(GV){DMA_V((t)+1,sl_next);} \
    CMASK(C0,C1,t); \
    { float a=MX3(C0[0],C0[1],C1[0]),b=MX3(C0[2],C0[3],C1[1]); a=MX3(a,C1[2],C1[3]); \
      _Pragma("unroll") for(int r=4;r<16;r+=4){a=MX3(a,C0[r],C0[r+1]);b=MX3(b,C0[r+2],C0[r+3]);a=MX3(a,C1[r],C1[r+1]);b=MX3(b,C1[r+2],C1[r+3]);} \
      float rm=__builtin_fmaxf(a,b); { auto rr=__builtin_amdgcn_permlane32_swap(__float_as_uint(rm),__float_as_uint(rm),false,false); rm=__builtin_fmaxf(__uint_as_float(rr[0]),__uint_as_float(rr[1])); } \
      resc=false; \
      if(__builtin_expect(__any(rm>(float)THRL),0)){ const float dl=__builtin_fmaxf(rm,0.f); mhat+=dl; \
        _Pragma("unroll") for(int r=0;r<16;++r){C0[r]-=dl;C1[r]-=dl;} \
        _Pragma("unroll") for(int r=0;r<16;++r)negm[r]=-mhat; asm volatile("":"+v"(negm)); \
        const float f=__builtin_amdgcn_exp2f(-dl); l_reg*=f; if(hi==0)wsf[r32]=f; resc=true; } } \
    SBAR(); \
    GAPB(o[0]=__builtin_amdgcn_mfma_f32_32x32x16_bf16(PAF(0),VFR(0),o[0],0,0,0), C0,0); \
    GAPB(o[1]=__builtin_amdgcn_mfma_f32_32x32x16_bf16(PAF(0),VFR(4),o[1],0,0,0), C0,4); \
    KRD(GL,0); GAPB(o[0]=__builtin_amdgcn_mfma_f32_32x32x16_bf16(PAF(1),VFR(1),o[0],0,0,0), C0,8); \
    KRD(GL,1); GAPB(o[1]=__builtin_amdgcn_mfma_f32_32x32x16_bf16(PAF(1),VFR(5),o[1],0,0,0), C0,12); \
    KRD(GL,2); GAPB(o[0]=__builtin_amdgcn_mfma_f32_32x32x16_bf16(PAF(2),VFR(2),o[0],0,0,0), C1,0); \
    KRD(GL,3); GAPB(o[1]=__builtin_amdgcn_mfma_f32_32x32x16_bf16(PAF(2),VFR(6),o[1],0,0,0), C1,4); \
    GAPB(o[0]=__builtin_amdgcn_mfma_f32_32x32x16_bf16(PAF(3),VFR(3),o[0],0,0,0), C1,8); \
    GAPB(o[1]=__builtin_amdgcn_mfma_f32_32x32x16_bf16(PAF(3),VFR(7),o[1],0,0,0), C1,12); \
    }while(0)
  int t=1;
  for(;t+5<NT;t+=2){
    STEP(pB0,pB1,pA0,pA1,t,true,true,true);     WAIT_BAR(2); RESC(); ROT();
    STEP(pA0,pA1,pB0,pB1,t+1,true,true,true);   WAIT_BAR(2); RESC(); ROT();
  }
  #define ENDW(tt) do{ if((tt)+3<NT){WAIT_BAR(2);} else if((tt)+2<NT){WAIT_BAR(1);} else {WAIT_BAR(0);} }while(0)
  for(;t+1<NT;t+=2){
    STEP(pB0,pB1,pA0,pA1,t,(t+3<NT),(t+1<NT),(t+1<NT));       ENDW(t);   RESC(); ROT();
    STEP(pA0,pA1,pB0,pB1,t+1,(t+4<NT),(t+2<NT),(t+2<NT));     ENDW(t+1); RESC(); ROT();
  }
  STEP(pB0,pB1,pA0,pA1,NT-1,false,false,false); RESC();
  { float sacc=pB0[0]+pB0[1]; _Pragma("unroll") for(int r=2;r<16;++r)sacc+=pB0[r]; _Pragma("unroll") for(int r=0;r<16;++r)sacc+=pB1[r]; l_reg+=sacc;
    pw0=(u32x4){PKW(pB0,0),PKW(pB0,2),PKW(pB0,4),PKW(pB0,6)};pw1=(u32x4){PKW(pB0,8),PKW(pB0,10),PKW(pB0,12),PKW(pB0,14)};pw2=(u32x4){PKW(pB1,0),PKW(pB1,2),PKW(pB1,4),PKW(pB1,6)};pw3=(u32x4){PKW(pB1,8),PKW(pB1,10),PKW(pB1,12),PKW(pB1,14)};
    SBAR(); pv(o,vb0+sl_cur,PAF(0),PAF(1),PAF(2),PAF(3)); }
  #undef PKW
  #undef PAF
  #undef VFR
  #undef PIN
  #undef MX3
  #undef GAPA
  #undef GAPB
  #undef EX
  #undef VRD
  #undef KRD
  #undef STEP
  #undef ENDW
  {auto rr=__builtin_amdgcn_permlane32_swap(__float_as_uint(l_reg),__float_as_uint(l_reg),false,false);l_reg=__uint_as_float(rr[0])+__uint_as_float(rr[1]);}
  if(hi==0)wsf[32+r32]=l_reg;asm volatile("s_waitcnt lgkmcnt(0)":::"memory");
  float rli[16];
  #pragma unroll
  for(int r=0;r<16;++r)rli[r]=__builtin_amdgcn_rcpf(wsf[32+crow(r,hi)]);
  {
    #pragma unroll
    for(int d0=0;d0<2;++d0)
      #pragma unroll
      for(int r=0;r<16;++r)o[d0][r]*=rli[r];
    bf16*Ow=J.O+(long)(wid*QBLK)*OP;
    bf16*stg=(bf16*)(shm+LDS_OST)+wid*2048;
    #pragma unroll
    for(int r=0;r<16;++r){const int orow=crow(r,hi);
      #pragma unroll
      for(int d0=0;d0<2;++d0)stg[orow*64+d0*32+r32]=__float2bfloat16(o[d0][r]);}
    asm volatile("s_waitcnt lgkmcnt(0)":::"memory");
    const bool comb=(pass==1);
    #pragma unroll
    for(int i=0;i<4;++i){const int row=i*8+(lane>>3),ch=lane&7; u32x4 v=*(const u32x4*)(stg+row*64+ch*8); bf16*gp=Ow+(long)row*OP+ch*8;
      if(comb){ const u32x4 a=*(const u32x4*)gp; const float lam=J.lam; float s=0.f;
        #pragma unroll
        for(int e=0;e<4;++e){const float x0=__uint_as_float(a[e]<<16)-lam*__uint_as_float(v[e]<<16),x1=__uint_as_float(a[e]&0xffff0000u)-lam*__uint_as_float(v[e]&0xffff0000u);
          const unsigned w=cvtpk_s(x0,x1); v[e]=w; const float y0=__uint_as_float(w<<16),y1=__uint_as_float(w&0xffff0000u); s+=y0*y0+y1*y1;}
        s+=__shfl_xor(s,1); s+=__shfl_xor(s,2); s+=__shfl_xor(s,4);
        if(ch==0)J.ss[(long)(wid*QBLK+row)*J.ssP]=s; }
      ATTN_STORE16(gp,v); }
  }
  asm volatile("s_waitcnt lgkmcnt(0)\n\ts_barrier":::"memory");
  #undef DMA_K
  #undef DMA_V
  #undef CMASK
  #undef START
  #undef RESC
  #undef ROT
}
constexpr int ATTN_LDS_BYTES=LDS_BYTES;
#undef SBAR
#undef WAIT_BAR
}
constexpr int NWAVES = 8;
constexpr int NTOK = 8192, NPROMPT = 4096, DM = 1024, DFF = 2816, NUP = 5632, DEPTH = 4, NPART = 16;
constexpr int KVROWS = 4096 + 2 * 2304;
constexpr float NORM_EPS = 1e-6f;
enum { I_XP = 0, I_XS, I_CKD, I_CVD, I_CKG, I_CVG, I_C, I_CCTX, I_MODW, I_MODB, I_NATT, I_NFFN, I_WQD, I_WOD, I_LAMD, I_SUBLN, I_WQG, I_WOG, I_QNG, I_KNG, I_WUP, I_CONVW, I_CONVB, I_WDN, I_FNORM, N_IN };
constexpr size_t OUT_Y = 0, OUT_NKD = 8388608, OUT_NVD = 16777216, OUT_NKG = 25165824, OUT_NVG = 27262976, OUT_TOTAL = 29360128;
constexpr size_t MiB = 1u << 20;
constexpr size_t WS_CTL = 0, CTL_ZERO_BYTES = 65536;
constexpr size_t WS_TAB = 1 * MiB;
constexpr size_t T_MOD = 0;
constexpr size_t T_GA = T_MOD + 4 * 3 * 6144;
constexpr size_t T_GF = T_GA + 4 * 3 * 1024;
constexpr size_t T_BQD = T_GF + 4 * 3 * 1024;
constexpr size_t T_BQG = T_BQD + 2 * 3 * 3072;
constexpr size_t T_BUP = T_BQG + 2 * 3 * 1536;
constexpr size_t T_ROPE = T_BUP + 4 * 3 * 5632;
constexpr size_t T_LAM = T_ROPE + 64 * 16 * 2;
constexpr size_t T_ROWSS = T_LAM + 64;
constexpr size_t T_SSD = T_ROWSS + (size_t)NPART * NTOK;
constexpr size_t T_MODP = T_SSD + (size_t)NTOK * 16;
constexpr size_t T_END = T_MODP + 8 * 4 * 3 * 6144;
static_assert(T_END * 4 <= 8 * MiB, "tables fit their region");
constexpr size_t WS_W = 16 * MiB;
constexpr size_t W_QD = WS_W, W_OD = W_QD + 2 * 6 * MiB, W_QG = W_OD + 2 * 2 * MiB, W_OG = W_QG + 2 * 3 * MiB, W_UP = W_OG + 2 * 2 * MiB, W_DN = W_UP + 4 * 11 * MiB, W_END = W_DN + 4 * 11 * MiB / 2;
static_assert(W_END == 108 * MiB, "weight map");
constexpr size_t WS_X = 112 * MiB, WS_XG = 144 * MiB, WS_Q = 160 * MiB, WS_O = 176 * MiB, WS_K = 192 * MiB, WS_V = 210 * MiB, WS_U = 228 * MiB, WS_H = 316 * MiB, WS_STASH = 360 * MiB, WS_END = 376 * MiB;
static_assert((size_t)KVROWS * DM * 2 <= 18 * MiB && (size_t)NTOK * NUP * 2 == 88 * MiB && (size_t)NTOK * DFF * 2 == 44 * MiB, "activation map");
constexpr int RING_OFF = 0, RING_BYTES = 131072, LDSCTL_OFF = RING_BYTES, MISC_OFF = LDSCTL_OFF + 320, RSTD_OFF = LDSCTL_OFF + 1024, LDS_BYTES = 147456;

#define GAS __attribute__((address_space(1)))
#define LAS __attribute__((address_space(3)))
typedef unsigned short bf16;
typedef unsigned v4u __attribute__((ext_vector_type(4)));
typedef float f32x4 __attribute__((ext_vector_type(4)));
typedef short bf16x8 __attribute__((ext_vector_type(8)));
typedef GAS unsigned gu32;
typedef GAS unsigned long long gu64;
#define RLX_AGENT __ATOMIC_RELAXED, __HIP_MEMORY_SCOPE_AGENT
#define LDS_WAIT() asm volatile("s_waitcnt lgkmcnt(0)" ::: "memory")
#define VM_WAIT() asm volatile("s_waitcnt vmcnt(0)" ::: "memory")
__device__ __forceinline__ unsigned long long rt() { return __builtin_amdgcn_s_memrealtime(); }
__device__ __forceinline__ unsigned f2bf(float f) { unsigned u = __builtin_bit_cast(unsigned, f); return (u + 0x7fffu + ((u >> 16) & 1u)) >> 16; }
__device__ __forceinline__ unsigned pk2(float lo, float hi) { return f2bf(lo) | (f2bf(hi) << 16); }

#define XB_TMO      128
#define XB_XCNT(j)  (256  + 64 * (j))
#define XB_XSUB(j)  (1280 + 64 * (j))
#define XB_XGEN(j)  (2304 + 64 * (j))
#define XB_TOP      3328
#define XB_TOPGEN   3392
#define XCD_BAR_WORDS 3456
#define XB_SPIN_CAP (1u << 18)

__device__ __forceinline__ unsigned xb_ld(unsigned* p)              { return __hip_atomic_load(p, __ATOMIC_RELAXED, __HIP_MEMORY_SCOPE_AGENT); }
__device__ __forceinline__ unsigned xb_add(unsigned* p, unsigned v) { return __hip_atomic_fetch_add(p, v, __ATOMIC_RELAXED, __HIP_MEMORY_SCOPE_AGENT); }
__device__ __forceinline__ unsigned xb_xcc_id() { return (unsigned)__builtin_amdgcn_s_getreg((3 << 11) | 20) & 0xFu; }
#define XB_SPIN(cond, bar) do { unsigned _sp = 0; while (cond) { __builtin_amdgcn_s_sleep(1); \
    if ((++_sp & 255u) == 0u) { if (xb_ld(&(bar)[XB_TMO])) break; if (_sp > XB_SPIN_CAP) { atomicAdd(&(bar)[XB_TMO], 1u); break; } } } } while (0)

struct XcdBarrier {
    unsigned* bar; unsigned x;
    volatile LAS unsigned* st;
};

__device__ __forceinline__ XcdBarrier xcd_barrier_post(unsigned* bar, volatile LAS unsigned* st) {
    XcdBarrier b; b.bar = bar; b.x = xb_xcc_id(); b.st = st;
    if (threadIdx.x == 0) (void)xb_add(&bar[XB_XCNT(b.x)], 1u);
    return b;
}
__device__ __forceinline__ void xcd_barrier_complete(unsigned* bar, unsigned x, unsigned& nloc, unsigned& nx) {
    const unsigned G = gridDim.x * gridDim.y * gridDim.z;
    unsigned sum, cnt, mine, sp = 0u;
    for (;;) {
        sum = 0u; cnt = 0u; mine = 0u;
#pragma unroll
        for (unsigned j = 0; j < 16; ++j) { const unsigned c = xb_ld(&bar[XB_XCNT(j)]); sum += c; cnt += (c > 0u) ? 1u : 0u; mine = (j == x) ? c : mine; }
        if (sum == G) break;
        __builtin_amdgcn_s_sleep(1);
        if ((++sp & 255u) == 0u) { if (xb_ld(&bar[XB_TMO])) break; if (sp > XB_SPIN_CAP) { atomicAdd(&bar[XB_TMO], 1u); break; } }
    }
    nloc = mine > 0u ? mine : 1u; nx = cnt > 0u ? cnt : 1u;
}

__device__ __forceinline__ void xcd_barrier(const XcdBarrier& b) {
    asm volatile("s_waitcnt vmcnt(0)" ::: "memory");
    __syncthreads();
    if (threadIdx.x == 0) {
        unsigned* bar = b.bar;
        __builtin_amdgcn_s_waitcnt(0);
        unsigned nloc = b.st[0], nx = b.st[1];
        if (nloc == 0u) { xcd_barrier_complete(bar, b.x, nloc, nx); b.st[0] = nloc; b.st[1] = nx; }
        const unsigned old = xb_add(&bar[XB_XSUB(b.x)], 1u);
        const unsigned gen = old / nloc;
        if (old + 1u == (gen + 1u) * nloc) {
            __builtin_amdgcn_fence(__ATOMIC_RELEASE, "agent");
            asm volatile("s_waitcnt vmcnt(0)" ::: "memory");
            const unsigned og = xb_add(&bar[XB_TOP], 1u);
            const unsigned tg = og / nx;
            if (og + 1u == (tg + 1u) * nx) xb_add(&bar[XB_TOPGEN], 1u);
            else XB_SPIN(xb_ld(&bar[XB_TOPGEN]) == tg, bar);
            __builtin_amdgcn_fence(__ATOMIC_ACQUIRE, "agent");
            xb_add(&bar[XB_XGEN(b.x)], 1u);
            asm volatile("s_waitcnt vmcnt(0)" ::: "memory");
        } else {
            XB_SPIN(xb_ld(&bar[XB_XGEN(b.x)]) == gen, bar);
            __builtin_amdgcn_fence(__ATOMIC_ACQUIRE, "agent");
            asm volatile("s_waitcnt vmcnt(0)" ::: "memory");
        }
    }
    __syncthreads();
}

typedef unsigned u32x2v __attribute__((ext_vector_type(2)));
__device__ __forceinline__ float wave_sum(float v) {
#pragma unroll
    for (int o = 1; o < 64; o <<= 1) v += __shfl_xor(v, o);
    return v;
}
__device__ __forceinline__ float bf_lo(unsigned w) { return __uint_as_float(w << 16); }
__device__ __forceinline__ float bf_hi(unsigned w) { return __uint_as_float(w & 0xffff0000u); }
__device__ __forceinline__ float silu_f(float x) { return x / (1.0f + __expf(-x)); }

__device__ __forceinline__ void p0_transpose_item(const float* W, int K, int N, bf16* WT, int k0, int n0, int prow0, LAS float* scr, int lane) {
#pragma unroll 8
    for (int i = 0; i < 32; ++i) { const int kk = 2 * i + (lane >> 5); scr[kk * 33 + (lane & 31)] = W[(size_t)(k0 + kk) * N + n0 + (lane & 31)]; }
    LDS_WAIT(); asm volatile("" ::: "memory");
    const int c = lane & 7;
#pragma unroll
    for (int j = 0; j < 4; ++j) { const int n = (lane >> 3) + 8 * j; const LAS float* s = scr + (8 * c) * 33 + n;
        v4u o; o.x = pk2(s[0 * 33], s[1 * 33]); o.y = pk2(s[2 * 33], s[3 * 33]); o.z = pk2(s[4 * 33], s[5 * 33]); o.w = pk2(s[6 * 33], s[7 * 33]);
        *(GAS v4u*)(WT + (size_t)(prow0 + n) * K + k0 + 8 * c) = o; }
    LDS_WAIT(); asm volatile("" ::: "memory");
}
__device__ __forceinline__ int phys_gqa(int n0) { const int w = n0 & 255; return (n0 & ~255) + 128 * ((w & 63) >> 5) + 32 * (w >> 6); }
__device__ __forceinline__ int phys_up(int n0) { return n0 < DFF ? 256 * (n0 >> 7) + (n0 & 127) : 256 * ((n0 - DFF) >> 7) + 128 + ((n0 - DFF) & 127); }

#ifndef PH_MASK
#define PH_MASK 0xfff
#endif
#define PH_EN(b) ((PH_MASK >> (b)) & 1)

#define FILL_RSTD(S) do { pg8::Unit uu_; for (int i_ = 0; i_ < 8 && (S).next(i_, uu_); ++i_) { if (tid < 256) { float s_ = 0.f; _Pragma("unroll") for (int p_ = 0; p_ < NPART; ++p_) s_ += rowss[p_ * NTOK + uu_.pm * 256 + tid]; \
        ((LAS float*)(L + RSTD_OFF))[i_ * 256 + tid] = __builtin_amdgcn_rsqf(s_ * (1.0f / DM) + NORM_EPS); } } __syncthreads(); } while (0)
struct Args { const float* in[N_IN]; float* out; unsigned char* ws; int ph_lo, ph_hi; };
static_assert(sizeof(Args) == (N_IN + 2) * 8 + 8, "Args has no padding");

constexpr int PH_LAYER0 = 3, PH_PER_LAYER = 7, PH_FINAL = PH_LAYER0 + DEPTH * PH_PER_LAYER, N_PHASES = PH_FINAL + 1;

__global__ void __launch_bounds__(NWAVES * 64, 2) skel_fwd(Args args) {
    extern __shared__ __attribute__((aligned(16))) unsigned char lds[];
    LAS unsigned char* const L = (LAS unsigned char*)lds;
    volatile LAS unsigned* const MISC = (volatile LAS unsigned*)(L + MISC_OFF);
    const int tid0 = threadIdx.x;
    const int G = gridDim.x; const int vcu = (G % 8 == 0) ? ((int)blockIdx.x % 8) * (G / 8) + (int)blockIdx.x / 8 : (int)blockIdx.x;
    const int NGW = G * NWAVES, NGT = G * NWAVES * 64;
    gu32* const ctl = (gu32*)(args.ws + WS_CTL);
    for (int u = tid0; u < (LDS_BYTES - LDSCTL_OFF) / 4; u += NWAVES * 64) ((LAS unsigned*)(L + LDSCTL_OFF))[u] = 0u;
    __syncthreads();
    const bool single = (args.ph_hi - args.ph_lo) > 1;
    XcdBarrier bar; bar.bar = (unsigned*)(ctl + 1024); bar.x = 0; bar.st = nullptr;
    if (single) bar = xcd_barrier_post((unsigned*)(ctl + 1024), MISC + 8);

    for (int ph = args.ph_lo; ph < args.ph_hi; ++ph) {
        int tid = threadIdx.x; asm volatile("" : "+v"(tid));
        unsigned char* ws = args.ws; asm volatile("" : "+s"(ws));
        const int lane = tid & 63, wave = __builtin_amdgcn_readfirstlane(tid >> 6);
        const int gw = vcu * NWAVES + wave, gt = vcu * (NWAVES * 64) + tid;
        float* const TAB = (float*)(ws + WS_TAB);
        float* const X = (float*)(ws + WS_X); bf16* const XG = (bf16*)(ws + WS_XG); bf16* const Qb = (bf16*)(ws + WS_Q); bf16* const Ob = (bf16*)(ws + WS_O);
        bf16* const Kb = (bf16*)(ws + WS_K); bf16* const Vb = (bf16*)(ws + WS_V); bf16* const Ub = (bf16*)(ws + WS_U); bf16* const Hb = (bf16*)(ws + WS_H);
        float* const rowss = TAB + T_ROWSS; float* const ssd = TAB + T_SSD;
        if (ph == 0) { if (PH_EN(0)) {
            LAS float* scr = (LAS float*)(L + RING_OFF + wave * 16384);
            constexpr int IQD = 16 * 96, IOD = 16 * 32, IQG = 16 * 48, IUP = 16 * 176, IDN = 44 * 32;
            constexpr int NITEMS = 2 * IQD + 2 * IOD + 2 * IQG + 2 * IOD + 4 * IUP + 4 * IDN;
            for (int it = gw; it < NITEMS; it += NGW) {
                int r = it;
                if (r < 2 * IQD) { const int j = r / IQD; r -= j * IQD; const int kb = r / 96, nb = r % 96;
                    p0_transpose_item(args.in[I_WQD] + (size_t)j * DM * 3072, DM, 3072, (bf16*)(ws + W_QD) + (size_t)j * 3072 * DM, 64 * kb, 32 * nb, 32 * nb, scr, lane); continue; } r -= 2 * IQD;
                if (r < 2 * IOD) { const int j = r / IOD; r -= j * IOD; const int kb = r / 32, nb = r % 32;
                    p0_transpose_item(args.in[I_WOD] + (size_t)j * DM * DM, DM, DM, (bf16*)(ws + W_OD) + (size_t)j * DM * DM, 64 * kb, 32 * nb, 32 * nb, scr, lane); continue; } r -= 2 * IOD;
                if (r < 2 * IQG) { const int j = r / IQG; r -= j * IQG; const int kb = r / 48, nb = r % 48;
                    p0_transpose_item(args.in[I_WQG] + (size_t)j * DM * 1536, DM, 1536, (bf16*)(ws + W_QG) + (size_t)j * 1536 * DM, 64 * kb, 32 * nb, phys_gqa(32 * nb), scr, lane); continue; } r -= 2 * IQG;
                if (r < 2 * IOD) { const int j = r / IOD; r -= j * IOD; const int kb = r / 32, nb = r % 32;
                    p0_transpose_item(args.in[I_WOG] + (size_t)j * DM * DM, DM, DM, (bf16*)(ws + W_OG) + (size_t)j * DM * DM, 64 * kb, 32 * nb, 32 * nb, scr, lane); continue; } r -= 2 * IOD;
                if (r < 4 * IUP) { const int l = r / IUP; r -= l * IUP; const int kb = r / 176, nb = r % 176;
                    p0_transpose_item(args.in[I_WUP] + (size_t)l * DM * NUP, DM, NUP, (bf16*)(ws + W_UP) + (size_t)l * NUP * DM, 64 * kb, 32 * nb, phys_up(32 * nb), scr, lane); continue; } r -= 4 * IUP;
                { const int l = r / IDN; r -= l * IDN; const int kb = r / 32, nb = r % 32;
                    p0_transpose_item(args.in[I_WDN] + (size_t)l * DFF * DM, DFF, DM, (bf16*)(ws + W_DN) + (size_t)l * DM * DFF, 64 * kb, 32 * nb, 32 * nb, scr, lane); }
            }
            for (int it = gw; it < 4 * 24 * 8; it += NGW) {
                const int kc = it & 7, nb = (it >> 3) % 24, l = it / (8 * 24);
                float sv[3][2];
#pragma unroll
                for (int h = 0; h < 2; ++h) { const int k = kc * 128 + h * 64 + lane;
                    sv[0][h] = silu_f(args.in[I_CCTX][k]); sv[1][h] = silu_f(args.in[I_C][k]); sv[2][h] = silu_f(args.in[I_C][DM + k]); }
                f32x4 a0 = {0.f, 0.f, 0.f, 0.f}, a1 = a0, a2 = a0;
                const float* wp = args.in[I_MODW] + ((size_t)l * DM + kc * 128) * 6144 + nb * 256 + lane * 4;
#pragma unroll
                for (int h = 0; h < 2; ++h)
#pragma unroll 8
                    for (int kk = 0; kk < 64; ++kk) { const f32x4 w = *(const f32x4*)(wp + (size_t)(h * 64 + kk) * 6144);
                        const float s0 = __shfl(sv[0][h], kk), s1 = __shfl(sv[1][h], kk), s2 = __shfl(sv[2][h], kk);
                        a0 += w * s0; a1 += w * s1; a2 += w * s2; }
                float* pp = TAB + T_MODP + ((size_t)(kc * 4 + l) * 3) * 6144 + nb * 256 + lane * 4;
                *(f32x4*)pp = a0; *(f32x4*)(pp + 6144) = a1; *(f32x4*)(pp + 2 * 6144) = a2;
            }
            for (int e = gt; e < 64 * 16; e += NGT) { const int pos = e >> 4, i = e & 15; const float inv = powf(10000.0f, -(float)i * (1.0f / 16.0f)); const float ang = (float)pos * inv;
                TAB[T_ROPE + 2 * e] = cosf(ang); TAB[T_ROPE + 2 * e + 1] = sinf(ang); }
            if (gw < 2) { const float* lp = args.in[I_LAMD] + gw * 256; const float a = wave_sum(lp[lane] * lp[64 + lane]), b = wave_sum(lp[128 + lane] * lp[192 + lane]);
                const float lam_init = 0.8f - 0.6f * expf(-0.3f * (float)(2 * gw)); if (lane == 0) TAB[T_LAM + gw] = expf(a) - expf(b) + lam_init; }
        } } else if (ph == 1) { if (PH_EN(1)) {
            for (int e = gt; e < 4 * 3 * 6144; e += NGT) { const int n = e % 6144, lv = e / 6144, l = lv / 3;
                float s = args.in[I_MODB][l * 6144 + n];
#pragma unroll
                for (int kc = 0; kc < 8; ++kc) s += TAB[T_MODP + (size_t)kc * (4 * 3 * 6144) + e];
                TAB[T_MOD + e] = s;
                if (n >= 1024 && n < 2048) TAB[T_GA + lv * 1024 + (n - 1024)] = args.in[I_NATT][l * 1024 + (n - 1024)] * (1.0f + s);
                if (n >= 4096 && n < 5120) TAB[T_GF + lv * 1024 + (n - 4096)] = args.in[I_NFFN][l * 1024 + (n - 4096)] * (1.0f + s); }
        } } else if (ph == 2) { if (PH_EN(2)) {
            for (int mat = 0; mat < 8; ++mat) {
                const int kind = mat < 2 ? 0 : (mat < 4 ? 1 : 2), idx = mat < 2 ? mat : (mat < 4 ? mat - 2 : mat - 4);
                const int nrows = kind == 0 ? 3072 : (kind == 1 ? 1536 : NUP), l = kind == 0 ? 2 * idx : (kind == 1 ? 2 * idx + 1 : idx);
                const bf16* WT = kind == 0 ? (const bf16*)(ws + W_QD) + (size_t)idx * 3072 * DM : (kind == 1 ? (const bf16*)(ws + W_QG) + (size_t)idx * 1536 * DM : (const bf16*)(ws + W_UP) + (size_t)idx * NUP * DM);
                float* outb = TAB + (kind == 0 ? T_BQD + (size_t)idx * 3 * 3072 : (kind == 1 ? T_BQG + (size_t)idx * 3 * 1536 : T_BUP + (size_t)idx * 3 * NUP));
                const float* sh = TAB + T_MOD + (size_t)l * 3 * 6144 + (kind == 2 ? 3072 : 0) + lane * 16;
                f32x4 s[3][4];
#pragma unroll
                for (int v = 0; v < 3; ++v)
#pragma unroll
                    for (int q = 0; q < 4; ++q) s[v][q] = *(const f32x4*)(sh + v * 6144 + 4 * q);
                for (int p = gw; p < nrows; p += NGW) {
                    const v4u w0 = *(const GAS v4u*)(WT + (size_t)p * DM + lane * 16), w1 = *(const GAS v4u*)(WT + (size_t)p * DM + lane * 16 + 8);
                    float wf[16];
#pragma unroll
                    for (int q = 0; q < 4; ++q) { wf[2 * q] = bf_lo(w0[q]); wf[2 * q + 1] = bf_hi(w0[q]); wf[8 + 2 * q] = bf_lo(w1[q]); wf[8 + 2 * q + 1] = bf_hi(w1[q]); }
                    float d[3];
#pragma unroll
                    for (int v = 0; v < 3; ++v) { float a = 0.f;
#pragma unroll
                        for (int q = 0; q < 4; ++q) a += (s[v][q][0] * wf[4 * q] + s[v][q][1] * wf[4 * q + 1]) + (s[v][q][2] * wf[4 * q + 2] + s[v][q][3] * wf[4 * q + 3]);
                        d[v] = wave_sum(a); }
                    if (lane == 0) { outb[p] = d[0]; outb[nrows + p] = d[1]; outb[2 * nrows + p] = d[2]; }
                }
            }
            for (int m = gw; m < NTOK; m += NGW) {
                const float* xr = (m < NPROMPT ? args.in[I_XP] + (size_t)m * DM : args.in[I_XS] + (size_t)(m - NPROMPT) * DM);
                const int v = m < NPROMPT ? 0 : 1 + ((m - NPROMPT) >> 11);
                const float* ga = TAB + T_GA + v * 1024; float ss = 0.f;
#pragma unroll
                for (int j = 0; j < 4; ++j) { const f32x4 x = *(const GAS f32x4*)(xr + 256 * j + 4 * lane), g = *(const f32x4*)(ga + 256 * j + 4 * lane);
                    *(GAS f32x4*)(X + (size_t)m * DM + 256 * j + 4 * lane) = x; ss += (x[0] * x[0] + x[1] * x[1]) + (x[2] * x[2] + x[3] * x[3]);
                    u32x2v w; w.x = pk2(x[0] * g[0], x[1] * g[1]); w.y = pk2(x[2] * g[2], x[3] * g[3]); *(GAS u32x2v*)(XG + (size_t)m * DM + 256 * j + 4 * lane) = w; }
                ss = wave_sum(ss);
                if (lane < NPART) rowss[lane * NTOK + m] = lane == 0 ? ss : 0.f;
            }
        } } else if (ph < PH_FINAL) {
            const int l = (ph - PH_LAYER0) / PH_PER_LAYER, sub = (ph - PH_LAYER0) % PH_PER_LAYER, j = l >> 1; const bool diff = (l & 1) == 0;
            if (sub == 0) {
                if (diff) { if (PH_EN(3)) {
                    for (int e = gt; e < 2 * 8 * 256 * 32; e += NGT) { const int d4 = e & 31, p = (e >> 5) & 255, h = (e >> 13) & 7, b = e >> 16;
                        const size_t src = ((((size_t)b * 2 + j) * 8 + h) * 256 + p) * 128 + d4 * 4, dst = ((size_t)(4096 + b * 2304 + p)) * DM + h * 128 + d4 * 4;
                        const f32x4 k = *(const GAS f32x4*)(args.in[I_CKD] + src), vv = *(const GAS f32x4*)(args.in[I_CVD] + src);
                        u32x2v w; w.x = pk2(k[0], k[1]); w.y = pk2(k[2], k[3]); *(GAS u32x2v*)(Kb + dst) = w; w.x = pk2(vv[0], vv[1]); w.y = pk2(vv[2], vv[3]); *(GAS u32x2v*)(Vb + dst) = w; }
                    pg8::Gemm g{XG, (const bf16*)(ws + W_QD) + (size_t)j * 3072 * DM, NTOK, 3072, DM}; pg8::StaticOrder S; S.init(NTOK, 3072, G, (int)blockIdx.x);
                    FILL_RSTD(S);
                    pg8::EpiQkvDiff E{Qb, Kb, Vb, TAB + T_BQD + (size_t)j * 3 * 3072, (const LAS float*)(L + RSTD_OFF), TAB + T_ROPE, args.out + OUT_NKD + (size_t)j * 8 * 256 * 128, args.out + OUT_NVD + (size_t)j * 8 * 256 * 128};
                    pg8::gemm_phase<pg8::EpiQkvDiff, pg8::StaticOrder, true, true>(L + RING_OFF, g, S, E);
                } } else if (PH_EN(4)) {
                    for (int e = gt; e < 2 * 4 * 256 * 16; e += NGT) { const int d4 = e & 15, p = (e >> 4) & 255, h = (e >> 12) & 3, b = e >> 14;
                        const size_t src = ((((size_t)b * 2 + j) * 4 + h) * 256 + p) * 64 + d4 * 4, dst = ((size_t)(4096 + b * 2304 + p)) * 256 + h * 64 + d4 * 4;
                        const f32x4 k = *(const GAS f32x4*)(args.in[I_CKG] + src), vv = *(const GAS f32x4*)(args.in[I_CVG] + src);
                        u32x2v w; w.x = pk2(k[0], k[1]); w.y = pk2(k[2], k[3]); *(GAS u32x2v*)(Kb + dst) = w; w.x = pk2(vv[0], vv[1]); w.y = pk2(vv[2], vv[3]); *(GAS u32x2v*)(Vb + dst) = w; }
                    pg8::Gemm g{XG, (const bf16*)(ws + W_QG) + (size_t)j * 1536 * DM, NTOK, 1536, DM}; pg8::StaticOrder S; S.init(NTOK, 1536, G, (int)blockIdx.x);
                    FILL_RSTD(S);
                    pg8::EpiQkvGqa E{Qb, Kb, Vb, TAB + T_BQG + (size_t)j * 3 * 1536, (const LAS float*)(L + RSTD_OFF), TAB + T_ROPE, args.in[I_QNG] + j * 64, args.in[I_KNG] + j * 64,
                                     args.out + OUT_NKG + (size_t)j * 4 * 256 * 64, args.out + OUT_NVG + (size_t)j * 4 * 256 * 64};
                    pg8::gemm_phase<pg8::EpiQkvGqa, pg8::StaticOrder, true, true>(L + RING_OFF, g, S, E);
                }
            } else if (sub == 1) { if (PH_EN(5)) {
                const int npass = diff ? 2 : 1;
                for (int sidx = 0;; ++sidx) { const int u = vcu + (diff ? (sidx >> 1) : sidx) * G, pass = diff ? (sidx & 1) : 0; if (u >= 512) break;
                    attn_body::AttnJob J; const bool lat = u < 256; const int uu = u & 255; int m0, k0, hq;
                    if (diff) { int b, h, vh; if (lat) { b = uu >> 7; h = (uu >> 4) & 7; const int qb = (uu >> 1) & 7; vh = uu & 1; m0 = NPROMPT + b * 2048 + qb * 256; k0 = NPROMPT + b * 2304; }
                                else { b = uu >> 4; h = (uu >> 1) & 7; vh = uu & 1; m0 = b * 256; k0 = m0; }
                        J.Q = (const attn_body::bf16*)Qb + (size_t)m0 * DM + h * 128; J.QP = DM; J.K = (const attn_body::bf16*)Kb + (size_t)k0 * DM + h * 128; J.KP = DM;
                        J.V = (const attn_body::bf16*)Vb + (size_t)k0 * DM + h * 128 + vh * 64; J.VP = DM; J.O = (attn_body::bf16*)Ob + (size_t)m0 * DM + h * 128 + vh * 64; J.OP = DM;
                        J.npass = npass; J.lam = TAB[T_LAM + j]; J.ss = ssd + ((size_t)m0 * 8 + h) * 2 + vh; J.ssP = 16; hq = 0; }
                    else { int b; if (lat) { b = uu >> 7; hq = (uu >> 3) & 15; const int qb = uu & 7; m0 = NPROMPT + b * 2048 + qb * 256; k0 = NPROMPT + b * 2304; } else { b = uu >> 4; hq = uu & 15; m0 = b * 256; k0 = m0; }
                        J.Q = (const attn_body::bf16*)Qb + (size_t)m0 * DM + hq * 64; J.QP = DM; J.K = (const attn_body::bf16*)Kb + (size_t)k0 * 256 + (hq >> 2) * 64; J.KP = 256;
                        J.V = (const attn_body::bf16*)Vb + (size_t)k0 * 256 + (hq >> 2) * 64; J.VP = 256; J.O = (attn_body::bf16*)Ob + (size_t)m0 * DM + hq * 64; J.OP = DM;
                        J.npass = npass; J.lam = 0.f; J.ss = nullptr; J.ssP = 0; }
                    J.NT = lat ? 36 : 4;
                    attn_body::attn_unit<8>(J, pass, (char*)lds + RING_OFF);
                }
            } } else if (sub == 2) { if (PH_EN(6)) {
                if (diff) {
                    const float oml = 1.0f - (0.8f - 0.6f * expf(-0.3f * (float)l));
                    const float* sw = args.in[I_SUBLN] + j * 128 + (lane & 7) * 16; f32x4 w4[4];
#pragma unroll
                    for (int q = 0; q < 4; ++q) w4[q] = *(const f32x4*)(sw + 4 * q) * oml;
                    for (int m = gw; m < NTOK; m += NGW) { const int h = lane >> 3; const float rs = __builtin_amdgcn_rsqf((ssd[(m * 8 + h) * 2] + ssd[(m * 8 + h) * 2 + 1]) * (1.0f / 128.0f) + NORM_EPS);
                        GAS v4u* p = (GAS v4u*)(Ob + (size_t)m * DM + lane * 16); v4u a = p[0], b = p[1];
#pragma unroll
                        for (int q = 0; q < 4; ++q) { const int e = 2 * q; a[q] = pk2(bf_lo(a[q]) * rs * w4[e >> 2][e & 3], bf_hi(a[q]) * rs * w4[(e + 1) >> 2][(e + 1) & 3]);
                            b[q] = pk2(bf_lo(b[q]) * rs * w4[2 + (e >> 2)][e & 3], bf_hi(b[q]) * rs * w4[2 + ((e + 1) >> 2)][(e + 1) & 3]); }
                        p[0] = a; p[1] = b; }
                }
            } } else if (sub == 3) { if (PH_EN(7)) {
                pg8::Gemm g{Ob, (const bf16*)(ws + (diff ? W_OD : W_OG)) + (size_t)j * DM * DM, NTOK, DM, DM}; pg8::StaticOrder S; S.init(NTOK, DM, G, (int)blockIdx.x);
                pg8::EpiResid E{X, XG, TAB + T_MOD + (size_t)l * 3 * 6144 + 2048, 6144, TAB + T_GF + (size_t)l * 3 * 1024, rowss};
                pg8::gemm_phase<pg8::EpiResid, pg8::StaticOrder, true, true>(L + RING_OFF, g, S, E);
            } } else if (sub == 4) { if (PH_EN(8)) {
                pg8::Gemm g{XG, (const bf16*)(ws + W_UP) + (size_t)l * NUP * DM, NTOK, NUP, DM}; pg8::StaticOrder S; S.init(NTOK, NUP, G, (int)blockIdx.x);
                FILL_RSTD(S);
                pg8::EpiUp E{Ub, NUP, TAB + T_BUP + (size_t)l * 3 * NUP, (const LAS float*)(L + RSTD_OFF)};
                pg8::gemm_phase<pg8::EpiUp, pg8::StaticOrder, true, true>(L + RING_OFF, g, S, E);
            } } else if (sub == 5) { if (PH_EN(9)) {
                for (int it = vcu; it < (NTOK / 64) * 22; it += G) { const int pn = it % 22, rb = it / 22; const int c = tid & 15, rg = tid >> 4;
                    const int m0 = rb * 64 + 2 * rg; const int seqlen = m0 < NPROMPT ? 256 : 2048; const int t0 = (m0 < NPROMPT ? m0 : m0 - NPROMPT) % seqlen;
                    const float* cw = args.in[I_CONVW] + (size_t)l * 3 * NUP; const float* cb = args.in[I_CONVB] + (size_t)l * NUP; const int lg = pn * 128 + c * 8, lv = DFF + lg;
                    float wg[3][8], wv[3][8], bg[8], bvv[8];
#pragma unroll
                    for (int t = 0; t < 3; ++t)
#pragma unroll
                        for (int e = 0; e < 8; ++e) { wg[t][e] = cw[t * NUP + lg + e]; wv[t][e] = cw[t * NUP + lv + e]; }
#pragma unroll
                    for (int e = 0; e < 8; ++e) { bg[e] = cb[lg + e]; bvv[e] = cb[lv + e]; }
                    v4u ug[4], uv[4];
#pragma unroll
                    for (int r = 0; r < 4; ++r) { const int t = t0 - 1 + r; const bool ok = t >= 0 && t < seqlen; const bf16* up = Ub + (size_t)(m0 - 1 + r) * NUP + pn * 256 + c * 8;
                        ug[r] = ok ? *(const GAS v4u*)up : (v4u){0u, 0u, 0u, 0u}; uv[r] = ok ? *(const GAS v4u*)(up + 128) : (v4u){0u, 0u, 0u, 0u}; }
#pragma unroll
                    for (int r = 0; r < 2; ++r) { v4u o;
#pragma unroll
                        for (int q = 0; q < 4; ++q) { float hv[2];
#pragma unroll
                            for (int s = 0; s < 2; ++s) { const int e = 2 * q + s;
                                const float g0 = s ? bf_hi(ug[r][q]) : bf_lo(ug[r][q]), g1 = s ? bf_hi(ug[r + 1][q]) : bf_lo(ug[r + 1][q]), g2 = s ? bf_hi(ug[r + 2][q]) : bf_lo(ug[r + 2][q]);
                                const float v0 = s ? bf_hi(uv[r][q]) : bf_lo(uv[r][q]), v1 = s ? bf_hi(uv[r + 1][q]) : bf_lo(uv[r + 1][q]), v2 = s ? bf_hi(uv[r + 2][q]) : bf_lo(uv[r + 2][q]);
                                const float gg = g0 * wg[0][e] + g1 * wg[1][e] + g2 * wg[2][e] + bg[e], vv = v0 * wv[0][e] + v1 * wv[1][e] + v2 * wv[2][e] + bvv[e];
                                hv[s] = silu_f(gg) * vv; }
                            o[q] = pk2(hv[0], hv[1]); }
                        *(GAS v4u*)(Hb + (size_t)(m0 + r) * DFF + lg) = o; }
                }
            } } else { if (PH_EN(10)) {
                pg8::Gemm g{Hb, (const bf16*)(ws + W_DN) + (size_t)l * DM * DFF, NTOK, DM, DFF}; pg8::StaticOrder S; S.init(NTOK, DM, G, (int)blockIdx.x);
                pg8::EpiResid E{X, XG, TAB + T_MOD + (size_t)l * 3 * 6144 + 5120, 6144, l + 1 < DEPTH ? TAB + T_GA + (size_t)(l + 1) * 3 * 1024 : nullptr, rowss};
                pg8::gemm_phase<pg8::EpiResid, pg8::StaticOrder, true, true>(L + RING_OFF, g, S, E);
            } }
        } else { if (PH_EN(11)) {
            for (int m = gw; m < NTOK; m += NGW) { float s = 0.f; if (lane < NPART) s = rowss[lane * NTOK + m]; s = wave_sum(s); const float rs = __builtin_amdgcn_rsqf(s * (1.0f / DM) + NORM_EPS);
#pragma unroll
                for (int jj = 0; jj < 4; ++jj) { const f32x4 x = *(const GAS f32x4*)(X + (size_t)m * DM + 256 * jj + 4 * lane), w = *(const f32x4*)(args.in[I_FNORM] + 256 * jj + 4 * lane);
                    *(GAS f32x4*)(args.out + OUT_Y + (size_t)m * DM + 256 * jj + 4 * lane) = x * rs * w; } }
        } }
        if (ph + 1 < args.ph_hi) xcd_barrier(bar);
    }
}
#ifndef MK_MULTI
#define MK_MULTI 0
#endif
extern "C" void kernel_launch(void* const* d_in, const int* in_sizes, int n_in, void* d_out, int out_size, void* d_ws, size_t ws_size, hipStream_t stream) {
    static int grid = 0;
    if (grid == 0) {
        if (n_in != N_IN || out_size != (int)OUT_TOTAL || ws_size < WS_END) { fprintf(stderr, "kernel_launch: unexpected problem: n_in %d out %d ws %zu (need %zu)\n", n_in, out_size, ws_size, (size_t)WS_END); grid = -1; return; }
        int dev = 0, cus = 0, per_cu = 0;
        if (hipGetDevice(&dev) != hipSuccess || hipDeviceGetAttribute(&cus, hipDeviceAttributeMultiprocessorCount, dev) != hipSuccess) { grid = -1; return; }
        if (hipFuncSetAttribute((const void*)skel_fwd, hipFuncAttributeMaxDynamicSharedMemorySize, LDS_BYTES) != hipSuccess) { fprintf(stderr, "kernel_launch: hipFuncSetAttribute failed\n"); grid = -1; return; }
        if (hipOccupancyMaxActiveBlocksPerMultiprocessor(&per_cu, (const void*)skel_fwd, NWAVES * 64, LDS_BYTES) != hipSuccess || per_cu < 1) { fprintf(stderr, "kernel_launch: occupancy query says %d\n", per_cu); per_cu = 1; }
        (void)hipGetLastError();
        grid = cus;
        if (grid % 8 != 0) grid -= grid % 8;
    }
    if (grid < 0) return;
    (void)hipMemsetAsync((char*)d_ws + WS_CTL, 0, CTL_ZERO_BYTES, stream);
    Args a{};
    for (int i = 0; i < N_IN; ++i) a.in[i] = (const float*)d_in[i];
    a.out = (float*)d_out; a.ws = (unsigned char*)d_ws;
#if MK_MULTI
    for (int ph = 0; ph < N_PHASES; ++ph) {
        if (ph >= PH_LAYER0 && ph < PH_FINAL && ((ph - PH_LAYER0) % PH_PER_LAYER) == 2 && (((ph - PH_LAYER0) / PH_PER_LAYER) & 1)) continue;
        a.ph_lo = ph; a.ph_hi = ph + 1;
        hipLaunchKernelGGL(skel_fwd, dim3(grid), dim3(NWAVES * 64), LDS_BYTES, stream, a);
    }
#else
    a.ph_lo = 0; a.ph_hi = N_PHASES;
    hipLaunchKernelGGL(skel_fwd, dim3(grid), dim3(NWAVES * 64), LDS_BYTES, stream, a);
#endif
    const hipError_t le = hipPeekAtLastError();
    if (le != hipSuccess) fprintf(stderr, "kernel_launch: launch failed: %s\n", hipGetErrorName(le));
}
```

```cpp
#include <hip/hip_runtime.h>
#include <hip/hip_bf16.h>
#include <cstdio>
#include <cstdint>
#include <cmath>
#define MK_MULTI 0
__device__ __forceinline__ int lane_id_opaque() { unsigned m_ = ~0u; asm volatile("" : "+s"(m_)); return (int)__builtin_amdgcn_mbcnt_hi(m_, __builtin_amdgcn_mbcnt_lo(m_, 0u)); }
namespace pg8 {
#define PG8_LAS __attribute__((address_space(3)))
typedef unsigned short bf16_t;
typedef short bf16x8 __attribute__((ext_vector_type(8)));
typedef float f32x4 __attribute__((ext_vector_type(4)));
typedef unsigned u32x4 __attribute__((ext_vector_type(4)));
constexpr int BM = 256, BK = 64, HALF = 128, HTB = HALF * BK * 2  , STAGE_BYTES = 8 * HTB, NXCD = 8, WGM = 8;

__host__ __device__ __forceinline__ int lds_byte(int r, int c) { const int st = (r >> 4) * 2 + (c >> 5), rr = r & 15, cc = c & 31, ob = rr * 64 + cc * 2; return st * 1024 + (ob ^ (((ob >> 9) & 1) << 5)); }
__host__ __device__ __forceinline__ void stage_rc(int b, int& R, int& C) { const int st = b / 1024, sb = b % 1024, swz = sb ^ (((sb >> 9) & 1) << 5); R = (st >> 1) * 16 + swz / 64; C = (st & 1) * 32 + (swz % 64) / 2; }
__host__ __device__ __forceinline__ int perm32(int rho) { const int n = rho >> 4, i = rho & 15; return 8 * (i >> 2) + 4 * n + (i & 3); }

struct Unit { int pm, pn, idx; };
struct Gemm { const bf16_t* A; const bf16_t* Bt; int M, N, K; };

struct StaticOrder {
    int nM, nN, nwg, G, c;
    __host__ __device__ void init(int M, int N, int G_, int c_, int bn = BM) { nM = M / BM; nN = N / bn; nwg = nM * nN; G = G_; c = c_; }
    __host__ __device__ bool next(int i, Unit& u) const {
        const long L = (long)i * G + c; if (L >= nwg) return false;
        int wgid = (int)L; { const int q = nwg / NXCD, r = nwg % NXCD, xcd = wgid % NXCD, off = wgid / NXCD; wgid = (xcd < r ? xcd * (q + 1) : r * (q + 1) + (xcd - r) * q) + off; }
        const int nig = WGM * nN, gid = wgid / nig, fm = gid * WGM, gsz = (nM - fm) < WGM ? (nM - fm) : WGM;
        u.pm = fm + ((wgid % nig) % gsz); u.pn = (wgid % nig) / gsz; u.idx = i; return true;
    }
    __device__ __forceinline__ void a_ready(const Unit&) const {}
    __device__ __forceinline__ void done(const Unit&) const {}
};

struct DiffQkvOrder {
    int vcu, G;
    __host__ __device__ bool next(int i, Unit& u) const {
        const int e = i * G + vcu; if (e >= 768) return false;
        const int vc = e & 255, r = e >> 8, x = vc >> 5, c = vc & 31, rh = c % 3;
        if (r == rh) { u.pm = 2 * x + (c >> 4); u.pn = 8 + (c & 15); }
        else { const int li = c + 32 * ((r > rh) ? r - 1 : r);
            if (li < 16) { u.pm = 2 * x + (li >> 3); u.pn = li & 7; } else { const int t = li - 16; u.pm = 16 + 2 * x + t / 24; u.pn = t % 24; } }
        u.idx = i; return true;
    }
    __device__ __forceinline__ void a_ready(const Unit&) const {}
    __device__ __forceinline__ void done(const Unit&) const {}
};


struct XcdOrder {
    int lo, n16, nN, r, nloc, dq;
    __device__ __forceinline__ bool next(int i, Unit& u) const {
        const int e = i * nloc + r;
        if (dq) { if (e >= 96) return false; const int rh = r % 3;
            if (i == rh) { u.pm = lo + (r >> 4); u.pn = 8 + (r & 15); }
            else { const int li = r + 32 * ((i > rh) ? i - 1 : i);
                if (li < 16) { u.pm = lo + (li >> 3); u.pn = li & 7; } else { const int t = li - 16; u.pm = 16 + lo + t / 24; u.pn = t % 24; } } }
        else { const int np = 2 * n16; if (e >= np * nN) return false; const int pn = e / np, pi = e - pn * np; u.pn = pn; u.pm = pi < n16 ? lo + pi : 16 + lo + (pi - n16); }
        u.idx = i; return true;
    }
    __device__ __forceinline__ void a_ready(const Unit&) const {}
    __device__ __forceinline__ void done(const Unit&) const {}
};
__device__ __forceinline__ unsigned cvt_pk_bf16(float lo, float hi) { unsigned r; asm volatile("v_cvt_pk_bf16_f32 %0, %1, %2" : "=v"(r) : "v"(lo), "v"(hi)); return r; }
typedef float f32x2 __attribute__((ext_vector_type(2)));
template <class Epi, class Sched, bool ALIGN_EPI = false, bool SP2 = false, bool NARROW = false>
__device__ __forceinline__ void gemm_phase(PG8_LAS unsigned char* lds, const Gemm g, const Sched& S, const Epi& E, const int wave_id) {
    int tid_ = wave_id * 64 + lane_id_opaque(); asm volatile("" : "+v"(tid_));
    const int tid = tid_, wid = __builtin_amdgcn_readfirstlane(tid >> 6), lane = tid & 63, wr = wid >> 2, wc = wid & 3, fr = lane & 15, fq = lane >> 4;
    const int K = g.K, nt = K / BK;
    unsigned voffA[2], voffB[2];
#pragma unroll
    for (int i = 0; i < 2; ++i) { int R, C; stage_rc(tid * 16 + i * 8192, R, C); const int Rb = Epi::PERM ? ((R & ~31) + perm32(R & 31)) : R;
        voffA[i] = (unsigned)(R * K + C) * 2u; voffB[i] = (unsigned)(Rb * K + C) * 2u; }
    const size_t kstep = (size_t)(BK * 2);
    const size_t hstep = (size_t)HALF * K * 2;
    const size_t tstep = 2 * hstep;
    const size_t tstepB = NARROW ? hstep : tstep;
    static_assert(!NARROW || SP2, "NARROW is an SP2 variant");
    const unsigned ldsw = (unsigned)wid * 1024u;
    const int aoff = lds_byte(wr * 64 + fr, fq * 8), boff = lds_byte(wc * 32 + fr, fq * 8);
#define PG8_SA(b, h) (((b) * 2 + (h)) * HTB)
#define PG8_SB(b, h) ((4 + (b) * 2 + (h)) * HTB)
#define PG8_STAGE(bufoff, gbase, voff) do { _Pragma("unroll") for (int _i = 0; _i < 2; ++_i) \
        __builtin_amdgcn_global_load_lds((const unsigned*)((const char*)(gbase) + (voff)[_i]), (PG8_LAS unsigned*)(lds + (bufoff) + ldsw + _i * 8192), 16, 0, 0); } while (0)
#define PG8_LDA(dst, b, h) do { _Pragma("unroll") for (int m = 0; m < 4; ++m) _Pragma("unroll") for (int k = 0; k < 2; ++k) dst[m][k] = *(const PG8_LAS bf16x8*)(lds + PG8_SA(b, h) + aoff + m * 2048 + k * 1024); } while (0)
#define PG8_LDB(dst, b, h) do { _Pragma("unroll") for (int n = 0; n < 2; ++n) _Pragma("unroll") for (int k = 0; k < 2; ++k) dst[n][k] = *(const PG8_LAS bf16x8*)(lds + PG8_SB(b, h) + boff + n * 2048 + k * 1024); } while (0)
#define PG8_MMA(ai, bj, At, Bt) do { __builtin_amdgcn_s_setprio(1); _Pragma("unroll") for (int m = 0; m < 4; ++m) _Pragma("unroll") for (int n = 0; n < 2; ++n) _Pragma("unroll") for (int k = 0; k < 2; ++k) \
        acc[ai][bj][m][n] = __builtin_amdgcn_mfma_f32_16x16x32_bf16(Bt[n][k], At[m][k], acc[ai][bj][m][n], 0, 0, 0); __builtin_amdgcn_s_setprio(0); } while (0)
#define PG8_WAIT_V(n) asm volatile("s_waitcnt vmcnt(" #n ")" ::: "memory")
#define PG8_WAIT_L(n) asm volatile("s_waitcnt lgkmcnt(" #n ")" ::: "memory")
#define PG8_BAR __builtin_amdgcn_s_barrier()
#define PG8_SCHED __builtin_amdgcn_sched_barrier(0)
    Unit cur, nxt; int ui = 0;
    if (!S.next(0, cur)) return;
    f32x4 acc[2][2][4][2];
#pragma unroll
    for (int a = 0; a < 2; ++a)
#pragma unroll
        for (int b = 0; b < 2; ++b)
#pragma unroll
            for (int m = 0; m < 4; ++m)
#pragma unroll
                for (int n = 0; n < 2; ++n) acc[a][b][m][n] = (f32x4){0.f, 0.f, 0.f, 0.f};
    bf16x8 At[4][2], B0[2][2], B1[2][2];
    const char* cA = (const char*)g.A + (size_t)cur.pm * tstep; const char* cB = (const char*)g.Bt + (size_t)cur.pn * tstepB;
    S.a_ready(cur);
    if constexpr (SP2) {
        if constexpr (NARROW) {
        PG8_STAGE(PG8_SB(0, 0), cB, voffB); PG8_STAGE(PG8_SA(0, 0), cA, voffA); PG8_STAGE(PG8_SA(0, 1), cA + hstep, voffA);
        if (wr == 1) PG8_BAR;
        PG8_WAIT_V(2); PG8_BAR;
        PG8_STAGE(PG8_SB(1, 0), cB + kstep, voffB); PG8_STAGE(PG8_SA(1, 0), cA + kstep, voffA);
        PG8_WAIT_V(4); PG8_BAR;
        } else {
        PG8_STAGE(PG8_SB(0, 0), cB, voffB); PG8_STAGE(PG8_SB(0, 1), cB + hstep, voffB); PG8_STAGE(PG8_SA(0, 0), cA, voffA); PG8_STAGE(PG8_SA(0, 1), cA + hstep, voffA);
        if (wr == 1) PG8_BAR;
        PG8_WAIT_V(2); PG8_BAR;
        PG8_STAGE(PG8_SB(1, 0), cB + kstep, voffB); PG8_STAGE(PG8_SA(1, 0), cA + kstep, voffA); PG8_STAGE(PG8_SB(1, 1), cB + hstep + kstep, voffB);
        PG8_WAIT_V(6); PG8_BAR;
        }
    } else {
        PG8_STAGE(PG8_SB(0, 0), cB, voffB); PG8_STAGE(PG8_SA(0, 0), cA, voffA); PG8_STAGE(PG8_SB(0, 1), cB + hstep, voffB); PG8_STAGE(PG8_SA(0, 1), cA + hstep, voffA);
        if (wr == 1) PG8_BAR;
        PG8_WAIT_V(4); PG8_BAR;
        PG8_STAGE(PG8_SB(1, 0), cB + kstep, voffB); PG8_STAGE(PG8_SA(1, 0), cA + kstep, voffA); PG8_STAGE(PG8_SB(1, 1), cB + hstep + kstep, voffB);
        PG8_WAIT_V(6); PG8_BAR;
    }
    for (;;) {
        const bool has_next = S.next(ui + 1, nxt);
        const char* nA = has_next ? (const char*)g.A + (size_t)nxt.pm * tstep : cA; const char* nB = has_next ? (const char*)g.Bt + (size_t)nxt.pn * tstepB : cB;
        for (int t = 0; t < nt; t += 2) {
            const bool last = (t == nt - 2);
            const char* a1 = cA + (size_t)(t + 1) * kstep;
            const char* a2 = last ? nA : cA + (size_t)(t + 2) * kstep; const char* b2 = last ? nB : cB + (size_t)(t + 2) * kstep;
            const char* a3 = a2 + kstep; const char* b3 = b2 + kstep;
            if (last && has_next) S.a_ready(nxt);
            if constexpr (SP2 && NARROW) {
            PG8_LDB(B0, 0, 0); PG8_SCHED; PG8_LDA(At, 0, 0); PG8_STAGE(PG8_SA(1, 1), a1 + hstep, voffA);
            PG8_WAIT_V(6); PG8_WAIT_L(0); PG8_BAR; PG8_MMA(0, 0, At, B0); PG8_BAR; PG8_SCHED;
            PG8_LDA(At, 0, 1); PG8_STAGE(PG8_SB(0, 0), b2, voffB); PG8_STAGE(PG8_SA(0, 0), a2, voffA);
            PG8_WAIT_V(6); PG8_WAIT_L(0); PG8_BAR; PG8_MMA(1, 0, At, B0); PG8_BAR; PG8_SCHED;
            PG8_LDB(B0, 1, 0); PG8_SCHED; PG8_LDA(At, 1, 0); PG8_STAGE(PG8_SA(0, 1), a2 + hstep, voffA);
            PG8_WAIT_V(6); PG8_WAIT_L(0); PG8_BAR; PG8_MMA(0, 0, At, B0); PG8_BAR; PG8_SCHED;
            PG8_LDA(At, 1, 1); PG8_STAGE(PG8_SB(1, 0), b3, voffB); PG8_STAGE(PG8_SA(1, 0), a3, voffA);
            PG8_WAIT_V(6); PG8_WAIT_L(0); PG8_BAR; PG8_MMA(1, 0, At, B0); PG8_BAR; PG8_SCHED;
            } else if constexpr (SP2) {
            PG8_LDB(B0, 0, 0); PG8_LDB(B1, 0, 1); PG8_SCHED; PG8_LDA(At, 0, 0); PG8_STAGE(PG8_SA(1, 1), a1 + hstep, voffA);
            PG8_WAIT_V(8); PG8_WAIT_L(0); PG8_BAR; PG8_MMA(0, 0, At, B0); PG8_MMA(0, 1, At, B1); PG8_BAR; PG8_SCHED;
            PG8_LDA(At, 0, 1); PG8_STAGE(PG8_SB(0, 0), b2, voffB); PG8_STAGE(PG8_SB(0, 1), b2 + hstep, voffB); PG8_STAGE(PG8_SA(0, 0), a2, voffA);
            PG8_WAIT_V(8); PG8_WAIT_L(0); PG8_BAR; PG8_MMA(1, 0, At, B0); PG8_MMA(1, 1, At, B1); PG8_BAR; PG8_SCHED;
            PG8_LDB(B0, 1, 0); PG8_LDB(B1, 1, 1); PG8_SCHED; PG8_LDA(At, 1, 0); PG8_STAGE(PG8_SA(0, 1), a2 + hstep, voffA);
            PG8_WAIT_V(8); PG8_WAIT_L(0); PG8_BAR; PG8_MMA(0, 0, At, B0); PG8_MMA(0, 1, At, B1); PG8_BAR; PG8_SCHED;
            PG8_LDA(At, 1, 1); PG8_STAGE(PG8_SB(1, 0), b3, voffB); PG8_STAGE(PG8_SB(1, 1), b3 + hstep, voffB); PG8_STAGE(PG8_SA(1, 0), a3, voffA);
            PG8_WAIT_V(8); PG8_WAIT_L(0); PG8_BAR; PG8_MMA(1, 0, At, B0); PG8_MMA(1, 1, At, B1); PG8_BAR; PG8_SCHED;
            } else {
            PG8_LDB(B0, 0, 0); PG8_SCHED; PG8_LDA(At, 0, 0); PG8_STAGE(PG8_SA(1, 1), a1 + hstep, voffA);
            PG8_WAIT_L(8); PG8_BAR; PG8_WAIT_L(0); PG8_MMA(0, 0, At, B0); PG8_BAR; PG8_SCHED;
            PG8_LDB(B1, 0, 1); PG8_STAGE(PG8_SB(0, 0), b2, voffB);
            PG8_BAR; PG8_WAIT_L(0); PG8_MMA(0, 1, At, B1); PG8_BAR;
            PG8_LDA(At, 0, 1); PG8_STAGE(PG8_SA(0, 0), a2, voffA);
            PG8_BAR; PG8_WAIT_L(0); PG8_MMA(1, 0, At, B0); PG8_BAR; PG8_SCHED;
            PG8_STAGE(PG8_SB(0, 1), b2 + hstep, voffB);
            PG8_WAIT_V(6); PG8_BAR; PG8_MMA(1, 1, At, B1); PG8_BAR;
            PG8_LDB(B0, 1, 0); PG8_SCHED; PG8_LDA(At, 1, 0); PG8_STAGE(PG8_SA(0, 1), a2 + hstep, voffA);
            PG8_WAIT_L(8); PG8_BAR; PG8_WAIT_L(0); PG8_MMA(0, 0, At, B0); PG8_BAR; PG8_SCHED;
            PG8_LDB(B1, 1, 1); PG8_STAGE(PG8_SB(1, 0), b3, voffB);
            PG8_BAR; PG8_WAIT_L(0); PG8_MMA(0, 1, At, B1); PG8_BAR;
            PG8_LDA(At, 1, 1); PG8_STAGE(PG8_SA(1, 0), a3, voffA);
            PG8_BAR; PG8_WAIT_L(0); PG8_MMA(1, 0, At, B0); PG8_BAR; PG8_SCHED;
            PG8_STAGE(PG8_SB(1, 1), b3 + hstep, voffB);
            PG8_WAIT_V(6); PG8_BAR; PG8_MMA(1, 1, At, B1); PG8_BAR;
            }
        }
        if constexpr (ALIGN_EPI) { if (wr == 0) PG8_BAR; }
        if constexpr (!Epi::AFTER_DRAIN) { E(acc, cur, wr, wc, fr, fq);
            S.done(cur); }
        if (!has_next) break;
#pragma unroll
        for (int a = 0; a < 2; ++a)
#pragma unroll
            for (int b = 0; b < 2; ++b)
#pragma unroll
                for (int m = 0; m < 4; ++m)
#pragma unroll
                    for (int n = 0; n < 2; ++n) acc[a][b][m][n] = (f32x4){0.f, 0.f, 0.f, 0.f};
        cur = nxt; cA = nA; cB = nB; ++ui;
        if constexpr (ALIGN_EPI) { if (wr == 1) PG8_BAR; }
    }
    PG8_WAIT_V(0);
    if constexpr (!ALIGN_EPI) { if (wr == 0) PG8_BAR; }
    PG8_BAR;
    if constexpr (Epi::AFTER_DRAIN) { E.fused(acc, cur, wr, wc, fr, fq, lds, wid, lane); S.done(cur); }
#undef PG8_SA
#undef PG8_SB
#undef PG8_STAGE
#undef PG8_LDA
#undef PG8_LDB
#undef PG8_MMA
#undef PG8_WAIT_V
#undef PG8_WAIT_L
#undef PG8_BAR
#undef PG8_SCHED
}
}
namespace pg8 {
typedef unsigned u32x2 __attribute__((ext_vector_type(2)));
__device__ __forceinline__ void store16f_wt(void* p, f32x4 v) { asm volatile("global_store_dwordx4 %0, %1, off sc1\n\ts_nop 1" :: "v"(p), "v"(v) : "memory"); }
__device__ __forceinline__ void store16_wt(void* p, u32x4 v) { asm volatile("global_store_dwordx4 %0, %1, off sc1\n\ts_nop 1" :: "v"(p), "v"(v) : "memory"); }
constexpr int NTOK = 8192, NPROMPT = 4096, DMODEL = 1024, NPART = 32;
constexpr float C2Q = 0.125f * 1.4426950408889634f;
__device__ __forceinline__ u32x2 pack4(const f32x4 v) { u32x2 w; w.x = cvt_pk_bf16(v[0], v[1]); w.y = cvt_pk_bf16(v[2], v[3]); return w; }
__device__ __forceinline__ void store_pair16_wt(bf16_t* p, const u32x2 A, const u32x2 B, const int fq) {
    const auto r0 = __builtin_amdgcn_permlane16_swap(A.x, B.x, false, false), r1 = __builtin_amdgcn_permlane16_swap(A.y, B.y, false, false);
    u32x4 w; w.x = r0[0]; w.y = r1[0]; w.z = r0[1]; w.w = r1[1];
    store16_wt(p + ((fq & 1) ? 12 : 0), w);
}
__device__ __forceinline__ int mod_index(int pm) { return pm < 16 ? 0 : 1 + ((pm - 16) >> 3); }
__device__ __forceinline__ int kv_row(int m) { return m < NPROMPT ? m : m + 256 * (((m - NPROMPT) >> 11) + 1); }
__device__ __forceinline__ float row_rstd(const float* rowss, int row) {
    float s = 0.f;
#pragma unroll
    for (int p = 0; p < NPART; ++p) s += rowss[row * NPART + p];
    return __builtin_amdgcn_rsqf(s * (1.0f / DMODEL) + 1e-6f);
}

struct EpiResid {
    static constexpr bool PERM = true, AFTER_DRAIN = false, IDEMPOTENT = false;
    bf16_t* X16; bf16_t* XG; const float* gate; int gate_ld; const float* gain; float* rowss;
    __device__ __forceinline__ void operator()(const f32x4 (&acc)[2][2][4][2], const Unit& u, int wr, int wc, int fr_, int fq_) const {
        int fr, fq; { int ln_ = lane_id_opaque(); asm volatile("" : "+v"(ln_)); fr = ln_ & 15; fq = ln_ >> 4; } (void)fr_; (void)fq_;
        const int v = mod_index(u.pm), col0 = u.pn * HALF + wc * 32 + 8 * fq;
        f32x4 gt[2], gn[2];
#pragma unroll
        for (int n = 0; n < 2; ++n) { gt[n] = *(const f32x4*)(gate + v * gate_ld + col0 + 4 * n);
            gn[n] = gain ? *(const f32x4*)(gain + v * DMODEL + col0 + 4 * n) : (f32x4){0.f, 0.f, 0.f, 0.f}; }
        u32x4 xold[2][4];
#pragma unroll
        for (int ai = 0; ai < 2; ++ai)
#pragma unroll
            for (int m = 0; m < 4; ++m) xold[ai][m] = *(const u32x4*)(X16 + (size_t)(u.pm * BM + ai * HALF + wr * 64 + m * 16 + fr) * DMODEL + col0);
#pragma unroll
        for (int ai = 0; ai < 2; ++ai)
#pragma unroll
            for (int m = 0; m < 4; ++m) { const int row = u.pm * BM + ai * HALF + wr * 64 + m * 16 + fr; const size_t off = (size_t)row * DMODEL + col0; float ss = 0.f; const u32x4 xo = xold[ai][m];
                f32x4 xn[2];
#pragma unroll
                for (int n = 0; n < 2; ++n) { const f32x4 xf = (f32x4){__uint_as_float(xo[2 * n] << 16), __uint_as_float(xo[2 * n] & 0xffff0000u), __uint_as_float(xo[2 * n + 1] << 16), __uint_as_float(xo[2 * n + 1] & 0xffff0000u)};
                    xn[n] = xf + gt[n] * acc[ai][0][m][n]; ss += (xn[n][0] * xn[n][0] + xn[n][1] * xn[n][1]) + (xn[n][2] * xn[n][2] + xn[n][3] * xn[n][3]); }
                { u32x4 w; w.x = cvt_pk_bf16(xn[0][0], xn[0][1]); w.y = cvt_pk_bf16(xn[0][2], xn[0][3]); w.z = cvt_pk_bf16(xn[1][0], xn[1][1]); w.w = cvt_pk_bf16(xn[1][2], xn[1][3]); store16_wt(X16 + off, w); }
                if (gain) { const f32x4 g0 = xn[0] * gn[0], g1 = xn[1] * gn[1]; u32x4 w; w.x = cvt_pk_bf16(g0[0], g0[1]); w.y = cvt_pk_bf16(g0[2], g0[3]); w.z = cvt_pk_bf16(g1[0], g1[1]); w.w = cvt_pk_bf16(g1[2], g1[3]); store16_wt(XG + off, w); }
                ss += __shfl_xor(ss, 16); ss += __shfl_xor(ss, 32);
                if (fq == 0) rowss[row * NPART + (u.pn * 4 + wc)] = ss; }
    }
};

template <int CTRL> __device__ __forceinline__ f32x4 dpp4(const f32x4 oldv, const f32x4 src) {
    f32x4 r;
#pragma unroll
    for (int e = 0; e < 4; ++e) { const float o_ = oldv[e], s_ = src[e];
        r[e] = __int_as_float(__builtin_amdgcn_update_dpp(__float_as_int(o_), __float_as_int(s_), CTRL, 0xf, 0xf, false)); }
    return r;
}
struct EpiUpConv {
    static constexpr bool PERM = true, AFTER_DRAIN = false, IDEMPOTENT = false;
    bf16_t* H; const float* bias; const float* cw; const float* cb; const PG8_LAS float* rstd; PG8_LAS float* edge; float* uedge;
    __device__ __forceinline__ void operator()(f32x4 (&acc)[2][2][4][2], const Unit& u, int wr, int wc, int fr_, int fq_) const {
        int fr, fq; { int ln_ = lane_id_opaque(); asm volatile("" : "+v"(ln_)); fr = ln_ & 15; fq = ln_ >> 4; } (void)fr_; (void)fq_;

        const int v = mod_index(u.pm), cbase = wc * 32 + 8 * fq;
        { float rs[2][4];
#pragma unroll
          for (int ai = 0; ai < 2; ++ai)
#pragma unroll
              for (int m = 0; m < 4; ++m) rs[ai][m] = rstd[(u.idx & 7) * 256 + ai * HALF + wr * 64 + m * 16 + fr];
#pragma unroll
          for (int bj = 0; bj < 2; ++bj)
#pragma unroll
              for (int n = 0; n < 2; ++n) { const f32x4 b4 = *(const f32x4*)(bias + (size_t)v * 5632 + u.pn * BM + bj * HALF + cbase + 4 * n);
#pragma unroll
                  for (int ai = 0; ai < 2; ++ai)
#pragma unroll
                      for (int m = 0; m < 4; ++m) { acc[ai][bj][m][n] = acc[ai][bj][m][n] * rs[ai][m] + b4; asm volatile("" : "+v"(acc[ai][bj][m][n])); } } }
        { const unsigned ebase = (unsigned)(uintptr_t)edge + (unsigned)(cbase * 4);
#pragma unroll
          for (int ai = 0; ai < 2; ++ai) { const unsigned a0 = ebase + (unsigned)(((ai * 2 + wr) * 2) * 1024);
            if (fr == 0) {
#pragma unroll
                for (int bj = 0; bj < 2; ++bj)
#pragma unroll
                    for (int n = 0; n < 2; ++n) asm volatile("ds_write_b128 %0, %1 offset:%c2" :: "v"(a0), "v"(acc[ai][bj][0][n]), "i"(bj * 512 + n * 16) : "memory"); }
            if (fr == 15) {
#pragma unroll
                for (int bj = 0; bj < 2; ++bj)
#pragma unroll
                    for (int n = 0; n < 2; ++n) asm volatile("ds_write_b128 %0, %1 offset:%c2" :: "v"(a0), "v"(acc[ai][bj][3][n]), "i"(1024 + bj * 512 + n * 16) : "memory"); } } }
        if (u.pm >= 16) {
            if (wr == 0 && fr < 2) { float* o = uedge + ((size_t)u.pm * 4 + fr) * 5632 + u.pn * BM + cbase;
#pragma unroll
                for (int bj = 0; bj < 2; ++bj)
#pragma unroll
                    for (int n = 0; n < 2; ++n) store16f_wt(o + bj * HALF + 4 * n, acc[0][bj][0][n]); }
            if (wr == 1 && fr >= 14) { float* o = uedge + ((size_t)u.pm * 4 + 2 + (fr - 14)) * 5632 + u.pn * BM + cbase;
#pragma unroll
                for (int bj = 0; bj < 2; ++bj)
#pragma unroll
                    for (int n = 0; n < 2; ++n) store16f_wt(o + bj * HALF + 4 * n, acc[1][bj][3][n]); } }
        asm volatile("s_waitcnt lgkmcnt(0)\n\ts_barrier" ::: "memory"); __builtin_amdgcn_sched_barrier(0);
#pragma unroll
        for (int bj = 0; bj < 2; ++bj) {
#pragma unroll
          for (int n = 0; n < 2; ++n) {
            int fr2 = fr, cb2 = cbase; asm volatile("" : "+v"(fr2), "+v"(cb2));
            const float* wp = cw + bj * 2816 + u.pn * HALF + cb2 + 4 * n;
            const f32x4 w0 = *(const f32x4*)wp, w1 = *(const f32x4*)(wp + 5632), w2 = *(const f32x4*)(wp + 2 * 5632), cbv = *(const f32x4*)(cb + bj * 2816 + u.pn * HALF + cb2 + 4 * n);
#pragma unroll
            for (int ai = 0; ai < 2; ++ai) { const int blk = ai * 2 + wr;
                f32x4 carry = *(const PG8_LAS f32x4*)(edge + ((blk > 0 ? blk - 1 : 0) * 2 + 1) * 256 + bj * HALF + cb2 + 4 * n) * (blk > 0 ? 1.0f : 0.0f);
                const f32x4 en = *(const PG8_LAS f32x4*)(edge + ((blk < 3 ? blk + 1 : 3) * 2 + 0) * 256 + bj * HALF + cb2 + 4 * n) * (blk < 3 ? 1.0f : 0.0f);
#pragma unroll
                for (int m = 0; m < 4; ++m) { const f32x4 cur = acc[ai][bj][m][n];
                    const f32x4 nold = m < 3 ? dpp4<0x12F>(cur, acc[ai][bj][m < 3 ? m + 1 : 3][n]) : en;
                    const f32x4 prev = dpp4<0x111>(carry, cur);
                    const f32x4 next = dpp4<0x101>(nold, cur);
                    carry = dpp4<0x121>(cur, cur);
                    const f32x4 o = w0 * prev + w1 * cur + w2 * next + cbv;
                    if (bj == 0) {
#pragma unroll
                        for (int e = 0; e < 4; ++e) acc[ai][0][m][n][e] = o[e] * __builtin_amdgcn_rcpf(1.0f + __expf(-o[e]));
                    } else { const f32x4 h = acc[ai][0][m][n] * o; const unsigned p0 = cvt_pk_bf16(h[0], h[1]), p1 = cvt_pk_bf16(h[2], h[3]);
                        if (n == 0) { acc[ai][0][m][0][0] = __uint_as_float(p0); acc[ai][0][m][0][1] = __uint_as_float(p1); }
                        else { u32x4 w; w.x = __float_as_uint(acc[ai][0][m][0][0]); w.y = __float_as_uint(acc[ai][0][m][0][1]); w.z = p0; w.w = p1;

                            store16_wt(H + (size_t)(u.pm * BM + ai * HALF + wr * 64 + m * 16 + fr2) * 2816 + u.pn * HALF + cb2, w); } }
                    __builtin_amdgcn_sched_barrier(0); } }
            asm volatile("" ::: "memory"); __builtin_amdgcn_sched_barrier(0); } }
    }
};


struct EpiQkvDiff {
    static constexpr bool PERM = false, AFTER_DRAIN = false, IDEMPOTENT = true;
    bf16_t *Q, *K, *V; const float* bias; const PG8_LAS float* rstd; const float* rope;
    float *newk, *newv;
    __device__ __forceinline__ void operator()(const f32x4 (&acc)[2][2][4][2], const Unit& u, int wr, int wc, int fr_, int fq_) const {
        int fr, fq; { int ln_ = lane_id_opaque(); asm volatile("" : "+v"(ln_)); fr = ln_ & 15; fq = ln_ >> 4; } (void)fr_; (void)fq_;
        const int v = mod_index(u.pm), sec = u.pn >> 3, hd = u.pn & 7, cs = hd * HALF + wc * 32 + 4 * fq;
        const bool latent = u.pm >= 16; const int qb = (u.pm - 16) & 7;
        const float* biasp = bias + v * 3072 + sec * 1024 + cs; const f32x4 b0 = *(const f32x4*)biasp, b1 = *(const f32x4*)(biasp + 16);
        f32x4 ra[2][4], rb[2][4];
        const bool roped = latent && sec < 2;
        if (roped) {
#pragma unroll
            for (int ai = 0; ai < 2; ++ai)
#pragma unroll
                for (int m = 0; m < 4; ++m) { const int trow = ai * HALF + wr * 64 + m * 16 + fr; const int pos = (wc & 1) ? (trow & 63) : (4 * qb + (trow >> 6));
                    const float* rp = rope + (pos * 16 + 4 * fq) * 2; ra[ai][m] = *(const f32x4*)rp; rb[ai][m] = *(const f32x4*)(rp + 4); } }
#pragma unroll
        for (int ai = 0; ai < 2; ++ai)
#pragma unroll
            for (int m = 0; m < 4; ++m) { const int trow = ai * HALF + wr * 64 + m * 16 + fr, row = u.pm * BM + trow; const float rs = rstd[(u.idx & 7) * 256 + trow];
                f32x4 c4 = (f32x4){1.f, 1.f, 1.f, 1.f}, s4 = (f32x4){0.f, 0.f, 0.f, 0.f};
                if (roped) { const f32x4 a = ra[ai][m], b = rb[ai][m]; c4 = (f32x4){a[0], a[2], b[0], b[2]}; s4 = (f32x4){a[1], a[3], b[1], b[3]}; }
                const f32x4 x0 = acc[ai][0][m][0] * rs + b0, x1 = acc[ai][0][m][1] * rs + b1;
                if (sec == 0) { const f32x4 y0 = (x0 * c4 - x1 * s4) * C2Q, y1 = (x1 * c4 + x0 * s4) * C2Q; bf16_t* p = Q + (size_t)row * DMODEL + cs;
                    store_pair16_wt(p, pack4(y0), pack4(y1), fq); }
                else { const size_t kr = (size_t)kv_row(row) * DMODEL + cs;
                    if (!latent) { float* o = (sec == 1 ? newk : newv) + ((size_t)(u.pm * 16 + hd) * 256 + trow) * 128 + wc * 32 + 4 * fq; store16f_wt(o, x0); store16f_wt(o + 16, x1); }
                    if (sec == 1) { const f32x4 y0 = x0 * c4 - x1 * s4, y1 = x1 * c4 + x0 * s4; store_pair16_wt(K + kr, pack4(y0), pack4(y1), fq); }
                    else { store_pair16_wt(V + kr, pack4(x0), pack4(x1), fq); } } }
    }
};

struct EpiQkvGqa {
    static constexpr bool PERM = false, AFTER_DRAIN = false, IDEMPOTENT = true;
    bf16_t *Q, *K, *V; const float* bias; const PG8_LAS float* rstd; const float* rope; const float *qnw, *knw;
    float *newk, *newv;
    __device__ __forceinline__ void operator()(const f32x4 (&acc)[2][2][4][2], const Unit& u, int wr, int wc, int fr_, int fq_) const {
        int fr, fq; { int ln_ = lane_id_opaque(); asm volatile("" : "+v"(ln_)); fr = ln_ & 15; fq = ln_ >> 4; } (void)fr_; (void)fq_;
        const int v = mod_index(u.pm), sec = u.pn < 4 ? 0 : u.pn - 3;
        const bool latent = u.pm >= 16; const int qb = (u.pm - 16) & 7;
        const float* biasp = bias + v * 1536 + u.pn * BM + wc * 32 + 4 * fq; const float* nwp = (sec == 0 ? qnw : knw) + 4 * fq;
#pragma unroll
        for (int ai = 0; ai < 2; ++ai)
#pragma unroll
            for (int m = 0; m < 4; ++m) { const int trow = ai * HALF + wr * 64 + m * 16 + fr, row = u.pm * BM + trow; const float rs = rstd[(u.idx & 7) * 256 + trow];
                f32x4 x[2][2]; float ss = 0.f;
#pragma unroll
                for (int bj = 0; bj < 2; ++bj)
#pragma unroll
                    for (int n = 0; n < 2; ++n) { x[bj][n] = acc[ai][bj][m][n] * rs + *(const f32x4*)(biasp + bj * HALF + n * 16); const f32x4 t = x[bj][n]; ss += (t[0] * t[0] + t[1] * t[1]) + (t[2] * t[2] + t[3] * t[3]); }
                if (sec < 2) { ss += __shfl_xor(ss, 16); ss += __shfl_xor(ss, 32); const float hr = __builtin_amdgcn_rsqf(ss * (1.0f / 64.0f) + 1e-6f);
#pragma unroll
                    for (int bj = 0; bj < 2; ++bj)
#pragma unroll
                        for (int n = 0; n < 2; ++n) x[bj][n] = x[bj][n] * hr * *(const f32x4*)(nwp + 32 * bj + 16 * n); }
                if (sec == 0) {
#pragma unroll
                    for (int bj = 0; bj < 2; ++bj) { f32x4 y0 = x[bj][0], y1 = x[bj][1];
                        if (latent) { const int pos = bj ? (trow & 63) : (4 * qb + (trow >> 6)); const float* rp = rope + (pos * 16 + 4 * fq) * 2; const f32x4 a = *(const f32x4*)rp, b = *(const f32x4*)(rp + 4);
                            const f32x4 c4 = (f32x4){a[0], a[2], b[0], b[2]}, s4 = (f32x4){a[1], a[3], b[1], b[3]}; y0 = x[bj][0] * c4 - x[bj][1] * s4; y1 = x[bj][1] * c4 + x[bj][0] * s4; }
                        bf16_t* p = Q + (size_t)row * DMODEL + (u.pn * 4 + wc) * 64 + 32 * bj + 4 * fq; store_pair16_wt(p, pack4(y0 * C2Q), pack4(y1 * C2Q), fq); }
                } else {
                    const size_t kr = (size_t)kv_row(row) * 256 + wc * 64 + 4 * fq;
                    if (!latent) { float* o = (sec == 1 ? newk : newv) + ((size_t)(u.pm * 8 + wc) * 256 + trow) * 64 + 4 * fq;
#pragma unroll
                        for (int bj = 0; bj < 2; ++bj) { store16f_wt(o + 32 * bj, x[bj][0]); store16f_wt(o + 32 * bj + 16, x[bj][1]); } }
#pragma unroll
                    for (int bj = 0; bj < 2; ++bj) { f32x4 y0 = x[bj][0], y1 = x[bj][1];
                        if (latent && sec == 1) { const int pos = bj ? (trow & 63) : (4 * qb + (trow >> 6)); const float* rp = rope + (pos * 16 + 4 * fq) * 2; const f32x4 a = *(const f32x4*)rp, b = *(const f32x4*)(rp + 4);
                            const f32x4 c4 = (f32x4){a[0], a[2], b[0], b[2]}, s4 = (f32x4){a[1], a[3], b[1], b[3]}; y0 = x[bj][0] * c4 - x[bj][1] * s4; y1 = x[bj][1] * c4 + x[bj][0] * s4; }
                        bf16_t* p = (sec == 1 ? K : V) + kr + 32 * bj; store_pair16_wt(p, pack4(y0), pack4(y1), fq); } }
                asm volatile("" ::: "memory");
            }
    }
};

}
namespace attn_body {
using bf16=__hip_bfloat16;
using bf16x8=__attribute__((ext_vector_type(8)))short;
using s16x4=__attribute__((ext_vector_type(4)))short;
using f32x16=__attribute__((ext_vector_type(16)))float;
using u32x4=__attribute__((ext_vector_type(4)))unsigned;
using f32x4_t=__attribute__((ext_vector_type(4)))float;
constexpr int D=64;
constexpr int NW=8,QBLK=32,QB=QBLK*NW,KVBLK=64;
constexpr int ATTN_UNIT_ROWS=QB;
__device__ __forceinline__ int crow(int r,int hi){return (r&3)+8*(r>>2)+4*hi;}
#define SBAR() __builtin_amdgcn_sched_barrier(0)

constexpr int NSLOT=3, SLOTB=8192;
constexpr int LDS_K=0, LDS_V=NSLOT*SLOTB;
__host__ __device__ constexpr int lds_ws(int DV){return LDS_V+NSLOT*SLOTB*(DV/64);} __host__ __device__ constexpr int lds_ost(int DV){return lds_ws(DV)+NW*64*4;} __host__ __device__ constexpr int lds_bytes(int DV){return lds_ost(DV)+NW*4096;}
constexpr float C2=0.125f*1.4426950408889634f;
__device__ __forceinline__ void glds16(const void*gsrc,unsigned lds_dst){unsigned keep;
  asm volatile("s_mov_b32 %0, m0\n\ts_mov_b32 m0, %2\n\ts_nop 0\n\tglobal_load_lds_dwordx4 %1, off\n\ts_mov_b32 m0, %0":"=&s"(keep):"v"(gsrc),"s"(lds_dst):"memory");}
__device__ __forceinline__ float max3f(float a,float b,float c){float r;asm("v_max3_f32 %0, %1, %2, %3":"=v"(r):"v"(a),"v"(b),"v"(c));return r;}
__device__ __forceinline__ float max2f(float a,float b){float r;asm("v_max_f32_e32 %0, %1, %2":"=v"(r):"v"(a),"v"(b));return r;}
__device__ __forceinline__ float fadd_s(float a,float b){float r;asm("v_add_f32_e32 %0, %1, %2":"=v"(r):"v"(a),"v"(b));return r;}
__device__ __forceinline__ float fsub_s(float a,float b){float r;asm("v_sub_f32_e32 %0, %1, %2":"=v"(r):"v"(a),"v"(b));return r;}
typedef float f32x2_t __attribute__((ext_vector_type(2))); typedef __bf16 bf16x2_t __attribute__((ext_vector_type(2)));
__device__ __forceinline__ unsigned cvtpk_s(float lo,float hi){f32x2_t v={lo,hi};bf16x2_t b=__builtin_convertvector(v,bf16x2_t);return __builtin_bit_cast(unsigned,b);}
#define WAIT_BAR(N) asm volatile("s_waitcnt vmcnt(" #N ") lgkmcnt(0)\n\ts_barrier":::"memory")

__device__ __forceinline__ void qkt(f32x16&p0,f32x16&p1,const char*Kslot,const bf16x8*qr,const f32x16&negm,int r32,int hi){
  const char*kb=Kslot+hi*1024+r32*16;
  #pragma unroll
  for(int d0=0;d0<4;++d0){
    const bf16x8 b0=*reinterpret_cast<const bf16x8*>(kb+d0*2048);
    const bf16x8 b1=*reinterpret_cast<const bf16x8*>(kb+d0*2048+512);
    if(d0==0){p0=__builtin_amdgcn_mfma_f32_32x32x16_bf16(b0,qr[0],negm,0,0,0);p1=__builtin_amdgcn_mfma_f32_32x32x16_bf16(b1,qr[0],negm,0,0,0);}
    else{p0=__builtin_amdgcn_mfma_f32_32x32x16_bf16(b0,qr[d0],p0,0,0,0);p1=__builtin_amdgcn_mfma_f32_32x32x16_bf16(b1,qr[d0],p1,0,0,0);}}
}
typedef __attribute__((address_space(3))) const char* lds_cptr;
typedef short v4i16_t __attribute__((ext_vector_type(4)));
__device__ __forceinline__ void kload8(bf16x8*kf,lds_cptr kp){
  kf[0]=*(const __attribute__((address_space(3))) bf16x8*)(kp);      kf[1]=*(const __attribute__((address_space(3))) bf16x8*)(kp+512);
  kf[2]=*(const __attribute__((address_space(3))) bf16x8*)(kp+2048); kf[3]=*(const __attribute__((address_space(3))) bf16x8*)(kp+2560);
  kf[4]=*(const __attribute__((address_space(3))) bf16x8*)(kp+4096); kf[5]=*(const __attribute__((address_space(3))) bf16x8*)(kp+4608);
  kf[6]=*(const __attribute__((address_space(3))) bf16x8*)(kp+6144); kf[7]=*(const __attribute__((address_space(3))) bf16x8*)(kp+6656);
}
__device__ __forceinline__ void kload2(bf16x8*kf,lds_cptr kp,int j){ kf[2*j]=*(const __attribute__((address_space(3))) bf16x8*)(kp+j*2048); kf[2*j+1]=*(const __attribute__((address_space(3))) bf16x8*)(kp+j*2048+512); }
__device__ __forceinline__ s16x4 vtr(lds_cptr p){ return __builtin_bit_cast(s16x4,__builtin_amdgcn_ds_read_tr16_b64_v4i16((__attribute__((address_space(3))) v4i16_t*)p)); }
__device__ __forceinline__ float rowmax(const f32x16&p0,const f32x16&p1){
  float a=max3f(p0[0],p0[1],p1[0]),b=max3f(p0[2],p0[3],p1[1]);a=max3f(a,p1[2],p1[3]);
  #pragma unroll
  for(int r=4;r<16;r+=4){a=max3f(a,p0[r],p0[r+1]);b=max3f(b,p0[r+2],p0[r+3]);a=max3f(a,p1[r],p1[r+1]);b=max3f(b,p1[r+2],p1[r+3]);}
  const float m=max2f(a,b);
  auto rr=__builtin_amdgcn_permlane32_swap(__float_as_uint(m),__float_as_uint(m),false,false);
  return max2f(__uint_as_float(rr[0]),__uint_as_float(rr[1]));
}
__device__ __forceinline__ void pv(f32x16*o,int vb,bf16x8 pa0,bf16x8 pa1,bf16x8 pa2,bf16x8 pa3){
  #pragma unroll
  for(int d0=0;d0<2;++d0){s16x4 lo[4],hi[4];
    #pragma unroll
    for(int ks=0;ks<4;++ks){
      asm volatile("ds_read_b64_tr_b16 %0,%1 offset:%c2":"=&v"(lo[ks]):"v"(vb),"i"(d0*4096+ks*1024):"memory");
      asm volatile("ds_read_b64_tr_b16 %0,%1 offset:%c2":"=&v"(hi[ks]):"v"(vb),"i"(d0*4096+ks*1024+512):"memory");}
    asm volatile("s_waitcnt lgkmcnt(0)":::"memory");SBAR();
    #define PK(k) (bf16x8){lo[k][0],lo[k][1],lo[k][2],lo[k][3],hi[k][0],hi[k][1],hi[k][2],hi[k][3]}
    o[d0]=__builtin_amdgcn_mfma_f32_32x32x16_bf16(pa0,PK(0),o[d0],0,0,0);
    o[d0]=__builtin_amdgcn_mfma_f32_32x32x16_bf16(pa1,PK(1),o[d0],0,0,0);
    o[d0]=__builtin_amdgcn_mfma_f32_32x32x16_bf16(pa2,PK(2),o[d0],0,0,0);
    o[d0]=__builtin_amdgcn_mfma_f32_32x32x16_bf16(pa3,PK(3),o[d0],0,0,0);
    #undef PK
  }
}

#ifndef ATTN_STORE16
#define ATTN_STORE16(p,v) asm volatile("global_store_dwordx4 %0, %1, off sc1\n\ts_nop 1" :: "v"(p), "v"(v) : "memory")
#endif
struct AttnJob {
  const bf16* Q; int QP;
  const bf16* K; int KP;
  const bf16* V; int VP;
  bf16* O; int OP;
  int NT;
  int comb; unsigned* flag; unsigned target; float lam, oml; const float* sw;
};
template<int THRL,int DV> __device__ __forceinline__ void attn_unit(const AttnJob& J,char*shm,const int wave_id){
  constexpr int NV=DV/64, ND=DV/32, LDS_WS=lds_ws(DV), LDS_OST=lds_ost(DV);
  int tid_=wave_id*64+lane_id_opaque(); asm volatile("":"+v"(tid_));
  const int tid=tid_,lane=tid&63,r32=lane&31,hi=lane>>5; const int wid=__builtin_amdgcn_readfirstlane(tid>>6);
  const int QP=J.QP,KP=J.KP,VP=J.VP,OP=J.OP;
  const bf16*Qw=J.Q+(long)(wid*QBLK)*QP;
  const bf16*Kh=J.K,*Vh=J.V;
  const unsigned lds0=(unsigned)(uintptr_t)shm;
  float*wsf=(float*)(shm+LDS_WS)+wid*64;
  const bf16*ksrc=Kh+(long)lane*KP+wid*8;
  const bf16*vsrc=Vh+(long)(16*(wid&3)+(lane>>2))*VP+(wid>>2)*32+(lane&3)*8;
  const unsigned kdst=lds0+LDS_K+wid*1024, vdst=lds0+LDS_V+wid*1024;
  #define DMA_K(t,slot) glds16(ksrc+(long)(t)*KVBLK*KP,(unsigned)__builtin_amdgcn_readfirstlane(kdst+(slot)))
  #define DMA_V(t,slot) do{ _Pragma("unroll") for(int k_=0;k_<NV;++k_) glds16(vsrc+(long)(t)*KVBLK*VP+k_*64,(unsigned)__builtin_amdgcn_readfirstlane(vdst+NV*(slot)+k_*8192)); }while(0)
  const int vb0=(int)(lds0+LDS_V)+((lane>>4)&1)*32+(lane&3)*8+(4*hi+((lane&15)>>2))*64;
  const char*Kbase=shm+LDS_K; bf16x8 kf[8];
  const lds_cptr shm3=(lds_cptr)shm; const lds_cptr kp0=shm3+LDS_K+hi*1024+r32*16; const lds_cptr vp0=shm3+LDS_V+((lane>>4)&1)*32+(lane&3)*8+(4*hi+((lane&15)>>2))*64;
  const int NT=J.NT;
  DMA_K(0,0);DMA_V(0,0);DMA_K(1,SLOTB);
  bf16x8 qr[4];
  #pragma unroll
  for(int d0=0;d0<4;++d0)qr[d0]=*reinterpret_cast<const bf16x8*>(&Qw[(long)r32*QP+d0*16+hi*8]);
  float mhat=0.f,l_reg=0.f;f32x16 o[ND]; _Pragma("unroll") for(int d_=0;d_<ND;++d_)o[d_]=f32x16{};f32x16 negm=f32x16{};asm volatile("":"+v"(negm)); const f32x16 zero16=f32x16{};
  const u32x4 kone_u=(u32x4){hi==0?0x3f803f80u:0u,0u,0u,0u}; const bf16x8 kone=__builtin_bit_cast(bf16x8,kone_u); bf16x8 qm=__builtin_bit_cast(bf16x8,(u32x4){0u,0u,0u,0u});
  #define SETQM() do{ if constexpr(DV==128){ const float nm_=-mhat; const float hf_=__uint_as_float(cvtpk_s(nm_,0.f)<<16); const unsigned w_=cvtpk_s(hf_,nm_-hf_); \
      qm=__builtin_bit_cast(bf16x8,(u32x4){hi==0?w_:0u,0u,0u,0u}); } }while(0)
  #define CIN (DV==64?negm:zero16)
  #define CIN0(C) (DV==64?negm:C)
  #define CMASK(P0,P1,t) do{}while(0)
  bool resc=false;
  #define START(P0,P1) do{ const float rm=rowmax(P0,P1); resc=false; \
    { const float dl=rm; mhat=fadd_s(mhat,dl); \
      _Pragma("unroll") for(int r=0;r<16;++r){P0[r]=fsub_s(P0[r],dl);P1[r]=fsub_s(P1[r],dl);} \
      if constexpr(DV==64){ _Pragma("unroll") for(int r=0;r<16;++r)negm[r]=-mhat; asm volatile("":"+v"(negm)); } SETQM(); } \
    _Pragma("unroll") for(int r=0;r<16;++r)P0[r]=__builtin_amdgcn_exp2f(P0[r]); }while(0)
  #define RESC() do{ if(resc){ asm volatile("s_waitcnt lgkmcnt(0)":::"memory"); \
      _Pragma("unroll") for(int d_=0;d_<ND;++d_) _Pragma("unroll") for(int r=0;r<16;++r)o[d_][r]*=wsf[crow(r,hi)]; } }while(0)
  f32x16 pA0,pA1,pB0,pB1;
  int sl_prev=0,sl_cur=0,sl_next=SLOTB;
  #define ROT() do{sl_prev=sl_cur;sl_cur=sl_next;sl_next=(sl_next==(NSLOT-1)*SLOTB)?0:sl_next+SLOTB;}while(0)
  DMA_K(2,2*SLOTB);
  if constexpr(NV==2){WAIT_BAR(4);}else{WAIT_BAR(3);}
  qkt(pA0,pA1,Kbase,qr,CIN,r32,hi);asm volatile("s_nop 15\n\ts_nop 7":"+v"(pA0),"+v"(pA1));CMASK(pA0,pA1,0);
  START(pA0,pA1);
  _Pragma("unroll") for(int r=0;r<16;++r)pA1[r]=__builtin_amdgcn_exp2f(pA1[r]);
  WAIT_BAR(0);
  DMA_K(3,0);DMA_V(1,SLOTB);
  ROT();
  kload8(kf,kp0+sl_cur);
  if constexpr(NV==2){WAIT_BAR(3);}else{WAIT_BAR(2);}
  s16x4 vlo[8],vhi[8]; u32x4 pw0,pw1,pw2,pw3;
  #define PKW(P,B) cvtpk_s(P[B],P[B+1])
  #define PAF(k) __builtin_bit_cast(bf16x8,pw##k)
  #define VFR(i) (bf16x8){vlo[i][0],vlo[i][1],vlo[i][2],vlo[i][3],vhi[i][0],vhi[i][1],vhi[i][2],vhi[i][3]}
  #define PIN(x) asm volatile("":"+v"(x))
  #define MX3(a,b,c) __builtin_fmaxf(__builtin_fmaxf((a),(b)),(c))
  #define GAPA(MF,A0,A1,A2,A3,W0,W1,PW) do{ MF; sacc+=A0; sacc+=A1; sacc+=A2; sacc+=A3; PIN(sacc); W0; W1; PIN(PW); SBAR(); }while(0)
  #define EX(v) __builtin_amdgcn_exp2f(v)
  #define GAPB(MF,X,B) do{ MF; X[B]=EX(X[B]); X[B+1]=EX(X[B+1]); X[B+2]=EX(X[B+2]); X[B+3]=EX(X[B+3]); PIN(X); SBAR(); }while(0)
  #define VRD(i) do{ vlo[i]=vtr(vp_+(((i)>>2)*4096+((i)&3)*1024)); vhi[i]=vtr(vp_+(((i)>>2)*4096+((i)&3)*1024+512)); }while(0)
  #define VRD2(i) do{ vlo[i]=vtr(vp_+8192+(((i)>>2)*4096+((i)&3)*1024)); vhi[i]=vtr(vp_+8192+(((i)>>2)*4096+((i)&3)*1024+512)); }while(0)
  #define GAPC(MF) do{ MF; SBAR(); }while(0)
  #define KRD(G,j) do{ if(G){ kload2(kf,kp0+sl_next,j); SBAR(); } }while(0)
  #define STEP(C0,C1,P0,P1,t,GK,GV,GL) do{ SBAR(); \
    const lds_cptr vp_=vp0+NV*sl_prev; \
    VRD(0); SBAR(); float sacc=(P0[0]+P0[1]); \
    if constexpr(DV==128){ C0=__builtin_amdgcn_mfma_f32_32x32x16_bf16(kone,qm,zero16,0,0,0); C1=__builtin_amdgcn_mfma_f32_32x32x16_bf16(kone,qm,zero16,0,0,0); SBAR(); } \
    GAPA(C0=__builtin_amdgcn_mfma_f32_32x32x16_bf16(kf[0],qr[0],CIN0(C0),0,0,0), P0[2],P0[3],P0[4],P0[5],     pw0[0]=PKW(P0,0), pw0[1]=PKW(P0,2), pw0); \
    VRD(4); SBAR(); GAPA(C1=__builtin_amdgcn_mfma_f32_32x32x16_bf16(kf[1],qr[0],CIN0(C1),0,0,0), P0[6],P0[7],P0[8],P0[9],     pw0[2]=PKW(P0,4), pw0[3]=PKW(P0,6), pw0); \
    VRD(1); SBAR(); GAPA(C0=__builtin_amdgcn_mfma_f32_32x32x16_bf16(kf[2],qr[1],C0,0,0,0),   P0[10],P0[11],P0[12],P0[13], pw1[0]=PKW(P0,8), pw1[1]=PKW(P0,10), pw1); \
    VRD(5); SBAR(); GAPA(C1=__builtin_amdgcn_mfma_f32_32x32x16_bf16(kf[3],qr[1],C1,0,0,0),   P0[14],P0[15],P1[0],P1[1],   pw1[2]=PKW(P0,12),pw1[3]=PKW(P0,14), pw1); \
    VRD(2); SBAR(); GAPA(C0=__builtin_amdgcn_mfma_f32_32x32x16_bf16(kf[4],qr[2],C0,0,0,0),   P1[2],P1[3],P1[4],P1[5],     pw2[0]=PKW(P1,0), pw2[1]=PKW(P1,2), pw2); \
    VRD(6); SBAR(); GAPA(C1=__builtin_amdgcn_mfma_f32_32x32x16_bf16(kf[5],qr[2],C1,0,0,0),   P1[6],P1[7],P1[8],P1[9],     pw2[2]=PKW(P1,4), pw2[3]=PKW(P1,6), pw2); \
    VRD(3); SBAR(); GAPA(C0=__builtin_amdgcn_mfma_f32_32x32x16_bf16(kf[6],qr[3],C0,0,0,0),   P1[10],P1[11],P1[12],P1[13], pw3[0]=PKW(P1,8), pw3[1]=PKW(P1,10), pw3); \
    VRD(7); SBAR(); GAPA(C1=__builtin_amdgcn_mfma_f32_32x32x16_bf16(kf[7],qr[3],C1,0,0,0),   P1[14],P1[15],0.f,0.f,       pw3[2]=PKW(P1,12),pw3[3]=PKW(P1,14), pw3); \
    l_reg+=sacc; \
    if(GK){DMA_K((t)+3,sl_cur);} if(GV){DMA_V((t)+1,sl_next);} \
    CMASK(C0,C1,t); \
    { float a=MX3(C0[0],C0[1],C1[0]),b=MX3(C0[2],C0[3],C1[1]); a=MX3(a,C1[2],C1[3]); \
      _Pragma("unroll") for(int r=4;r<16;r+=4){a=MX3(a,C0[r],C0[r+1]);b=MX3(b,C0[r+2],C0[r+3]);a=MX3(a,C1[r],C1[r+1]);b=MX3(b,C1[r+2],C1[r+3]);} \
      float rm=__builtin_fmaxf(a,b); { auto rr=__builtin_amdgcn_permlane32_swap(__float_as_uint(rm),__float_as_uint(rm),false,false); rm=__builtin_fmaxf(__uint_as_float(rr[0]),__uint_as_float(rr[1])); } \
      resc=false; \
      if(__builtin_expect(__any(rm>(float)THRL),0)){ const float dl=__builtin_fmaxf(rm,0.f); mhat+=dl; \
        _Pragma("unroll") for(int r=0;r<16;++r){C0[r]-=dl;C1[r]-=dl;} \
        if constexpr(DV==64){ _Pragma("unroll") for(int r=0;r<16;++r)negm[r]=-mhat; asm volatile("":"+v"(negm)); } SETQM(); \
        const float f=__builtin_amdgcn_exp2f(-dl); l_reg*=f; if(hi==0)wsf[r32]=f; resc=true; } } \
    SBAR(); \
    GAPB(o[0]=__builtin_amdgcn_mfma_f32_32x32x16_bf16(PAF(0),VFR(0),o[0],0,0,0), C0,0); \
    GAPB(o[1]=__builtin_amdgcn_mfma_f32_32x32x16_bf16(PAF(0),VFR(4),o[1],0,0,0), C0,4); \
    KRD(GL,0); GAPB(o[0]=__builtin_amdgcn_mfma_f32_32x32x16_bf16(PAF(1),VFR(1),o[0],0,0,0), C0,8); \
    KRD(GL,1); GAPB(o[1]=__builtin_amdgcn_mfma_f32_32x32x16_bf16(PAF(1),VFR(5),o[1],0,0,0), C0,12); \
    KRD(GL,2); GAPB(o[0]=__builtin_amdgcn_mfma_f32_32x32x16_bf16(PAF(2),VFR(2),o[0],0,0,0), C1,0); \
    KRD(GL,3); GAPB(o[1]=__builtin_amdgcn_mfma_f32_32x32x16_bf16(PAF(2),VFR(6),o[1],0,0,0), C1,4); \
    GAPB(o[0]=__builtin_amdgcn_mfma_f32_32x32x16_bf16(PAF(3),VFR(3),o[0],0,0,0), C1,8); \
    GAPB(o[1]=__builtin_amdgcn_mfma_f32_32x32x16_bf16(PAF(3),VFR(7),o[1],0,0,0), C1,12); \
    if constexpr(DV==128){   \
      VRD2(0); VRD2(4); SBAR(); \
      VRD2(1); SBAR(); GAPC(o[2]=__builtin_amdgcn_mfma_f32_32x32x16_bf16(PAF(0),VFR(0),o[2],0,0,0)); \
      VRD2(5); SBAR(); GAPC(o[3]=__builtin_amdgcn_mfma_f32_32x32x16_bf16(PAF(0),VFR(4),o[3],0,0,0)); \
      VRD2(2); SBAR(); GAPC(o[2]=__builtin_amdgcn_mfma_f32_32x32x16_bf16(PAF(1),VFR(1),o[2],0,0,0)); \
      VRD2(6); SBAR(); GAPC(o[3]=__builtin_amdgcn_mfma_f32_32x32x16_bf16(PAF(1),VFR(5),o[3],0,0,0)); \
      VRD2(3); SBAR(); GAPC(o[2]=__builtin_amdgcn_mfma_f32_32x32x16_bf16(PAF(2),VFR(2),o[2],0,0,0)); \
      VRD2(7); SBAR(); GAPC(o[3]=__builtin_amdgcn_mfma_f32_32x32x16_bf16(PAF(2),VFR(6),o[3],0,0,0)); \
      GAPC(o[2]=__builtin_amdgcn_mfma_f32_32x32x16_bf16(PAF(3),VFR(3),o[2],0,0,0)); \
      GAPC(o[3]=__builtin_amdgcn_mfma_f32_32x32x16_bf16(PAF(3),VFR(7),o[3],0,0,0)); } \
    }while(0)
  #define WAIT_KV() do{ if constexpr(NV==2){WAIT_BAR(3);}else{WAIT_BAR(2);} }while(0)
  #define WAIT_V() do{ if constexpr(NV==2){WAIT_BAR(2);}else{WAIT_BAR(1);} }while(0)
  int t=1;
  for(;t+5<NT;t+=2){
    STEP(pB0,pB1,pA0,pA1,t,true,true,true);     WAIT_KV(); RESC(); ROT();
    STEP(pA0,pA1,pB0,pB1,t+1,true,true,true);   WAIT_KV(); RESC(); ROT();
  }
  #define ENDW(tt) do{ if((tt)+3<NT){WAIT_KV();} else if((tt)+2<NT){WAIT_V();} else {WAIT_BAR(0);} }while(0)
  for(;t+1<NT;t+=2){
    STEP(pB0,pB1,pA0,pA1,t,(t+3<NT),(t+1<NT),(t+1<NT));       ENDW(t);   RESC(); ROT();
    STEP(pA0,pA1,pB0,pB1,t+1,(t+4<NT),(t+2<NT),(t+2<NT));     ENDW(t+1); RESC(); ROT();
  }
  STEP(pB0,pB1,pA0,pA1,NT-1,false,false,false); RESC();
  { float sacc=pB0[0]+pB0[1]; _Pragma("unroll") for(int r=2;r<16;++r)sacc+=pB0[r]; _Pragma("unroll") for(int r=0;r<16;++r)sacc+=pB1[r]; l_reg+=sacc;
    pw0=(u32x4){PKW(pB0,0),PKW(pB0,2),PKW(pB0,4),PKW(pB0,6)};pw1=(u32x4){PKW(pB0,8),PKW(pB0,10),PKW(pB0,12),PKW(pB0,14)};pw2=(u32x4){PKW(pB1,0),PKW(pB1,2),PKW(pB1,4),PKW(pB1,6)};pw3=(u32x4){PKW(pB1,8),PKW(pB1,10),PKW(pB1,12),PKW(pB1,14)};
    SBAR(); pv(o,vb0+NV*sl_cur,PAF(0),PAF(1),PAF(2),PAF(3)); if constexpr(DV==128){ pv(o+2,vb0+NV*sl_cur+8192,PAF(0),PAF(1),PAF(2),PAF(3)); } }
  #undef PKW
  #undef PAF
  #undef VFR
  #undef PIN
  #undef MX3
  #undef GAPA
  #undef GAPB
  #undef EX
  #undef VRD
  #undef VRD2
  #undef CIN
  #undef CIN0
  #undef SETQM
  #undef GAPC
  #undef WAIT_KV
  #undef WAIT_V
  #undef KRD
  #undef STEP
  #undef ENDW
  {auto rr=__builtin_amdgcn_permlane32_swap(__float_as_uint(l_reg),__float_as_uint(l_reg),false,false);l_reg=__uint_as_float(rr[0])+__uint_as_float(rr[1]);}
  if(hi==0)wsf[32+r32]=l_reg;asm volatile("s_waitcnt lgkmcnt(0)":::"memory");
  float rli[16];
  #pragma unroll
  for(int r=0;r<16;++r)rli[r]=__builtin_amdgcn_rcpf(wsf[32+crow(r,hi)]);
  {
    bf16*Ow=J.O+(long)(wid*QBLK)*OP;
    bf16*stg=(bf16*)(shm+LDS_OST)+wid*2048;
    bool comb=false; if constexpr(DV==128) comb=J.comb!=0;
    if(!comb){
    #pragma unroll
    for(int hf=0;hf<NV;++hf){
      #pragma unroll
      for(int r=0;r<16;++r){const int orow=crow(r,hi);
        #pragma unroll
        for(int d0=0;d0<2;++d0)stg[orow*64+d0*32+r32]=__float2bfloat16(o[2*hf+d0][r]*rli[r]);}
      asm volatile("s_waitcnt lgkmcnt(0)":::"memory");
      #pragma unroll
      for(int i=0;i<4;++i){const int row=i*8+(lane>>3),ch=lane&7; const u32x4 v=*(const u32x4*)(stg+row*64+ch*8); ATTN_STORE16(Ow+(long)row*OP+hf*64+ch*8,v);}
      asm volatile("s_waitcnt lgkmcnt(0)":::"memory");
    }
    if constexpr(DV==128){ if(J.flag){
      asm volatile("s_waitcnt vmcnt(0) lgkmcnt(0)\n\ts_barrier":::"memory");
      if(wid==0&&lane==0) (void)__hip_atomic_fetch_add(J.flag,1u,__ATOMIC_RELAXED,__HIP_MEMORY_SCOPE_AGENT); } }
    } else { if constexpr(DV==128){
      u32x4 q2[2][4],q1[2][4];
      #pragma unroll
      for(int hf=0;hf<2;++hf){
        #pragma unroll
        for(int r=0;r<16;++r){const int orow=crow(r,hi);
          #pragma unroll
          for(int d0=0;d0<2;++d0)stg[orow*64+d0*32+r32]=__float2bfloat16(o[2*hf+d0][r]*rli[r]);}
        asm volatile("s_waitcnt lgkmcnt(0)":::"memory");
        #pragma unroll
        for(int i=0;i<4;++i){const int row=i*8+(lane>>3),ch=lane&7; q2[hf][i]=*(const u32x4*)(stg+row*64+ch*8);}
        asm volatile("s_waitcnt lgkmcnt(0)":::"memory");
      }
      if(wid==0&&lane==0){ unsigned sp_=0; while(__hip_atomic_load(J.flag,__ATOMIC_RELAXED,__HIP_MEMORY_SCOPE_AGENT)<J.target){ __builtin_amdgcn_s_sleep(1); if(++sp_>(1u<<20))break; } }
      asm volatile("s_waitcnt vmcnt(0) lgkmcnt(0)\n\ts_barrier":::"memory");
      #pragma unroll
      for(int hf=0;hf<2;++hf)
        #pragma unroll
        for(int i=0;i<4;++i){const int row=i*8+(lane>>3),ch=lane&7; const bf16*src=Ow+(long)row*OP+hf*64+ch*8;
          asm volatile("global_load_dwordx4 %0, %1, off sc1":"=v"(q1[hf][i]):"v"(src):"memory");}
      asm volatile("s_waitcnt vmcnt(0)":"+v"(q1[0][0]),"+v"(q1[0][1]),"+v"(q1[0][2]),"+v"(q1[0][3]),"+v"(q1[1][0]),"+v"(q1[1][1]),"+v"(q1[1][2]),"+v"(q1[1][3])::"memory");
      int lam_i=__builtin_amdgcn_readfirstlane(__float_as_int(J.lam)),oml_i=__builtin_amdgcn_readfirstlane(__float_as_int(J.oml)); asm volatile("":"+s"(lam_i),"+s"(oml_i)); const float lam=__int_as_float(lam_i),oml=__int_as_float(oml_i); const int ch=lane&7;
      f32x4_t w4[4];
      #pragma unroll
      for(int hf=0;hf<2;++hf){ w4[2*hf]=*(const f32x4_t*)(J.sw+hf*64+ch*8)*oml; w4[2*hf+1]=*(const f32x4_t*)(J.sw+hf*64+ch*8+4)*oml; }
      #pragma unroll
      for(int i=0;i<4;++i){ float d[16]; float ss=0.f;
        #pragma unroll
        for(int hf=0;hf<2;++hf)
          #pragma unroll
          for(int q=0;q<4;++q){ const unsigned a=q1[hf][i][q],b=q2[hf][i][q];
            d[8*hf+2*q]=__uint_as_float(a<<16)-lam*__uint_as_float(b<<16); d[8*hf+2*q+1]=__uint_as_float(a&0xffff0000u)-lam*__uint_as_float(b&0xffff0000u); }
        #pragma unroll
        for(int e=0;e<16;++e)ss+=d[e]*d[e];
        ss+=__shfl_xor(ss,1); ss+=__shfl_xor(ss,2); ss+=__shfl_xor(ss,4);
        const float rs=__builtin_amdgcn_rsqf(ss*(1.0f/128.0f)+1e-6f);
        #pragma unroll
        for(int hf=0;hf<2;++hf){ u32x4 v;
          #pragma unroll
          for(int q=0;q<4;++q) v[q]=cvtpk_s(d[8*hf+2*q]*rs*w4[2*hf+(q>>1)][(2*q)&3], d[8*hf+2*q+1]*rs*w4[2*hf+(q>>1)][(2*q+1)&3]);
          const int row=i*8+(lane>>3); ATTN_STORE16(Ow+(long)row*OP+hf*64+ch*8,v); } }
    } }
  }
  asm volatile("s_waitcnt lgkmcnt(0)\n\ts_barrier":::"memory");
  #undef DMA_K
  #undef DMA_V
  #undef CMASK
  #undef START
  #undef RESC
  #undef ROT
}
constexpr int ATTN_LDS_BYTES=lds_bytes(128);
#undef SBAR
#undef WAIT_BAR
}
constexpr int NWAVES = 8;
constexpr int NTOK = 8192, NPROMPT = 4096, DM = 1024, DFF = 2816, NUP = 5632, DEPTH = 4, NPART = 32;
constexpr int KVROWS = 4096 + 2 * 2304;
constexpr float NORM_EPS = 1e-6f;
enum { I_XP = 0, I_XS, I_CKD, I_CVD, I_CKG, I_CVG, I_C, I_CCTX, I_MODW, I_MODB, I_NATT, I_NFFN, I_WQD, I_WOD, I_LAMD, I_SUBLN, I_WQG, I_WOG, I_QNG, I_KNG, I_WUP, I_CONVW, I_CONVB, I_WDN, I_FNORM, N_IN };
constexpr size_t OUT_Y = 0, OUT_NKD = 8388608, OUT_NVD = 16777216, OUT_NKG = 25165824, OUT_NVG = 27262976, OUT_TOTAL = 29360128;
constexpr size_t MiB = 1u << 20;
constexpr size_t WS_CTL = 0, CTL_ZERO_BYTES = 65536;
constexpr size_t WS_TAB = 1 * MiB;
constexpr size_t T_MOD = 0;
constexpr size_t T_GA = T_MOD + 4 * 3 * 6144;
constexpr size_t T_GF = T_GA + 4 * 3 * 1024;
constexpr size_t T_BQD = T_GF + 4 * 3 * 1024;
constexpr size_t T_BQG = T_BQD + 2 * 3 * 3072;
constexpr size_t T_BUP = T_BQG + 2 * 3 * 1536;
constexpr size_t T_ROPE = T_BUP + 4 * 3 * 5632;
constexpr size_t T_LAM = T_ROPE + 64 * 16 * 2;
constexpr size_t T_ROWSS = T_LAM + 64;
constexpr size_t T_SSD = T_ROWSS + (size_t)NPART * NTOK;
constexpr size_t T_END = T_SSD + (size_t)NTOK * 16;
static_assert(T_END * 4 <= 8 * MiB, "tables fit their region");
constexpr size_t WS_W = 16 * MiB;
constexpr size_t W_QD = WS_W, W_OD = W_QD + 2 * 6 * MiB, W_QG = W_OD + 2 * 2 * MiB, W_OG = W_QG + 2 * 3 * MiB, W_UP = W_OG + 2 * 2 * MiB, W_DN = W_UP + 4 * 11 * MiB, W_END = W_DN + 4 * 11 * MiB / 2;
static_assert(W_END == 108 * MiB, "weight map");
constexpr size_t WS_X = 112 * MiB, WS_XG = 144 * MiB, WS_Q = 160 * MiB, WS_O = 176 * MiB, WS_K = 192 * MiB, WS_V = 210 * MiB, WS_U = 228 * MiB, WS_H = 316 * MiB, WS_STASH = 360 * MiB, WS_END = 376 * MiB;
constexpr size_t WS_MODP = WS_U + 16 * MiB;
static_assert((size_t)KVROWS * DM * 2 <= 18 * MiB && (size_t)NTOK * NUP * 2 == 88 * MiB && (size_t)NTOK * DFF * 2 == 44 * MiB, "activation map");
constexpr int RING_OFF = 0, RING_BYTES = 131072, LDSCTL_OFF = RING_BYTES, MISC_OFF = LDSCTL_OFF + 320, RSTD_OFF = LDSCTL_OFF + 1024, EDGE_OFF = RSTD_OFF + 8192, LDS_BYTES = 155648;

#define GAS __attribute__((address_space(1)))
#define LAS __attribute__((address_space(3)))
typedef unsigned short bf16;
typedef unsigned v4u __attribute__((ext_vector_type(4)));
typedef float f32x4 __attribute__((ext_vector_type(4)));
typedef short bf16x8 __attribute__((ext_vector_type(8)));
typedef GAS unsigned gu32;
typedef GAS unsigned long long gu64;
#define RLX_AGENT __ATOMIC_RELAXED, __HIP_MEMORY_SCOPE_AGENT
#define LDS_WAIT() asm volatile("s_waitcnt lgkmcnt(0)" ::: "memory")
#define VM_WAIT() asm volatile("s_waitcnt vmcnt(0)" ::: "memory")
__device__ __forceinline__ unsigned long long rt() { return __builtin_amdgcn_s_memrealtime(); }
__device__ __forceinline__ unsigned f2bf(float f) { unsigned u = __builtin_bit_cast(unsigned, f); return (u + 0x7fffu + ((u >> 16) & 1u)) >> 16; }
__device__ __forceinline__ unsigned pk2(float lo, float hi) { return f2bf(lo) | (f2bf(hi) << 16); }

#define XB_TMO      128
#define XB_XCNT(j)  (256  + 64 * (j))
#define XB_XSUB(j)  (1280 + 64 * (j))
#define XB_XGEN(j)  (2304 + 64 * (j))
#define XB_TOP      3328
#define XB_TOPGEN   3392
#define XCD_BAR_WORDS 3456
#define XL_SUB(j)   (3456 + 64 * (j))
#define XL_GEN(j)   (4480 + 64 * (j))
#define XL_UPD(j)   (5504 + 64 * (j))
#define XB_SPIN_CAP (1u << 18)

__device__ __forceinline__ unsigned xb_ld(unsigned* p)              { return __hip_atomic_load(p, __ATOMIC_RELAXED, __HIP_MEMORY_SCOPE_AGENT); }
__device__ __forceinline__ unsigned xb_add(unsigned* p, unsigned v) { return __hip_atomic_fetch_add(p, v, __ATOMIC_RELAXED, __HIP_MEMORY_SCOPE_AGENT); }
__device__ __forceinline__ unsigned xb_xcc_id() { return (unsigned)__builtin_amdgcn_s_getreg((3 << 11) | 20) & 0xFu; }
#define XB_SPIN(cond, bar) do { unsigned _sp = 0; while (cond) { __builtin_amdgcn_s_sleep(1); \
    if ((++_sp & 255u) == 0u) { if (xb_ld(&(bar)[XB_TMO])) break; if (_sp > XB_SPIN_CAP) { atomicAdd(&(bar)[XB_TMO], 1u); break; } } } } while (0)

struct XcdBarrier {
    unsigned* bar; unsigned x;
    volatile LAS unsigned* st;
};

__device__ __forceinline__ XcdBarrier xcd_barrier_post(unsigned* bar, volatile LAS unsigned* st, const bool leader) {
    XcdBarrier b; b.bar = bar; b.x = xb_xcc_id(); b.st = st;
    if (leader) st[2] = xb_add(&bar[XB_XCNT(b.x)], 1u);
    return b;
}
__device__ __forceinline__ void xcd_barrier_complete(unsigned* bar, unsigned x, unsigned& nloc, unsigned& nx, unsigned& vx) {
    const unsigned G = gridDim.x * gridDim.y * gridDim.z;
    unsigned sum, cnt, mine, below, sp = 0u;
    for (;;) {
        sum = 0u; cnt = 0u; mine = 0u; below = 0u;
#pragma unroll
        for (unsigned j = 0; j < 16; ++j) { const unsigned c = xb_ld(&bar[XB_XCNT(j)]); sum += c; cnt += (c > 0u) ? 1u : 0u; mine = (j == x) ? c : mine; below += (c > 0u && j < x) ? 1u : 0u; }
        if (sum == G) break;
        __builtin_amdgcn_s_sleep(1);
        if ((++sp & 255u) == 0u) { if (xb_ld(&bar[XB_TMO])) break; if (sp > XB_SPIN_CAP) { atomicAdd(&bar[XB_TMO], 1u); break; } }
    }
    nloc = mine > 0u ? mine : 1u; nx = cnt > 0u ? cnt : 1u; vx = below;
}

__device__ __forceinline__ void xcd_barrier(const XcdBarrier& b, const bool leader) {
    asm volatile("s_waitcnt vmcnt(0)" ::: "memory");
    __syncthreads();
    if (leader) {
        unsigned* bar = b.bar;
        __builtin_amdgcn_s_waitcnt(0);
        unsigned nloc = b.st[0], nx = b.st[1];
        if (nloc == 0u) { unsigned vx; xcd_barrier_complete(bar, b.x, nloc, nx, vx); b.st[0] = nloc; b.st[1] = nx; b.st[3] = vx; }
        asm volatile("buffer_inv sc1" ::: "memory");
        const unsigned old = xb_add(&bar[XB_XSUB(b.x)], 1u);
        const unsigned gen = old / nloc;
        if (old + 1u == (gen + 1u) * nloc) {
            __builtin_amdgcn_fence(__ATOMIC_RELEASE, "agent");
            asm volatile("s_waitcnt vmcnt(0)" ::: "memory");
            const unsigned og = xb_add(&bar[XB_TOP], 1u);
            const unsigned tg = og / nx;
            if (og + 1u == (tg + 1u) * nx) xb_add(&bar[XB_TOPGEN], 1u);
            else XB_SPIN(xb_ld(&bar[XB_TOPGEN]) == tg, bar);
            xb_add(&bar[XB_XGEN(b.x)], 1u);
        } else {
            XB_SPIN(xb_ld(&bar[XB_XGEN(b.x)]) == gen, bar);
            asm volatile("s_waitcnt vmcnt(0)" ::: "memory");
        }
    }
    __syncthreads();
}

__device__ __forceinline__ void xcd_local_barrier(const XcdBarrier& b, const bool leader, const int flag_word, const int wait0 = -1, const int wait1 = -1, const unsigned target = 0u) {
    asm volatile("s_waitcnt vmcnt(0)" ::: "memory");
    __syncthreads();
    if (leader) {
        unsigned* bar = b.bar;
        __builtin_amdgcn_s_waitcnt(0);
        const unsigned nloc = b.st[0];
        asm volatile("buffer_inv sc1" ::: "memory");
        const unsigned old = xb_add(&bar[XL_SUB(b.x)], 1u);
        const unsigned gen = old / nloc;
        if (old + 1u == (gen + 1u) * nloc) { if (flag_word >= 0) (void)xb_add(&bar[flag_word], 1u); xb_add(&bar[XL_GEN(b.x)], 1u); }
        else XB_SPIN(xb_ld(&bar[XL_GEN(b.x)]) == gen, bar);
        if (wait0 >= 0) { XB_SPIN(xb_ld(&bar[wait0]) < target, bar); XB_SPIN(xb_ld(&bar[wait1]) < target, bar); }
        asm volatile("s_waitcnt vmcnt(0)" ::: "memory");
    }
    __syncthreads();
}
__device__ __forceinline__ void xcd_flag_wait(const XcdBarrier& b, const bool leader, const int w0, const int w1, const unsigned target) {
    if (leader) {
        unsigned* bar = b.bar;
        XB_SPIN(xb_ld(&bar[w0]) < target, bar);
        XB_SPIN(xb_ld(&bar[w1]) < target, bar);
        __builtin_amdgcn_fence(__ATOMIC_ACQUIRE, "agent");
        asm volatile("s_waitcnt vmcnt(0)" ::: "memory");
    }
    __syncthreads();
}

typedef unsigned u32x2v __attribute__((ext_vector_type(2)));
__device__ __forceinline__ float wave_sum(float v) {
#pragma unroll
    for (int o = 1; o < 64; o <<= 1) v += __shfl_xor(v, o);
    return v;
}
__device__ __forceinline__ float bf_lo(unsigned w) { return __uint_as_float(w << 16); }
__device__ __forceinline__ float bf_hi(unsigned w) { return __uint_as_float(w & 0xffff0000u); }
__device__ __forceinline__ float silu_f(float x) { return x / (1.0f + __expf(-x)); }

struct P0Item { const float* W; bf16* WT; int K, N, k0, n0, prow0; };
__device__ __forceinline__ void p0_load(const P0Item& t, int lane, f32x4 (&v)[8]) {
    const int kr = lane >> 3, n4 = (lane & 7) * 4;
#pragma unroll
    for (int i = 0; i < 8; ++i) v[i] = *(const GAS f32x4*)(t.W + (size_t)(t.k0 + kr + 8 * i) * t.N + t.n0 + n4);
}
__device__ __forceinline__ void p0_finish(const P0Item& t, int lane, const f32x4 (&v)[8], LAS float* scr) {
    const int kr = lane >> 3, n4 = (lane & 7) * 4;
#pragma unroll
    for (int i = 0; i < 8; ++i)
#pragma unroll
        for (int e = 0; e < 4; ++e) scr[(n4 + e) * 65 + kr + 8 * i] = v[i][e];
    LDS_WAIT(); asm volatile("" ::: "memory");
    const int c = lane & 7;
#pragma unroll
    for (int j = 0; j < 4; ++j) { const int n = (lane >> 3) + 8 * j; const LAS float* s = scr + n * 65 + 8 * c;
        v4u o; o.x = pk2(s[0], s[1]); o.y = pk2(s[2], s[3]); o.z = pk2(s[4], s[5]); o.w = pk2(s[6], s[7]);
        *(GAS v4u*)(t.WT + (size_t)(t.prow0 + n) * t.K + t.k0 + 8 * c) = o; }
    LDS_WAIT(); asm volatile("" ::: "memory");
}
__device__ __forceinline__ int phys_gqa(int n0) { const int w = n0 & 255; return (n0 & ~255) + 128 * ((w & 63) >> 5) + 32 * (w >> 6); }
__device__ __forceinline__ int phys_up(int n0) { return n0 < DFF ? 256 * (n0 >> 7) + (n0 & 127) : 256 * ((n0 - DFF) >> 7) + 128 + ((n0 - DFF) & 127); }

#ifndef PH_MASK
#define PH_MASK 0xfff
#endif
#define PH_EN(b) ((PH_MASK >> (b)) & 1)

#define FILL_RSTD(S) do { _Pragma("unroll") for (int h_ = 0; h_ < 2; ++h_) {     \
        const int iA_ = __builtin_amdgcn_readfirstlane((h_ * 1024 + tid) >> 8), iB_ = iA_ + 2; pg8::Unit uA_, uB_; const bool vA_ = (S).next(iA_, uA_), vB_ = (S).next(iB_, uB_); if (!vA_) break; \
        const int rA_ = uA_.pm * 256 + (tid & 255), rB_ = (vB_ ? uB_.pm : uA_.pm) * 256 + (tid & 255); float sA_ = 0.f, sB_ = 0.f; \
        { f32x4 qa_[NPART / 4], qb_[NPART / 4]; _Pragma("unroll") for (int p_ = 0; p_ < NPART / 4; ++p_) { qa_[p_] = *(const f32x4*)(rowss + (size_t)rA_ * NPART + 4 * p_); qb_[p_] = *(const f32x4*)(rowss + (size_t)rB_ * NPART + 4 * p_); } \
          _Pragma("unroll") for (int p_ = 0; p_ < NPART / 4; ++p_) { sA_ += (qa_[p_][0] + qa_[p_][1]) + (qa_[p_][2] + qa_[p_][3]); sB_ += (qb_[p_][0] + qb_[p_][1]) + (qb_[p_][2] + qb_[p_][3]); } } \
        ((LAS float*)(L + RSTD_OFF))[iA_ * 256 + (tid & 255)] = __builtin_amdgcn_rsqf(sA_ * (1.0f / DM) + NORM_EPS); \
        if (vB_) ((LAS float*)(L + RSTD_OFF))[iB_ * 256 + (tid & 255)] = __builtin_amdgcn_rsqf(sB_ * (1.0f / DM) + NORM_EPS); } __syncthreads(); } while (0)
struct Args { const float* in[N_IN]; float* out; unsigned char* ws; int ph_lo, ph_hi; };
static_assert(sizeof(Args) == (N_IN + 2) * 8 + 8, "Args has no padding");

constexpr int PH_LAYER0 = 3, PH_PER_LAYER = 7, PH_FINAL = PH_LAYER0 + DEPTH * PH_PER_LAYER, N_PHASES = PH_FINAL + 1;

__global__ void __launch_bounds__(NWAVES * 64, 2) skel_fwd(Args args) {
    extern __shared__ __attribute__((aligned(16))) unsigned char lds[];
    LAS unsigned char* const L = (LAS unsigned char*)lds;
    volatile LAS unsigned* const MISC = (volatile LAS unsigned*)(L + MISC_OFF);
    const int tid0 = threadIdx.x; const int wave0 = __builtin_amdgcn_readfirstlane(tid0 >> 6);
    const int G = gridDim.x; const int vcu = (G % 8 == 0) ? ((int)blockIdx.x % 8) * (G / 8) + (int)blockIdx.x / 8 : (int)blockIdx.x;
    const int NGW = G * NWAVES, NGT = G * NWAVES * 64;
    gu32* const ctl = (gu32*)(args.ws + WS_CTL);
    for (int u = tid0; u < (LDS_BYTES - LDSCTL_OFF) / 4; u += NWAVES * 64) ((LAS unsigned*)(L + LDSCTL_OFF))[u] = 0u;
    __syncthreads();
    const bool single = (args.ph_hi - args.ph_lo) > 1;
    XcdBarrier bar; bar.bar = (unsigned*)(ctl + 1024); bar.x = 0; bar.st = nullptr;
    if (single) bar = xcd_barrier_post((unsigned*)(ctl + 1024), MISC + 8, tid0 == 0);


#define PHASE_BEGIN(IDX, KIND) { int lo_ = args.ph_lo, hi_ = args.ph_hi; asm volatile("" : "+s"(lo_), "+s"(hi_));     \
    if (lo_ <= (IDX) && (IDX) < hi_) { \
        if ((IDX) > lo_) { int w0_ = wave0; asm volatile("" : "+s"(w0_)); const bool leader_ = w0_ == 0 && lane_id_opaque() == 0; \
            if ((KIND) == 0) xcd_barrier(bar, leader_); else if ((KIND) == 1) xcd_local_barrier(bar, leader_, -1); \
            else {   \
                const int nx_ = (int)MISC[9], vx_ = (int)MISC[11], pl_ = (16 * vx_ + nx_ - 1) / nx_, ph_ = (16 * (vx_ + 1) + nx_ - 1) / nx_; \
                const int below_ = (pl_ & 7) ? (pl_ - 1) : pl_, above_ = (ph_ & 7) ? ph_ : pl_;                             \
                xcd_local_barrier(bar, leader_, (int)XL_UPD(vx_), (int)XL_UPD((below_ * nx_) >> 4), (int)XL_UPD((above_ * nx_) >> 4), (unsigned)(KIND) - 1u); } } \
        int tid = wave0 * 64 + lane_id_opaque(); asm volatile("" : "+v"(tid)); \
        GAS unsigned char* wsg = (GAS unsigned char*)args.ws; asm volatile("" : "+s"(wsg)); unsigned char* const ws = (unsigned char*)wsg; \
        const int lane = tid & 63, wave = __builtin_amdgcn_readfirstlane(tid >> 6); \
        const int gw = vcu * NWAVES + wave, gt = vcu * (NWAVES * 64) + tid; (void)lane; (void)gw; (void)gt; \
        float* const TAB = (float*)(ws + WS_TAB); \
        bf16* const X16 = (bf16*)(ws + WS_X); bf16* const XG = (bf16*)(ws + WS_XG); bf16* const Qb = (bf16*)(ws + WS_Q); bf16* const Ob = (bf16*)(ws + WS_O); \
        bf16* const Kb = (bf16*)(ws + WS_K); bf16* const Vb = (bf16*)(ws + WS_V); bf16* const Ub = (bf16*)(ws + WS_U); bf16* const Hb = (bf16*)(ws + WS_H); \
        float* const rowss = TAB + T_ROWSS; float* const ssd = TAB + T_SSD; (void)X16; (void)XG; (void)Qb; (void)Ob; (void)Kb; (void)Vb; (void)Ub; (void)Hb; (void)rowss; (void)ssd;
#define PHASE_END } }
#define XCD_IDS int nloc = __builtin_amdgcn_readfirstlane((int)MISC[8]), nxc = __builtin_amdgcn_readfirstlane((int)MISC[9]), rk = __builtin_amdgcn_readfirstlane((int)MISC[10]), vx = __builtin_amdgcn_readfirstlane((int)MISC[11]); \
        if (nloc == 0) { nloc = G >> 3; nxc = 8; rk = (int)blockIdx.x >> 3; vx = (int)blockIdx.x & 7; }     \
        const int plo = (16 * vx + nxc - 1) / nxc, pn16 = (16 * (vx + 1) + nxc - 1) / nxc - plo; (void)rk; (void)nloc; (void)pn16
#define XCD_ROW(IDX_) ((((IDX_) >> 8) < pn16 ? plo + ((IDX_) >> 8) : 16 + plo + ((IDX_) >> 8) - pn16) * 256 + ((IDX_) & 255))
    PHASE_BEGIN(0, 0) if (PH_EN(0)) {
            LAS float* scr = (LAS float*)(L + RING_OFF + wave * 16384);
            constexpr int IQD = 16 * 96, IOD = 16 * 32, IQG = 16 * 48, IUP = 16 * 176, IDN = 44 * 32;
            constexpr int NITEMS = 2 * IQD + 2 * IOD + 2 * IQG + 2 * IOD + 4 * IUP + 4 * IDN;
#define P0_DECODE(IT, T) do { int r = (IT); \
                if (r < 2 * IQD) { const int j = r / IQD; r -= j * IQD; T = P0Item{args.in[I_WQD] + (size_t)j * DM * 3072, (bf16*)(ws + W_QD) + (size_t)j * 3072 * DM, DM, 3072, 64 * (r / 96), 32 * (r % 96), 32 * (r % 96)}; break; } r -= 2 * IQD; \
                if (r < 2 * IOD) { const int j = r / IOD; r -= j * IOD; T = P0Item{args.in[I_WOD] + (size_t)j * DM * DM, (bf16*)(ws + W_OD) + (size_t)j * DM * DM, DM, DM, 64 * (r / 32), 32 * (r % 32), 32 * (r % 32)}; break; } r -= 2 * IOD; \
                if (r < 2 * IQG) { const int j = r / IQG; r -= j * IQG; T = P0Item{args.in[I_WQG] + (size_t)j * DM * 1536, (bf16*)(ws + W_QG) + (size_t)j * 1536 * DM, DM, 1536, 64 * (r / 48), 32 * (r % 48), phys_gqa(32 * (r % 48))}; break; } r -= 2 * IQG; \
                if (r < 2 * IOD) { const int j = r / IOD; r -= j * IOD; T = P0Item{args.in[I_WOG] + (size_t)j * DM * DM, (bf16*)(ws + W_OG) + (size_t)j * DM * DM, DM, DM, 64 * (r / 32), 32 * (r % 32), 32 * (r % 32)}; break; } r -= 2 * IOD; \
                if (r < 4 * IUP) { const int l_ = r / IUP; r -= l_ * IUP; T = P0Item{args.in[I_WUP] + (size_t)l_ * DM * NUP, (bf16*)(ws + W_UP) + (size_t)l_ * NUP * DM, DM, NUP, 64 * (r / 176), 32 * (r % 176), phys_up(32 * (r % 176))}; break; } r -= 4 * IUP; \
                { const int l_ = r / IDN; r -= l_ * IDN; T = P0Item{args.in[I_WDN] + (size_t)l_ * DFF * DM, (bf16*)(ws + W_DN) + (size_t)l_ * DM * DFF, DFF, DM, 64 * (r / 32), 32 * (r % 32), 32 * (r % 32)}; } } while (0)
            { P0Item tA, tB; f32x4 vA[8], vB[8]; int it = gw < NITEMS ? gw : NITEMS - 1;
              P0_DECODE(it, tA); p0_load(tA, lane, vA);
              for (int i0 = gw; i0 < NITEMS; i0 += 2 * NGW) {
                  const int iB = i0 + NGW, iA = i0 + 2 * NGW;
                  { const int j = iB < NITEMS ? iB : NITEMS - 1; P0_DECODE(j, tB); p0_load(tB, lane, vB); }
                  p0_finish(tA, lane, vA, scr);
                  { const int j = iA < NITEMS ? iA : NITEMS - 1; P0_DECODE(j, tA); p0_load(tA, lane, vA); }
                  if (iB < NITEMS) p0_finish(tB, lane, vB, scr); } }
#undef P0_DECODE
            for (int it = gw; it < 4 * 24 * 32; it += NGW) {
                const int kc = it & 31, nb = (it >> 5) % 24, l = it / (32 * 24);
                const int k = kc * 32 + (lane & 31);
                const float sv0 = silu_f(args.in[I_CCTX][k]), sv1 = silu_f(args.in[I_C][k]), sv2 = silu_f(args.in[I_C][DM + k]);
                const float* wp = args.in[I_MODW] + ((size_t)l * DM + kc * 32) * 6144 + nb * 256 + lane * 4;
                f32x4 w[32];
#pragma unroll
                for (int kk = 0; kk < 32; ++kk) w[kk] = *(const GAS f32x4*)(wp + (size_t)kk * 6144);
                f32x4 a0 = {0.f, 0.f, 0.f, 0.f}, a1 = a0, a2 = a0;
#pragma unroll
                for (int kk = 0; kk < 32; ++kk) { a0 += w[kk] * __shfl(sv0, kk); a1 += w[kk] * __shfl(sv1, kk); a2 += w[kk] * __shfl(sv2, kk); }
                float* pp = (float*)(ws + WS_MODP) + ((size_t)(kc * 4 + l) * 3) * 6144 + nb * 256 + lane * 4;
                *(f32x4*)pp = a0; *(f32x4*)(pp + 6144) = a1; *(f32x4*)(pp + 2 * 6144) = a2;
            }
            for (int e = gt; e < 64 * 16; e += NGT) { const int pos = e >> 4, i = e & 15; const float inv = powf(10000.0f, -(float)i * (1.0f / 16.0f)); const float ang = (float)pos * inv;
                TAB[T_ROPE + 2 * e] = cosf(ang); TAB[T_ROPE + 2 * e + 1] = sinf(ang); }
            if (gw < 2) { const float* lp = args.in[I_LAMD] + gw * 256; const float a = wave_sum(lp[lane] * lp[64 + lane]), b = wave_sum(lp[128 + lane] * lp[192 + lane]);
                const float lam_init = 0.8f - 0.6f * expf(-0.3f * (float)(2 * gw)); if (lane == 0) TAB[T_LAM + gw] = expf(a) - expf(b) + lam_init; }
    } PHASE_END
    PHASE_BEGIN(1, 0) if (PH_EN(1)) {
            for (int e = gt; e < 4 * 3 * 6144; e += NGT) { const int n = e % 6144, lv = e / 6144, l = lv / 3;
                float s = args.in[I_MODB][l * 6144 + n];
#pragma unroll
                for (int kc = 0; kc < 32; ++kc) s += ((const float*)(ws + WS_MODP))[(size_t)kc * (4 * 3 * 6144) + e];
                TAB[T_MOD + e] = s;
                if (n >= 1024 && n < 2048) TAB[T_GA + lv * 1024 + (n - 1024)] = args.in[I_NATT][l * 1024 + (n - 1024)] * (1.0f + s);
                if (n >= 4096 && n < 5120) TAB[T_GF + lv * 1024 + (n - 4096)] = args.in[I_NFFN][l * 1024 + (n - 4096)] * (1.0f + s); }
    } PHASE_END
    PHASE_BEGIN(2, 0) if (PH_EN(2)) {
            for (int mat = 0; mat < 8; ++mat) {
                const int kind = mat < 2 ? 0 : (mat < 4 ? 1 : 2), idx = mat < 2 ? mat : (mat < 4 ? mat - 2 : mat - 4);
                const int nrows = kind == 0 ? 3072 : (kind == 1 ? 1536 : NUP), l = kind == 0 ? 2 * idx : (kind == 1 ? 2 * idx + 1 : idx);
                const bf16* WT = kind == 0 ? (const bf16*)(ws + W_QD) + (size_t)idx * 3072 * DM : (kind == 1 ? (const bf16*)(ws + W_QG) + (size_t)idx * 1536 * DM : (const bf16*)(ws + W_UP) + (size_t)idx * NUP * DM);
                float* outb = TAB + (kind == 0 ? T_BQD + (size_t)idx * 3 * 3072 : (kind == 1 ? T_BQG + (size_t)idx * 3 * 1536 : T_BUP + (size_t)idx * 3 * NUP));
                const float* sh = TAB + T_MOD + (size_t)l * 3 * 6144 + (kind == 2 ? 3072 : 0) + lane * 16;
                f32x4 s[3][4];
#pragma unroll
                for (int v = 0; v < 3; ++v)
#pragma unroll
                    for (int q = 0; q < 4; ++q) s[v][q] = *(const f32x4*)(sh + v * 6144 + 4 * q);
                for (int p0 = gw; p0 < nrows; p0 += 3 * NGW) {
                    v4u w0[3], w1[3]; float d[3][3];
#pragma unroll
                    for (int r = 0; r < 3; ++r) { const int p = (p0 + r * NGW < nrows) ? p0 + r * NGW : nrows - 1;
                        w0[r] = *(const GAS v4u*)(WT + (size_t)p * DM + lane * 16); w1[r] = *(const GAS v4u*)(WT + (size_t)p * DM + lane * 16 + 8); }
#pragma unroll
                    for (int r = 0; r < 3; ++r) { float wf[16];
#pragma unroll
                        for (int q = 0; q < 4; ++q) { wf[2 * q] = bf_lo(w0[r][q]); wf[2 * q + 1] = bf_hi(w0[r][q]); wf[8 + 2 * q] = bf_lo(w1[r][q]); wf[8 + 2 * q + 1] = bf_hi(w1[r][q]); }
#pragma unroll
                        for (int v = 0; v < 3; ++v) { float a = 0.f;
#pragma unroll
                            for (int q = 0; q < 4; ++q) a += (s[v][q][0] * wf[4 * q] + s[v][q][1] * wf[4 * q + 1]) + (s[v][q][2] * wf[4 * q + 2] + s[v][q][3] * wf[4 * q + 3]);
                            d[r][v] = a; } }
#pragma unroll
                    for (int o = 1; o < 64; o <<= 1)
#pragma unroll
                        for (int r = 0; r < 3; ++r)
#pragma unroll
                            for (int v = 0; v < 3; ++v) d[r][v] += __shfl_xor(d[r][v], o);
                    if (lane == 0) {
#pragma unroll
                        for (int r = 0; r < 3; ++r) { const int p = p0 + r * NGW; if (p < nrows) { outb[p] = d[r][0]; outb[nrows + p] = d[r][1]; outb[2 * nrows + p] = d[r][2]; } } }
                }
            }
            for (int mb = gw; mb < NTOK; mb += 4 * NGW) { f32x4 x[4][4], g[4][4]; int mr[4];
#pragma unroll
                for (int r = 0; r < 4; ++r) { const int m = (mb + r * NGW < NTOK) ? mb + r * NGW : mb; mr[r] = m;
                    const float* xr = (m < NPROMPT ? args.in[I_XP] + (size_t)m * DM : args.in[I_XS] + (size_t)(m - NPROMPT) * DM);
                    const float* ga = TAB + T_GA + (m < NPROMPT ? 0 : 1 + ((m - NPROMPT) >> 11)) * 1024;
#pragma unroll
                    for (int j = 0; j < 4; ++j) { x[r][j] = *(const GAS f32x4*)(xr + 256 * j + 4 * lane); g[r][j] = *(const f32x4*)(ga + 256 * j + 4 * lane); } }
#pragma unroll
                for (int r = 0; r < 4; ++r) { if (r > 0 && mb + r * NGW >= NTOK) break; const int m = mr[r]; float ss = 0.f;
#pragma unroll
                    for (int j = 0; j < 4; ++j) { const f32x4 xv = x[r][j], gv = g[r][j];
                        { u32x2v w0; w0.x = pk2(xv[0], xv[1]); w0.y = pk2(xv[2], xv[3]); *(GAS u32x2v*)(X16 + (size_t)m * DM + 256 * j + 4 * lane) = w0; } ss += (xv[0] * xv[0] + xv[1] * xv[1]) + (xv[2] * xv[2] + xv[3] * xv[3]);
                        u32x2v w; w.x = pk2(xv[0] * gv[0], xv[1] * gv[1]); w.y = pk2(xv[2] * gv[2], xv[3] * gv[3]); *(GAS u32x2v*)(XG + (size_t)m * DM + 256 * j + 4 * lane) = w; }
                    ss = wave_sum(ss);
                    if (lane < NPART) rowss[(size_t)m * NPART + lane] = lane == 0 ? ss : 0.f; } }
    } PHASE_END
    for (int l = 0; l < DEPTH; ++l) { const int j = l >> 1, pb = PH_LAYER0 + PH_PER_LAYER * l; const bool diff = (l & 1) == 0;
        PHASE_BEGIN(pb + 0, (l == 0 ? 0 : 1))
                XCD_IDS;
                if (diff) { if (PH_EN(3)) {
                    if (l == 0) for (int e = gt; e < 2 * 8 * 256 * 32; e += NGT) { const int d4 = e & 31, p = (e >> 5) & 255, h = (e >> 13) & 7, b = e >> 16;
                        const size_t src = ((((size_t)b * 2 + j) * 8 + h) * 256 + p) * 128 + d4 * 4, dst = ((size_t)(4096 + b * 2304 + p)) * DM + h * 128 + d4 * 4;
                        const f32x4 k = *(const GAS f32x4*)(args.in[I_CKD] + src), vv = *(const GAS f32x4*)(args.in[I_CVD] + src);
                        u32x2v w; w.x = pk2(k[0], k[1]); w.y = pk2(k[2], k[3]); *(GAS u32x2v*)(Kb + dst) = w; w.x = pk2(vv[0], vv[1]); w.y = pk2(vv[2], vv[3]); *(GAS u32x2v*)(Vb + dst) = w; }
                    pg8::Gemm g{XG, (const bf16*)(ws + W_QD) + (size_t)j * 3072 * DM, NTOK, 3072, DM};
                    pg8::XcdOrder S{plo, pn16, 24, rk, nloc, (pn16 == 2 && nloc == 32) ? 1 : 0};

                    FILL_RSTD(S);
                    pg8::EpiQkvDiff E{Qb, Kb, Vb, TAB + T_BQD + (size_t)j * 3 * 3072, (const LAS float*)(L + RSTD_OFF), TAB + T_ROPE, args.out + OUT_NKD + (size_t)j * 8 * 256 * 128, args.out + OUT_NVD + (size_t)j * 8 * 256 * 128};
                    pg8::gemm_phase<pg8::EpiQkvDiff, pg8::XcdOrder, true, true, true>(L + RING_OFF, g, S, E, wave0);
                } } else if (PH_EN(4)) {
                    if (l == 0) for (int e = gt; e < 2 * 4 * 256 * 16; e += NGT) { const int d4 = e & 15, p = (e >> 4) & 255, h = (e >> 12) & 3, b = e >> 14;
                        const size_t src = ((((size_t)b * 2 + j) * 4 + h) * 256 + p) * 64 + d4 * 4, dst = ((size_t)(4096 + b * 2304 + p)) * 256 + h * 64 + d4 * 4;
                        const f32x4 k = *(const GAS f32x4*)(args.in[I_CKG] + src), vv = *(const GAS f32x4*)(args.in[I_CVG] + src);
                        u32x2v w; w.x = pk2(k[0], k[1]); w.y = pk2(k[2], k[3]); *(GAS u32x2v*)(Kb + dst) = w; w.x = pk2(vv[0], vv[1]); w.y = pk2(vv[2], vv[3]); *(GAS u32x2v*)(Vb + dst) = w; }
                    pg8::Gemm g{XG, (const bf16*)(ws + W_QG) + (size_t)j * 1536 * DM, NTOK, 1536, DM}; pg8::XcdOrder S{plo, pn16, 6, rk, nloc, 0};
                    FILL_RSTD(S);
                    pg8::EpiQkvGqa E{Qb, Kb, Vb, TAB + T_BQG + (size_t)j * 3 * 1536, (const LAS float*)(L + RSTD_OFF), TAB + T_ROPE, args.in[I_QNG] + j * 64, args.in[I_KNG] + j * 64,
                                     args.out + OUT_NKG + (size_t)j * 4 * 256 * 64, args.out + OUT_NVG + (size_t)j * 4 * 256 * 64};
                    pg8::gemm_phase<pg8::EpiQkvGqa, pg8::XcdOrder, true, true>(L + RING_OFF, g, S, E, wave0);
                }
        PHASE_END
        PHASE_BEGIN(pb + 1, 0) if (PH_EN(5)) {
                static_assert(attn_body::ATTN_LDS_BYTES <= RING_BYTES, "attention LDS inside the ring region");
                const float oml = __int_as_float(__builtin_amdgcn_readfirstlane(__float_as_int(1.0f - (0.8f - 0.6f * expf(-0.3f * (float)l))))), lam = __int_as_float(__builtin_amdgcn_readfirstlane(__float_as_int(diff ? TAB[T_LAM + j] : 0.f)));
                for (int u = vcu; u < 512; u += G) {
                    attn_body::AttnJob J; const bool lat = u < 256; const int uu = u & 255; int m0, k0; J.comb = 0; J.flag = nullptr; J.target = 0u; J.lam = lam; J.oml = oml; J.sw = args.in[I_SUBLN] + j * 128;
                    if (diff) { int b, h, p; if (lat) { b = uu >> 7; h = (uu >> 4) & 7; const int qb = (uu >> 1) & 7; p = uu & 1; m0 = NPROMPT + b * 2048 + qb * 256; k0 = NPROMPT + b * 2304; }
                                else { b = uu >> 4; h = (uu >> 1) & 7; p = uu & 1; m0 = b * 256; k0 = m0; }
                        J.Q = (const attn_body::bf16*)Qb + (size_t)m0 * DM + h * 128 + p * 64; J.QP = DM; J.K = (const attn_body::bf16*)Kb + (size_t)k0 * DM + h * 128 + p * 64; J.KP = DM;
                        J.V = (const attn_body::bf16*)Vb + (size_t)k0 * DM + h * 128; J.VP = DM; J.O = (attn_body::bf16*)Ob + (size_t)m0 * DM + h * 128; J.OP = DM; J.NT = lat ? 36 : 4;
                        J.comb = p; J.flag = (unsigned*)(ws + WS_CTL) + 8192 + (u >> 1); J.target = (unsigned)(j + 1);
                        attn_body::attn_unit<8, 128>(J, (char*)lds + RING_OFF, wave0); }
                    else { int b, hq; if (lat) { b = uu >> 7; hq = (uu >> 3) & 15; const int qb = uu & 7; m0 = NPROMPT + b * 2048 + qb * 256; k0 = NPROMPT + b * 2304; } else { b = uu >> 4; hq = uu & 15; m0 = b * 256; k0 = m0; }
                        J.Q = (const attn_body::bf16*)Qb + (size_t)m0 * DM + hq * 64; J.QP = DM; J.K = (const attn_body::bf16*)Kb + (size_t)k0 * 256 + (hq >> 2) * 64; J.KP = 256;
                        J.V = (const attn_body::bf16*)Vb + (size_t)k0 * 256 + (hq >> 2) * 64; J.VP = 256; J.O = (attn_body::bf16*)Ob + (size_t)m0 * DM + hq * 64; J.OP = DM; J.NT = lat ? 36 : 4;
                        attn_body::attn_unit<8, 64>(J, (char*)lds + RING_OFF, wave0); }
                }
        } PHASE_END
        PHASE_BEGIN(pb + 3, 0) if (PH_EN(7)) { XCD_IDS;
                pg8::Gemm g{Ob, (const bf16*)(ws + (diff ? W_OD : W_OG)) + (size_t)j * DM * DM, NTOK, DM, DM}; pg8::XcdOrder S{plo, pn16, 8, rk, nloc, 0};
                pg8::EpiResid E{X16, XG, TAB + T_MOD + (size_t)l * 3 * 6144 + 2048, 6144, TAB + T_GF + (size_t)l * 3 * 1024, rowss};
                const int ln_ = l + 1, jn_ = ln_ >> 1; const bool dn_ = (ln_ & 1) == 0; const int nit_ = ln_ < DEPTH ? (dn_ ? 2 * 8 * 256 * 32 : 2 * 4 * 256 * 16) : 0;
#define KV_ITEM(E_, SRC_, DST_) do { if (dn_) { const int d4 = (E_) & 31, p = ((E_) >> 5) & 255, h = ((E_) >> 13) & 7, b = (E_) >> 16; \
                        SRC_ = ((((size_t)b * 2 + jn_) * 8 + h) * 256 + p) * 128 + d4 * 4; DST_ = ((size_t)(4096 + b * 2304 + p)) * DM + h * 128 + d4 * 4; } \
                    else { const int d4 = (E_) & 15, p = ((E_) >> 4) & 255, h = ((E_) >> 12) & 3, b = (E_) >> 14; \
                        SRC_ = ((((size_t)b * 2 + jn_) * 4 + h) * 256 + p) * 64 + d4 * 4; DST_ = ((size_t)(4096 + b * 2304 + p)) * 256 + h * 64 + d4 * 4; } } while (0)
                const float* cks_ = args.in[dn_ ? I_CKD : I_CKG]; const float* cvs_ = args.in[dn_ ? I_CVD : I_CVG];
                f32x4 ck_ = {0.f, 0.f, 0.f, 0.f}, cv_ = ck_; size_t cdst_ = 0; const bool cok_ = gt < nit_;
                if (cok_) { size_t src_; KV_ITEM(gt, src_, cdst_); ck_ = *(const GAS f32x4*)(cks_ + src_); cv_ = *(const GAS f32x4*)(cvs_ + src_); }
                pg8::gemm_phase<pg8::EpiResid, pg8::XcdOrder, true, true, true>(L + RING_OFF, g, S, E, wave0);
                if (cok_) { u32x2v w; w.x = pk2(ck_[0], ck_[1]); w.y = pk2(ck_[2], ck_[3]); *(GAS u32x2v*)(Kb + cdst_) = w; w.x = pk2(cv_[0], cv_[1]); w.y = pk2(cv_[2], cv_[3]); *(GAS u32x2v*)(Vb + cdst_) = w; }
                for (int e = gt + NGT; e < nit_; e += NGT) { size_t src_, dst_; KV_ITEM(e, src_, dst_); const f32x4 k = *(const GAS f32x4*)(cks_ + src_), vv = *(const GAS f32x4*)(cvs_ + src_);
                    u32x2v w; w.x = pk2(k[0], k[1]); w.y = pk2(k[2], k[3]); *(GAS u32x2v*)(Kb + dst_) = w; w.x = pk2(vv[0], vv[1]); w.y = pk2(vv[2], vv[3]); *(GAS u32x2v*)(Vb + dst_) = w; }
#undef KV_ITEM
        } PHASE_END
        PHASE_BEGIN(pb + 4, 1) if (PH_EN(8)) { XCD_IDS;
                pg8::Gemm g{XG, (const bf16*)(ws + W_UP) + (size_t)l * NUP * DM, NTOK, NUP, DM}; pg8::XcdOrder S{plo, pn16, 22, rk, nloc, 0};
                FILL_RSTD(S);
                pg8::EpiUpConv E{Hb, TAB + T_BUP + (size_t)l * 3 * NUP, args.in[I_CONVW] + (size_t)l * 3 * NUP, args.in[I_CONVB] + (size_t)l * NUP, (const LAS float*)(L + RSTD_OFF), (LAS float*)(L + EDGE_OFF), (float*)Ub};
                pg8::gemm_phase<pg8::EpiUpConv, pg8::XcdOrder, true, true>(L + RING_OFF, g, S, E, wave0);
        } PHASE_END
        PHASE_BEGIN(pb + 6, (2 + l)) if (PH_EN(10)) { XCD_IDS;
                pg8::Gemm g{Hb, (const bf16*)(ws + W_DN) + (size_t)l * DM * DFF, NTOK, DM, DFF}; pg8::XcdOrder S{plo, pn16, 8, rk, nloc, 0};
                { pg8::Unit uu; const float* ue = (const float*)Ub; const float* cw = args.in[I_CONVW] + (size_t)l * 3 * NUP; const float* cb = args.in[I_CONVB] + (size_t)l * NUP;
                  for (int i = 0; S.next(i, uu); ++i) { if (uu.pm < 16) continue; const int qb = (uu.pm - 16) & 7;
                    u32x2v hq[3]; bool doit[3]; size_t hoff[3];
#pragma unroll
                    for (int k = 0; k < 3; ++k) { int idx = tid + NWAVES * 64 * k; const bool ok_ = idx < 2 * (DFF / 4); idx = ok_ ? idx : 2 * (DFF / 4) - 1;
                        const int which = idx >= DFF / 4 ? 1 : 0, c4 = 4 * (idx - (DFF / 4) * which);
                        doit[k] = ok_ && !(which == 0 ? qb == 0 : qb == 7);
                        const int pc = 256 * (c4 >> 7) + (c4 & 127);
                        const float* r0 = ue + ((size_t)(which == 0 ? (uu.pm - 1) * 4 + 3 : uu.pm * 4 + 2)) * NUP + pc;
                        const float* r1 = ue + ((size_t)(which == 0 ? uu.pm * 4 + 0 : uu.pm * 4 + 3)) * NUP + pc;
                        const float* r2 = ue + ((size_t)(which == 0 ? uu.pm * 4 + 1 : (uu.pm + 1) * 4 + 0)) * NUP + pc;
                        const f32x4 a0 = *(const f32x4*)r0, a1 = *(const f32x4*)r1, a2 = *(const f32x4*)r2, b0 = *(const f32x4*)(r0 + 128), b1 = *(const f32x4*)(r1 + 128), b2 = *(const f32x4*)(r2 + 128);
                        const f32x4 wg0 = *(const f32x4*)(cw + c4), wg1 = *(const f32x4*)(cw + NUP + c4), wg2 = *(const f32x4*)(cw + 2 * NUP + c4), cg = *(const f32x4*)(cb + c4);
                        const f32x4 wv0 = *(const f32x4*)(cw + DFF + c4), wv1 = *(const f32x4*)(cw + NUP + DFF + c4), wv2 = *(const f32x4*)(cw + 2 * NUP + DFF + c4), cv = *(const f32x4*)(cb + DFF + c4);
                        const f32x4 gg = a0 * wg0 + a1 * wg1 + a2 * wg2 + cg, vv = b0 * wv0 + b1 * wv1 + b2 * wv2 + cv;
                        hq[k].x = pk2(silu_f(gg[0]) * vv[0], silu_f(gg[1]) * vv[1]); hq[k].y = pk2(silu_f(gg[2]) * vv[2], silu_f(gg[3]) * vv[3]);
                        hoff[k] = (size_t)(uu.pm * 256 + (which ? 255 : 0)) * DFF + c4; }
#pragma unroll
                    for (int k = 0; k < 3; ++k) if (doit[k]) *(GAS u32x2v*)(Hb + hoff[k]) = hq[k]; }
                  VM_WAIT(); __syncthreads(); }
                pg8::EpiResid E{X16, XG, TAB + T_MOD + (size_t)l * 3 * 6144 + 5120, 6144, l + 1 < DEPTH ? TAB + T_GA + (size_t)(l + 1) * 3 * 1024 : nullptr, rowss};
                pg8::gemm_phase<pg8::EpiResid, pg8::XcdOrder, true, true, true>(L + RING_OFF, g, S, E, wave0);
        } PHASE_END
    }
    PHASE_BEGIN(PH_FINAL, 1) if (PH_EN(11)) { XCD_IDS;
            { const int nrow = 2 * pn16 * 256, st = nloc * NWAVES; f32x4 w4[4];
#pragma unroll
              for (int jj = 0; jj < 4; ++jj) w4[jj] = *(const f32x4*)(args.in[I_FNORM] + 256 * jj + 4 * lane);
              for (int rb = rk * NWAVES + wave; rb < nrow; rb += 4 * st) { float sv[4]; u32x2v xb[4][4]; int mr[4];
#pragma unroll
                for (int r = 0; r < 4; ++r) { const int ri = (rb + r * st < nrow) ? rb + r * st : rb; const int m = XCD_ROW(ri); mr[r] = m; sv[r] = lane < NPART ? rowss[(size_t)m * NPART + lane] : 0.f;
#pragma unroll
                    for (int jj = 0; jj < 4; ++jj) xb[r][jj] = *(const GAS u32x2v*)(X16 + (size_t)m * DM + 256 * jj + 4 * lane); }
#pragma unroll
                for (int r = 0; r < 4; ++r) { if (r > 0 && rb + r * st >= nrow) break; const float rs = __builtin_amdgcn_rsqf(wave_sum(sv[r]) * (1.0f / DM) + NORM_EPS);
#pragma unroll
                    for (int jj = 0; jj < 4; ++jj) { const f32x4 x = (f32x4){bf_lo(xb[r][jj].x), bf_hi(xb[r][jj].x), bf_lo(xb[r][jj].y), bf_hi(xb[r][jj].y)};
                        *(GAS f32x4*)(args.out + OUT_Y + (size_t)mr[r] * DM + 256 * jj + 4 * lane) = x * rs * w4[jj]; } } } }
    } PHASE_END
#undef PHASE_BEGIN
#undef PHASE_END
}
#ifndef MK_MULTI
#define MK_MULTI 0
#endif
extern "C" void kernel_launch(void* const* d_in, const int* in_sizes, int n_in, void* d_out, int out_size, void* d_ws, size_t ws_size, hipStream_t stream) {
    static int grid = 0;
    if (grid == 0) {
        if (n_in != N_IN || out_size != (int)OUT_TOTAL || ws_size < WS_END) { fprintf(stderr, "kernel_launch: unexpected problem: n_in %d out %d ws %zu (need %zu)\n", n_in, out_size, ws_size, (size_t)WS_END); grid = -1; return; }
        int dev = 0, cus = 0, per_cu = 0;
        if (hipGetDevice(&dev) != hipSuccess || hipDeviceGetAttribute(&cus, hipDeviceAttributeMultiprocessorCount, dev) != hipSuccess) { grid = -1; return; }
        if (hipFuncSetAttribute((const void*)skel_fwd, hipFuncAttributeMaxDynamicSharedMemorySize, LDS_BYTES) != hipSuccess) { fprintf(stderr, "kernel_launch: hipFuncSetAttribute failed\n"); grid = -1; return; }
        if (hipOccupancyMaxActiveBlocksPerMultiprocessor(&per_cu, (const void*)skel_fwd, NWAVES * 64, LDS_BYTES) != hipSuccess || per_cu < 1) { fprintf(stderr, "kernel_launch: occupancy query says %d\n", per_cu); per_cu = 1; }
        (void)hipGetLastError();
        grid = cus;
        if (grid % 8 != 0) grid -= grid % 8;
    }
    if (grid < 0) return;
    (void)hipMemsetAsync((char*)d_ws + WS_CTL, 0, CTL_ZERO_BYTES, stream);
    Args a{};
    for (int i = 0; i < N_IN; ++i) a.in[i] = (const float*)d_in[i];
    a.out = (float*)d_out; a.ws = (unsigned char*)d_ws;
#if MK_MULTI
    for (int ph = 0; ph < N_PHASES; ++ph) {
        if (ph >= PH_LAYER0 && ph < PH_FINAL) { const int l_ = (ph - PH_LAYER0) / PH_PER_LAYER, sub_ = (ph - PH_LAYER0) % PH_PER_LAYER; if (sub_ == 5 || sub_ == 2) continue; }
        a.ph_lo = ph; a.ph_hi = ph + 1;
        int nrep = 1;
        for (int rep = 0; rep < nrep; ++rep)
        hipLaunchKernelGGL(skel_fwd, dim3(grid), dim3(NWAVES * 64), LDS_BYTES, stream, a);
    }
#else
    a.ph_lo = 0; a.ph_hi = N_PHASES;
    hipLaunchKernelGGL(skel_fwd, dim3(grid), dim3(NWAVES * 64), LDS_BYTES, stream, a);
#endif
    const hipError_t le = hipPeekAtLastError();
    if (le != hipSuccess) fprintf(stderr, "kernel_launch: launch failed: %s\n", hipGetErrorName(le));
}
```

```cpp
#include <hip/hip_runtime.h>
#include <hip/hip_bf16.h>
#include <cstdio>
#include <cstdint>
#include <cmath>
#define MK_MULTI 0
__device__ __forceinline__ int lane_id_opaque() { unsigned m_ = ~0u; asm volatile("" : "+s"(m_)); return (int)__builtin_amdgcn_mbcnt_hi(m_, __builtin_amdgcn_mbcnt_lo(m_, 0u)); }
namespace pg8 {
#define PG8_LAS __attribute__((address_space(3)))
typedef unsigned short bf16_t;
typedef short bf16x8 __attribute__((ext_vector_type(8)));
typedef float f32x4 __attribute__((ext_vector_type(4)));
typedef unsigned u32x4 __attribute__((ext_vector_type(4)));
constexpr int BM = 256, BK = 64, HALF = 128, HTB = HALF * BK * 2  , STAGE_BYTES = 8 * HTB, NXCD = 8, WGM = 8;

__host__ __device__ __forceinline__ int lds_byte(int r, int c) { const int st = (r >> 4) * 2 + (c >> 5), rr = r & 15, cc = c & 31, ob = rr * 64 + cc * 2; return st * 1024 + (ob ^ (((ob >> 9) & 1) << 5)); }
__host__ __device__ __forceinline__ void stage_rc(int b, int& R, int& C) { const int st = b / 1024, sb = b % 1024, swz = sb ^ (((sb >> 9) & 1) << 5); R = (st >> 1) * 16 + swz / 64; C = (st & 1) * 32 + (swz % 64) / 2; }
__host__ __device__ __forceinline__ int perm32(int rho) { const int n = rho >> 4, i = rho & 15; return 8 * (i >> 2) + 4 * n + (i & 3); }

struct Unit { int pm, pn, idx; };
struct Gemm { const bf16_t* A; const bf16_t* Bt; int M, N, K; };

struct StaticOrder {
    int nM, nN, nwg, G, c;
    __host__ __device__ void init(int M, int N, int G_, int c_, int bn = BM) { nM = M / BM; nN = N / bn; nwg = nM * nN; G = G_; c = c_; }
    __host__ __device__ bool next(int i, Unit& u) const {
        const long L = (long)i * G + c; if (L >= nwg) return false;
        int wgid = (int)L; { const int q = nwg / NXCD, r = nwg % NXCD, xcd = wgid % NXCD, off = wgid / NXCD; wgid = (xcd < r ? xcd * (q + 1) : r * (q + 1) + (xcd - r) * q) + off; }
        const int nig = WGM * nN, gid = wgid / nig, fm = gid * WGM, gsz = (nM - fm) < WGM ? (nM - fm) : WGM;
        u.pm = fm + ((wgid % nig) % gsz); u.pn = (wgid % nig) / gsz; u.idx = i; return true;
    }
    __device__ __forceinline__ void a_ready(const Unit&) const {}
    __device__ __forceinline__ void done(const Unit&) const {}
};

struct DiffQkvOrder {
    int vcu, G;
    __host__ __device__ bool next(int i, Unit& u) const {
        const int e = i * G + vcu; if (e >= 768) return false;
        const int vc = e & 255, r = e >> 8, x = vc >> 5, c = vc & 31, rh = c % 3;
        if (r == rh) { u.pm = 2 * x + (c >> 4); u.pn = 8 + (c & 15); }
        else { const int li = c + 32 * ((r > rh) ? r - 1 : r);
            if (li < 16) { u.pm = 2 * x + (li >> 3); u.pn = li & 7; } else { const int t = li - 16; u.pm = 16 + 2 * x + t / 24; u.pn = t % 24; } }
        u.idx = i; return true;
    }
    __device__ __forceinline__ void a_ready(const Unit&) const {}
    __device__ __forceinline__ void done(const Unit&) const {}
};


struct XcdOrder {
    int lo, n16, nN, r, nloc, dq;
    __device__ __forceinline__ bool next(int i, Unit& u) const {
        const int e = i * nloc + r;
        if (dq) { if (e >= 96) return false; const int rh = r % 3;
            if (i == rh) { u.pm = lo + (r >> 4); u.pn = 8 + (r & 15); }
            else { const int li = r + 32 * ((i > rh) ? i - 1 : i);
                if (li < 16) { u.pm = lo + (li >> 3); u.pn = li & 7; } else { const int t = li - 16; u.pm = 16 + lo + t / 24; u.pn = t % 24; } } }
        else { const int np = 2 * n16; if (e >= np * nN) return false; const int pn = e / np, pi = e - pn * np; u.pn = pn; u.pm = pi < n16 ? lo + pi : 16 + lo + (pi - n16); }
        u.idx = i; return true;
    }
    __device__ __forceinline__ void a_ready(const Unit&) const {}
    __device__ __forceinline__ void done(const Unit&) const {}
};
__device__ __forceinline__ unsigned cvt_pk_bf16(float lo, float hi) { unsigned r; asm volatile("v_cvt_pk_bf16_f32 %0, %1, %2" : "=v"(r) : "v"(lo), "v"(hi)); return r; }
typedef float f32x2 __attribute__((ext_vector_type(2)));
template <class Epi, class Sched, bool ALIGN_EPI = false, bool SP2 = false, bool NARROW = false>
__device__ __forceinline__ void gemm_phase(PG8_LAS unsigned char* lds, const Gemm g, const Sched& S, const Epi& E, const int wave_id) {
    int tid_ = wave_id * 64 + lane_id_opaque(); asm volatile("" : "+v"(tid_));
    const int tid = tid_, wid = __builtin_amdgcn_readfirstlane(tid >> 6), lane = tid & 63, wr = wid >> 2, wc = wid & 3, fr = lane & 15, fq = lane >> 4;
    const int K = g.K, nt = K / BK;
    unsigned voffA[2], voffB[2];
#pragma unroll
    for (int i = 0; i < 2; ++i) { int R, C; stage_rc(tid * 16 + i * 8192, R, C); const int Rb = Epi::PERM ? ((R & ~31) + perm32(R & 31)) : R;
        voffA[i] = (unsigned)(R * K + C) * 2u; voffB[i] = (unsigned)(Rb * K + C) * 2u; }
    const size_t kstep = (size_t)(BK * 2);
    const size_t hstep = (size_t)HALF * K * 2;
    const size_t tstep = 2 * hstep;
    const size_t tstepB = NARROW ? hstep : tstep;
    static_assert(!NARROW || SP2, "NARROW is an SP2 variant");
    const unsigned ldsw = (unsigned)wid * 1024u;
    const int aoff = lds_byte(wr * 64 + fr, fq * 8), boff = lds_byte(wc * 32 + fr, fq * 8);
#define PG8_SA(b, h) (((b) * 2 + (h)) * HTB)
#define PG8_SB(b, h) ((4 + (b) * 2 + (h)) * HTB)
#define PG8_STAGE(bufoff, gbase, voff) do { _Pragma("unroll") for (int _i = 0; _i < 2; ++_i) \
        __builtin_amdgcn_global_load_lds((const unsigned*)((const char*)(gbase) + (voff)[_i]), (PG8_LAS unsigned*)(lds + (bufoff) + ldsw + _i * 8192), 16, 0, 0); } while (0)
#define PG8_LDA(dst, b, h) do { _Pragma("unroll") for (int m = 0; m < 4; ++m) _Pragma("unroll") for (int k = 0; k < 2; ++k) dst[m][k] = *(const PG8_LAS bf16x8*)(lds + PG8_SA(b, h) + aoff + m * 2048 + k * 1024); } while (0)
#define PG8_LDB(dst, b, h) do { _Pragma("unroll") for (int n = 0; n < 2; ++n) _Pragma("unroll") for (int k = 0; k < 2; ++k) dst[n][k] = *(const PG8_LAS bf16x8*)(lds + PG8_SB(b, h) + boff + n * 2048 + k * 1024); } while (0)
#define PG8_MMA(ai, bj, At, Bt) do { __builtin_amdgcn_s_setprio(1); _Pragma("unroll") for (int m = 0; m < 4; ++m) _Pragma("unroll") for (int n = 0; n < 2; ++n) _Pragma("unroll") for (int k = 0; k < 2; ++k) \
        acc[ai][bj][m][n] = __builtin_amdgcn_mfma_f32_16x16x32_bf16(Bt[n][k], At[m][k], acc[ai][bj][m][n], 0, 0, 0); __builtin_amdgcn_s_setprio(0); } while (0)
#define PG8_WAIT_V(n) asm volatile("s_waitcnt vmcnt(" #n ")" ::: "memory")
#define PG8_WAIT_L(n) asm volatile("s_waitcnt lgkmcnt(" #n ")" ::: "memory")
#define PG8_BAR __builtin_amdgcn_s_barrier()
#define PG8_SCHED __builtin_amdgcn_sched_barrier(0)
    Unit cur, nxt; int ui = 0;
    if (!S.next(0, cur)) return;
    f32x4 acc[2][2][4][2];
#pragma unroll
    for (int a = 0; a < 2; ++a)
#pragma unroll
        for (int b = 0; b < 2; ++b)
#pragma unroll
            for (int m = 0; m < 4; ++m)
#pragma unroll
                for (int n = 0; n < 2; ++n) acc[a][b][m][n] = (f32x4){0.f, 0.f, 0.f, 0.f};
    bf16x8 At[4][2], B0[2][2], B1[2][2];
    const char* cA = (const char*)g.A + (size_t)cur.pm * tstep; const char* cB = (const char*)g.Bt + (size_t)cur.pn * tstepB;
    S.a_ready(cur);
    if constexpr (SP2) {
        if constexpr (NARROW) {
        PG8_STAGE(PG8_SB(0, 0), cB, voffB); PG8_STAGE(PG8_SA(0, 0), cA, voffA); PG8_STAGE(PG8_SA(0, 1), cA + hstep, voffA);
        if (wr == 1) PG8_BAR;
        PG8_WAIT_V(2); PG8_BAR;
        PG8_STAGE(PG8_SB(1, 0), cB + kstep, voffB); PG8_STAGE(PG8_SA(1, 0), cA + kstep, voffA);
        PG8_WAIT_V(4); PG8_BAR;
        } else {
        PG8_STAGE(PG8_SB(0, 0), cB, voffB); PG8_STAGE(PG8_SB(0, 1), cB + hstep, voffB); PG8_STAGE(PG8_SA(0, 0), cA, voffA); PG8_STAGE(PG8_SA(0, 1), cA + hstep, voffA);
        if (wr == 1) PG8_BAR;
        PG8_WAIT_V(2); PG8_BAR;
        PG8_STAGE(PG8_SB(1, 0), cB + kstep, voffB); PG8_STAGE(PG8_SA(1, 0), cA + kstep, voffA); PG8_STAGE(PG8_SB(1, 1), cB + hstep + kstep, voffB);
        PG8_WAIT_V(6); PG8_BAR;
        }
    } else {
        PG8_STAGE(PG8_SB(0, 0), cB, voffB); PG8_STAGE(PG8_SA(0, 0), cA, voffA); PG8_STAGE(PG8_SB(0, 1), cB + hstep, voffB); PG8_STAGE(PG8_SA(0, 1), cA + hstep, voffA);
        if (wr == 1) PG8_BAR;
        PG8_WAIT_V(4); PG8_BAR;
        PG8_STAGE(PG8_SB(1, 0), cB + kstep, voffB); PG8_STAGE(PG8_SA(1, 0), cA + kstep, voffA); PG8_STAGE(PG8_SB(1, 1), cB + hstep + kstep, voffB);
        PG8_WAIT_V(6); PG8_BAR;
    }
    for (;;) {
        const bool has_next = S.next(ui + 1, nxt);
        const char* nA = has_next ? (const char*)g.A + (size_t)nxt.pm * tstep : cA; const char* nB = has_next ? (const char*)g.Bt + (size_t)nxt.pn * tstepB : cB;
        for (int t = 0; t < nt; t += 2) {
            const bool last = (t == nt - 2);
            const char* a1 = cA + (size_t)(t + 1) * kstep;
            const char* a2 = last ? nA : cA + (size_t)(t + 2) * kstep; const char* b2 = last ? nB : cB + (size_t)(t + 2) * kstep;
            const char* a3 = a2 + kstep; const char* b3 = b2 + kstep;
            if (last && has_next) S.a_ready(nxt);
            if constexpr (SP2 && NARROW) {
            PG8_LDB(B0, 0, 0); PG8_SCHED; PG8_LDA(At, 0, 0); PG8_STAGE(PG8_SA(1, 1), a1 + hstep, voffA);
            PG8_WAIT_V(6); PG8_WAIT_L(0); PG8_BAR; PG8_MMA(0, 0, At, B0); PG8_BAR; PG8_SCHED;
            PG8_LDA(At, 0, 1); PG8_STAGE(PG8_SB(0, 0), b2, voffB); PG8_STAGE(PG8_SA(0, 0), a2, voffA);
            PG8_WAIT_V(6); PG8_WAIT_L(0); PG8_BAR; PG8_MMA(1, 0, At, B0); PG8_BAR; PG8_SCHED;
            PG8_LDB(B0, 1, 0); PG8_SCHED; PG8_LDA(At, 1, 0); PG8_STAGE(PG8_SA(0, 1), a2 + hstep, voffA);
            PG8_WAIT_V(6); PG8_WAIT_L(0); PG8_BAR; PG8_MMA(0, 0, At, B0); PG8_BAR; PG8_SCHED;
            PG8_LDA(At, 1, 1); PG8_STAGE(PG8_SB(1, 0), b3, voffB); PG8_STAGE(PG8_SA(1, 0), a3, voffA);
            PG8_WAIT_V(6); PG8_WAIT_L(0); PG8_BAR; PG8_MMA(1, 0, At, B0); PG8_BAR; PG8_SCHED;
            } else if constexpr (SP2) {
            PG8_LDB(B0, 0, 0); PG8_LDB(B1, 0, 1); PG8_SCHED; PG8_LDA(At, 0, 0); PG8_STAGE(PG8_SA(1, 1), a1 + hstep, voffA);
            PG8_WAIT_V(8); PG8_WAIT_L(0); PG8_BAR; PG8_MMA(0, 0, At, B0); PG8_MMA(0, 1, At, B1); PG8_BAR; PG8_SCHED;
            PG8_LDA(At, 0, 1); PG8_STAGE(PG8_SB(0, 0), b2, voffB); PG8_STAGE(PG8_SB(0, 1), b2 + hstep, voffB); PG8_STAGE(PG8_SA(0, 0), a2, voffA);
            PG8_WAIT_V(8); PG8_WAIT_L(0); PG8_BAR; PG8_MMA(1, 0, At, B0); PG8_MMA(1, 1, At, B1); PG8_BAR; PG8_SCHED;
            PG8_LDB(B0, 1, 0); PG8_LDB(B1, 1, 1); PG8_SCHED; PG8_LDA(At, 1, 0); PG8_STAGE(PG8_SA(0, 1), a2 + hstep, voffA);
            PG8_WAIT_V(8); PG8_WAIT_L(0); PG8_BAR; PG8_MMA(0, 0, At, B0); PG8_MMA(0, 1, At, B1); PG8_BAR; PG8_SCHED;
            PG8_LDA(At, 1, 1); PG8_STAGE(PG8_SB(1, 0), b3, voffB); PG8_STAGE(PG8_SB(1, 1), b3 + hstep, voffB); PG8_STAGE(PG8_SA(1, 0), a3, voffA);
            PG8_WAIT_V(8); PG8_WAIT_L(0); PG8_BAR; PG8_MMA(1, 0, At, B0); PG8_MMA(1, 1, At, B1); PG8_BAR; PG8_SCHED;
            } else {
            PG8_LDB(B0, 0, 0); PG8_SCHED; PG8_LDA(At, 0, 0); PG8_STAGE(PG8_SA(1, 1), a1 + hstep, voffA);
            PG8_WAIT_L(8); PG8_BAR; PG8_WAIT_L(0); PG8_MMA(0, 0, At, B0); PG8_BAR; PG8_SCHED;
            PG8_LDB(B1, 0, 1); PG8_STAGE(PG8_SB(0, 0), b2, voffB);
            PG8_BAR; PG8_WAIT_L(0); PG8_MMA(0, 1, At, B1); PG8_BAR;
            PG8_LDA(At, 0, 1); PG8_STAGE(PG8_SA(0, 0), a2, voffA);
            PG8_BAR; PG8_WAIT_L(0); PG8_MMA(1, 0, At, B0); PG8_BAR; PG8_SCHED;
            PG8_STAGE(PG8_SB(0, 1), b2 + hstep, voffB);
            PG8_WAIT_V(6); PG8_BAR; PG8_MMA(1, 1, At, B1); PG8_BAR;
            PG8_LDB(B0, 1, 0); PG8_SCHED; PG8_LDA(At, 1, 0); PG8_STAGE(PG8_SA(0, 1), a2 + hstep, voffA);
            PG8_WAIT_L(8); PG8_BAR; PG8_WAIT_L(0); PG8_MMA(0, 0, At, B0); PG8_BAR; PG8_SCHED;
            PG8_LDB(B1, 1, 1); PG8_STAGE(PG8_SB(1, 0), b3, voffB);
            PG8_BAR; PG8_WAIT_L(0); PG8_MMA(0, 1, At, B1); PG8_BAR;
            PG8_LDA(At, 1, 1); PG8_STAGE(PG8_SA(1, 0), a3, voffA);
            PG8_BAR; PG8_WAIT_L(0); PG8_MMA(1, 0, At, B0); PG8_BAR; PG8_SCHED;
            PG8_STAGE(PG8_SB(1, 1), b3 + hstep, voffB);
            PG8_WAIT_V(6); PG8_BAR; PG8_MMA(1, 1, At, B1); PG8_BAR;
            }
        }
        if constexpr (ALIGN_EPI) { if (wr == 0) PG8_BAR; }
        if constexpr (!Epi::AFTER_DRAIN) { E(acc, cur, wr, wc, fr, fq);
            S.done(cur); }
        if (!has_next) break;
#pragma unroll
        for (int a = 0; a < 2; ++a)
#pragma unroll
            for (int b = 0; b < 2; ++b)
#pragma unroll
                for (int m = 0; m < 4; ++m)
#pragma unroll
                    for (int n = 0; n < 2; ++n) acc[a][b][m][n] = (f32x4){0.f, 0.f, 0.f, 0.f};
        cur = nxt; cA = nA; cB = nB; ++ui;
        if constexpr (ALIGN_EPI) { if (wr == 1) PG8_BAR; }
    }
    PG8_WAIT_V(0);
    if constexpr (!ALIGN_EPI) { if (wr == 0) PG8_BAR; }
    PG8_BAR;
    if constexpr (Epi::AFTER_DRAIN) { E.fused(acc, cur, wr, wc, fr, fq, lds, wid, lane); S.done(cur); }
#undef PG8_SA
#undef PG8_SB
#undef PG8_STAGE
#undef PG8_LDA
#undef PG8_LDB
#undef PG8_MMA
#undef PG8_WAIT_V
#undef PG8_WAIT_L
#undef PG8_BAR
#undef PG8_SCHED
}
}
namespace pg8 {
typedef unsigned u32x2 __attribute__((ext_vector_type(2)));
__device__ __forceinline__ void store16f_wt(void* p, f32x4 v) { asm volatile("global_store_dwordx4 %0, %1, off sc1\n\ts_nop 1" :: "v"(p), "v"(v) : "memory"); }
__device__ __forceinline__ void store16_wt(void* p, u32x4 v) { asm volatile("global_store_dwordx4 %0, %1, off sc1\n\ts_nop 1" :: "v"(p), "v"(v) : "memory"); }
constexpr int NTOK = 8192, NPROMPT = 4096, DMODEL = 1024, NPART = 32;
constexpr float C2Q = 0.125f * 1.4426950408889634f;
__device__ __forceinline__ u32x2 pack4(const f32x4 v) { u32x2 w; w.x = cvt_pk_bf16(v[0], v[1]); w.y = cvt_pk_bf16(v[2], v[3]); return w; }
__device__ __forceinline__ void store_pair16_wt(bf16_t* p, const u32x2 A, const u32x2 B, const int fq) {
    const auto r0 = __builtin_amdgcn_permlane16_swap(A.x, B.x, false, false), r1 = __builtin_amdgcn_permlane16_swap(A.y, B.y, false, false);
    u32x4 w; w.x = r0[0]; w.y = r1[0]; w.z = r0[1]; w.w = r1[1];
    store16_wt(p + ((fq & 1) ? 12 : 0), w);
}
__device__ __forceinline__ int mod_index(int pm) { return pm < 16 ? 0 : 1 + ((pm - 16) >> 3); }
__device__ __forceinline__ int kv_row(int m) { return m < NPROMPT ? m : m + 256 * (((m - NPROMPT) >> 11) + 1); }
__device__ __forceinline__ float row_rstd(const float* rowss, int row) {
    float s = 0.f;
#pragma unroll
    for (int p = 0; p < NPART; ++p) s += rowss[row * NPART + p];
    return __builtin_amdgcn_rsqf(s * (1.0f / DMODEL) + 1e-6f);
}

struct EpiResid {
    static constexpr bool PERM = true, AFTER_DRAIN = false, IDEMPOTENT = false;
    bf16_t* X16; bf16_t* XG; const float* gate; int gate_ld; const float* gain; float* rowss;
    __device__ __forceinline__ void operator()(const f32x4 (&acc)[2][2][4][2], const Unit& u, int wr, int wc, int fr_, int fq_) const {
        int fr, fq; { int ln_ = lane_id_opaque(); asm volatile("" : "+v"(ln_)); fr = ln_ & 15; fq = ln_ >> 4; } (void)fr_; (void)fq_;
        const int v = mod_index(u.pm), col0 = u.pn * HALF + wc * 32 + 8 * fq;
        f32x4 gt[2], gn[2];
#pragma unroll
        for (int n = 0; n < 2; ++n) { gt[n] = *(const f32x4*)(gate + v * gate_ld + col0 + 4 * n);
            gn[n] = gain ? *(const f32x4*)(gain + v * DMODEL + col0 + 4 * n) : (f32x4){0.f, 0.f, 0.f, 0.f}; }
        u32x4 xold[2][4];
#pragma unroll
        for (int ai = 0; ai < 2; ++ai)
#pragma unroll
            for (int m = 0; m < 4; ++m) xold[ai][m] = *(const u32x4*)(X16 + (size_t)(u.pm * BM + ai * HALF + wr * 64 + m * 16 + fr) * DMODEL + col0);
#pragma unroll
        for (int ai = 0; ai < 2; ++ai)
#pragma unroll
            for (int m = 0; m < 4; ++m) { const int row = u.pm * BM + ai * HALF + wr * 64 + m * 16 + fr; const size_t off = (size_t)row * DMODEL + col0; float ss = 0.f; const u32x4 xo = xold[ai][m];
                f32x4 xn[2];
#pragma unroll
                for (int n = 0; n < 2; ++n) { const f32x4 xf = (f32x4){__uint_as_float(xo[2 * n] << 16), __uint_as_float(xo[2 * n] & 0xffff0000u), __uint_as_float(xo[2 * n + 1] << 16), __uint_as_float(xo[2 * n + 1] & 0xffff0000u)};
                    xn[n] = xf + gt[n] * acc[ai][0][m][n]; ss += (xn[n][0] * xn[n][0] + xn[n][1] * xn[n][1]) + (xn[n][2] * xn[n][2] + xn[n][3] * xn[n][3]); }
                { u32x4 w; w.x = cvt_pk_bf16(xn[0][0], xn[0][1]); w.y = cvt_pk_bf16(xn[0][2], xn[0][3]); w.z = cvt_pk_bf16(xn[1][0], xn[1][1]); w.w = cvt_pk_bf16(xn[1][2], xn[1][3]); store16_wt(X16 + off, w); }
                if (gain) { const f32x4 g0 = xn[0] * gn[0], g1 = xn[1] * gn[1]; u32x4 w; w.x = cvt_pk_bf16(g0[0], g0[1]); w.y = cvt_pk_bf16(g0[2], g0[3]); w.z = cvt_pk_bf16(g1[0], g1[1]); w.w = cvt_pk_bf16(g1[2], g1[3]); store16_wt(XG + off, w); }
                ss += __shfl_xor(ss, 16); ss += __shfl_xor(ss, 32);
                if (fq == 0) rowss[row * NPART + (u.pn * 4 + wc)] = ss; }
    }
};

template <int CTRL> __device__ __forceinline__ f32x4 dpp4(const f32x4 oldv, const f32x4 src) {
    f32x4 r;
#pragma unroll
    for (int e = 0; e < 4; ++e) { const float o_ = oldv[e], s_ = src[e];
        r[e] = __int_as_float(__builtin_amdgcn_update_dpp(__float_as_int(o_), __float_as_int(s_), CTRL, 0xf, 0xf, false)); }
    return r;
}
template <int CTRL> __device__ __forceinline__ f32x4 dpp4r(const f32x4 src) {
    f32x4 r;
#pragma unroll
    for (int e = 0; e < 4; ++e) { const float s_ = src[e]; r[e] = __int_as_float(__builtin_amdgcn_mov_dpp(__float_as_int(s_), CTRL, 0xf, 0xf, false)); }
    return r;
}
struct EpiUpConv {
    static constexpr bool PERM = true, AFTER_DRAIN = false, IDEMPOTENT = false;
    bf16_t* H; const float* bias; const float* cw; const float* cb; const PG8_LAS float* rstd; PG8_LAS float* edge; float* uedge;
    __device__ __forceinline__ void operator()(f32x4 (&acc)[2][2][4][2], const Unit& u, int wr, int wc, int fr_, int fq_) const {
        int fr, fq; { int ln_ = lane_id_opaque(); asm volatile("" : "+v"(ln_)); fr = ln_ & 15; fq = ln_ >> 4; } (void)fr_; (void)fq_;

        const int v = mod_index(u.pm), cbase = wc * 32 + 8 * fq;
        { float rs[2][4];
#pragma unroll
          for (int ai = 0; ai < 2; ++ai)
#pragma unroll
              for (int m = 0; m < 4; ++m) rs[ai][m] = rstd[(u.idx & 7) * 256 + ai * HALF + wr * 64 + m * 16 + fr];
#pragma unroll
          for (int bj = 0; bj < 2; ++bj)
#pragma unroll
              for (int n = 0; n < 2; ++n) { const f32x4 b4 = *(const f32x4*)(bias + (size_t)v * 5632 + u.pn * BM + bj * HALF + cbase + 4 * n);
#pragma unroll
                  for (int ai = 0; ai < 2; ++ai)
#pragma unroll
                      for (int m = 0; m < 4; ++m) { acc[ai][bj][m][n] = acc[ai][bj][m][n] * rs[ai][m] + b4; asm volatile("" : "+v"(acc[ai][bj][m][n])); } } }
        { const unsigned ebase = (unsigned)(uintptr_t)edge + (unsigned)(cbase * 4);
#pragma unroll
          for (int ai = 0; ai < 2; ++ai) { const unsigned a0 = ebase + (unsigned)(((ai * 2 + wr) * 2) * 1024);
            if (fr == 0) {
#pragma unroll
                for (int bj = 0; bj < 2; ++bj)
#pragma unroll
                    for (int n = 0; n < 2; ++n) asm volatile("ds_write_b128 %0, %1 offset:%c2" :: "v"(a0), "v"(acc[ai][bj][0][n]), "i"(bj * 512 + n * 16) : "memory"); }
            if (fr == 15) {
#pragma unroll
                for (int bj = 0; bj < 2; ++bj)
#pragma unroll
                    for (int n = 0; n < 2; ++n) asm volatile("ds_write_b128 %0, %1 offset:%c2" :: "v"(a0), "v"(acc[ai][bj][3][n]), "i"(1024 + bj * 512 + n * 16) : "memory"); } } }
        if (u.pm >= 16) {
            if (wr == 0 && fr < 2) { float* o = uedge + ((size_t)u.pm * 4 + fr) * 5632 + u.pn * BM + cbase;
#pragma unroll
                for (int bj = 0; bj < 2; ++bj)
#pragma unroll
                    for (int n = 0; n < 2; ++n) store16f_wt(o + bj * HALF + 4 * n, acc[0][bj][0][n]); }
            if (wr == 1 && fr >= 14) { float* o = uedge + ((size_t)u.pm * 4 + 2 + (fr - 14)) * 5632 + u.pn * BM + cbase;
#pragma unroll
                for (int bj = 0; bj < 2; ++bj)
#pragma unroll
                    for (int n = 0; n < 2; ++n) store16f_wt(o + bj * HALF + 4 * n, acc[1][bj][3][n]); } }
        asm volatile("s_waitcnt lgkmcnt(0)\n\ts_barrier" ::: "memory"); __builtin_amdgcn_sched_barrier(0);
#pragma unroll
        for (int bj = 0; bj < 2; ++bj) {
#pragma unroll
          for (int n = 0; n < 2; ++n) {
            int fr2 = fr, cb2 = cbase; asm volatile("" : "+v"(fr2), "+v"(cb2));
            const float* wp = cw + bj * 2816 + u.pn * HALF + cb2 + 4 * n;
            const f32x4 w0 = *(const f32x4*)wp, w1 = *(const f32x4*)(wp + 5632), w2 = *(const f32x4*)(wp + 2 * 5632), cbv = *(const f32x4*)(cb + bj * 2816 + u.pn * HALF + cb2 + 4 * n);
#pragma unroll
            for (int ai = 0; ai < 2; ++ai) { const int blk = ai * 2 + wr;
                f32x4 carry = *(const PG8_LAS f32x4*)(edge + ((blk > 0 ? blk - 1 : 0) * 2 + 1) * 256 + bj * HALF + cb2 + 4 * n) * (blk > 0 ? 1.0f : 0.0f);
                const f32x4 en = *(const PG8_LAS f32x4*)(edge + ((blk < 3 ? blk + 1 : 3) * 2 + 0) * 256 + bj * HALF + cb2 + 4 * n) * (blk < 3 ? 1.0f : 0.0f);
#pragma unroll
                for (int m = 0; m < 4; ++m) { const f32x4 cur = acc[ai][bj][m][n];
                    const f32x4 nold = m < 3 ? dpp4r<0x12F>(acc[ai][bj][m < 3 ? m + 1 : 3][n]) : en;
                    const f32x4 prev = dpp4<0x111>(carry, cur);
                    const f32x4 next = dpp4<0x101>(nold, cur);
                    carry = dpp4r<0x121>(cur);
                    const f32x4 o = w0 * prev + w1 * cur + w2 * next + cbv;
                    if (bj == 0) {
#pragma unroll
                        for (int e = 0; e < 4; ++e) acc[ai][0][m][n][e] = o[e] * __builtin_amdgcn_rcpf(1.0f + __expf(-o[e]));
                    } else { const f32x4 h = acc[ai][0][m][n] * o; const unsigned p0 = cvt_pk_bf16(h[0], h[1]), p1 = cvt_pk_bf16(h[2], h[3]);
                        if (n == 0) { acc[ai][0][m][0][0] = __uint_as_float(p0); acc[ai][0][m][0][1] = __uint_as_float(p1); }
                        else { u32x4 w; w.x = __float_as_uint(acc[ai][0][m][0][0]); w.y = __float_as_uint(acc[ai][0][m][0][1]); w.z = p0; w.w = p1;

                            store16_wt(H + (size_t)(u.pm * BM + ai * HALF + wr * 64 + m * 16 + fr2) * 2816 + u.pn * HALF + cb2, w); } }
                    __builtin_amdgcn_sched_barrier(0); } }
            asm volatile("" ::: "memory"); __builtin_amdgcn_sched_barrier(0); } }
    }
};


struct EpiQkvDiff {
    static constexpr bool PERM = false, AFTER_DRAIN = false, IDEMPOTENT = true;
    bf16_t *Q, *K, *V; const float* bias; const PG8_LAS float* rstd; const float* rope;
    float *newk, *newv;
    __device__ __forceinline__ void operator()(const f32x4 (&acc)[2][2][4][2], const Unit& u, int wr, int wc, int fr_, int fq_) const {
        int fr, fq; { int ln_ = lane_id_opaque(); asm volatile("" : "+v"(ln_)); fr = ln_ & 15; fq = ln_ >> 4; } (void)fr_; (void)fq_;
        const int v = mod_index(u.pm), sec = u.pn >> 3, hd = u.pn & 7, cs = hd * HALF + wc * 32 + 4 * fq;
        const bool latent = u.pm >= 16; const int qb = (u.pm - 16) & 7;
        const float* biasp = bias + v * 3072 + sec * 1024 + cs; const f32x4 b0 = *(const f32x4*)biasp, b1 = *(const f32x4*)(biasp + 16);
        f32x4 ra[2][4], rb[2][4];
        const bool roped = latent && sec < 2;
        if (roped) {
#pragma unroll
            for (int ai = 0; ai < 2; ++ai)
#pragma unroll
                for (int m = 0; m < 4; ++m) { const int trow = ai * HALF + wr * 64 + m * 16 + fr; const int pos = (wc & 1) ? (trow & 63) : (4 * qb + (trow >> 6));
                    const float* rp = rope + (pos * 16 + 4 * fq) * 2; ra[ai][m] = *(const f32x4*)rp; rb[ai][m] = *(const f32x4*)(rp + 4); } }
#pragma unroll
        for (int ai = 0; ai < 2; ++ai)
#pragma unroll
            for (int m = 0; m < 4; ++m) { const int trow = ai * HALF + wr * 64 + m * 16 + fr, row = u.pm * BM + trow; const float rs = rstd[(u.idx & 7) * 256 + trow];
                f32x4 c4 = (f32x4){1.f, 1.f, 1.f, 1.f}, s4 = (f32x4){0.f, 0.f, 0.f, 0.f};
                if (roped) { const f32x4 a = ra[ai][m], b = rb[ai][m]; c4 = (f32x4){a[0], a[2], b[0], b[2]}; s4 = (f32x4){a[1], a[3], b[1], b[3]}; }
                const f32x4 x0 = acc[ai][0][m][0] * rs + b0, x1 = acc[ai][0][m][1] * rs + b1;
                if (sec == 0) { const f32x4 y0 = (x0 * c4 - x1 * s4) * C2Q, y1 = (x1 * c4 + x0 * s4) * C2Q; bf16_t* p = Q + (size_t)row * DMODEL + cs;
                    store_pair16_wt(p, pack4(y0), pack4(y1), fq); }
                else { const size_t kr = (size_t)kv_row(row) * DMODEL + cs;
                    if (!latent) { float* o = (sec == 1 ? newk : newv) + ((size_t)(u.pm * 16 + hd) * 256 + trow) * 128 + wc * 32 + 4 * fq; store16f_wt(o, x0); store16f_wt(o + 16, x1); }
                    if (sec == 1) { const f32x4 y0 = x0 * c4 - x1 * s4, y1 = x1 * c4 + x0 * s4; store_pair16_wt(K + kr, pack4(y0), pack4(y1), fq); }
                    else { store_pair16_wt(V + kr, pack4(x0), pack4(x1), fq); } } }
    }
};

struct EpiQkvGqa {
    static constexpr bool PERM = false, AFTER_DRAIN = false, IDEMPOTENT = true;
    bf16_t *Q, *K, *V; const float* bias; const PG8_LAS float* rstd; const float* rope; const float *qnw, *knw;
    float *newk, *newv;
    __device__ __forceinline__ void operator()(const f32x4 (&acc)[2][2][4][2], const Unit& u, int wr, int wc, int fr_, int fq_) const {
        int fr, fq; { int ln_ = lane_id_opaque(); asm volatile("" : "+v"(ln_)); fr = ln_ & 15; fq = ln_ >> 4; } (void)fr_; (void)fq_;
        const int v = mod_index(u.pm), sec = u.pn < 4 ? 0 : u.pn - 3;
        const bool latent = u.pm >= 16; const int qb = (u.pm - 16) & 7;
        const float* biasp = bias + v * 1536 + u.pn * BM + wc * 32 + 4 * fq; const float* nwp = (sec == 0 ? qnw : knw) + 4 * fq;
#pragma unroll
        for (int ai = 0; ai < 2; ++ai)
#pragma unroll
            for (int m = 0; m < 4; ++m) { const int trow = ai * HALF + wr * 64 + m * 16 + fr, row = u.pm * BM + trow; const float rs = rstd[(u.idx & 7) * 256 + trow];
                f32x4 x[2][2]; float ss = 0.f;
#pragma unroll
                for (int bj = 0; bj < 2; ++bj)
#pragma unroll
                    for (int n = 0; n < 2; ++n) { x[bj][n] = acc[ai][bj][m][n] * rs + *(const f32x4*)(biasp + bj * HALF + n * 16); const f32x4 t = x[bj][n]; ss += (t[0] * t[0] + t[1] * t[1]) + (t[2] * t[2] + t[3] * t[3]); }
                if (sec < 2) { ss += __shfl_xor(ss, 16); ss += __shfl_xor(ss, 32); const float hr = __builtin_amdgcn_rsqf(ss * (1.0f / 64.0f) + 1e-6f);
#pragma unroll
                    for (int bj = 0; bj < 2; ++bj)
#pragma unroll
                        for (int n = 0; n < 2; ++n) x[bj][n] = x[bj][n] * hr * *(const f32x4*)(nwp + 32 * bj + 16 * n); }
                if (sec == 0) {
#pragma unroll
                    for (int bj = 0; bj < 2; ++bj) { f32x4 y0 = x[bj][0], y1 = x[bj][1];
                        if (latent) { const int pos = bj ? (trow & 63) : (4 * qb + (trow >> 6)); const float* rp = rope + (pos * 16 + 4 * fq) * 2; const f32x4 a = *(const f32x4*)rp, b = *(const f32x4*)(rp + 4);
                            const f32x4 c4 = (f32x4){a[0], a[2], b[0], b[2]}, s4 = (f32x4){a[1], a[3], b[1], b[3]}; y0 = x[bj][0] * c4 - x[bj][1] * s4; y1 = x[bj][1] * c4 + x[bj][0] * s4; }
                        bf16_t* p = Q + (size_t)row * DMODEL + (u.pn * 4 + wc) * 64 + 32 * bj + 4 * fq; store_pair16_wt(p, pack4(y0 * C2Q), pack4(y1 * C2Q), fq); }
                } else {
                    const size_t kr = (size_t)kv_row(row) * 256 + wc * 64 + 4 * fq;
                    if (!latent) { float* o = (sec == 1 ? newk : newv) + ((size_t)(u.pm * 8 + wc) * 256 + trow) * 64 + 4 * fq;
#pragma unroll
                        for (int bj = 0; bj < 2; ++bj) { store16f_wt(o + 32 * bj, x[bj][0]); store16f_wt(o + 32 * bj + 16, x[bj][1]); } }
#pragma unroll
                    for (int bj = 0; bj < 2; ++bj) { f32x4 y0 = x[bj][0], y1 = x[bj][1];
                        if (latent && sec == 1) { const int pos = bj ? (trow & 63) : (4 * qb + (trow >> 6)); const float* rp = rope + (pos * 16 + 4 * fq) * 2; const f32x4 a = *(const f32x4*)rp, b = *(const f32x4*)(rp + 4);
                            const f32x4 c4 = (f32x4){a[0], a[2], b[0], b[2]}, s4 = (f32x4){a[1], a[3], b[1], b[3]}; y0 = x[bj][0] * c4 - x[bj][1] * s4; y1 = x[bj][1] * c4 + x[bj][0] * s4; }
                        bf16_t* p = (sec == 1 ? K : V) + kr + 32 * bj; store_pair16_wt(p, pack4(y0), pack4(y1), fq); } }
                asm volatile("" ::: "memory");
            }
    }
};

}
namespace attn_body {
using bf16=__hip_bfloat16;
using bf16x8=__attribute__((ext_vector_type(8)))short;
using s16x4=__attribute__((ext_vector_type(4)))short;
using f32x16=__attribute__((ext_vector_type(16)))float;
using u32x4=__attribute__((ext_vector_type(4)))unsigned;
using f32x4_t=__attribute__((ext_vector_type(4)))float;
constexpr int D=64;
constexpr int NW=8,QBLK=32,QB=QBLK*NW,KVBLK=64;
constexpr int ATTN_UNIT_ROWS=QB;
__device__ __forceinline__ int crow(int r,int hi){return (r&3)+8*(r>>2)+4*hi;}
#define SBAR() __builtin_amdgcn_sched_barrier(0)

constexpr int NSLOT=3, SLOTB=8192;
constexpr int LDS_K=0, LDS_V=NSLOT*SLOTB;
__host__ __device__ constexpr int lds_ws(int DV){return LDS_V+NSLOT*SLOTB*(DV/64);} __host__ __device__ constexpr int lds_ost(int DV){return lds_ws(DV)+NW*64*4;} __host__ __device__ constexpr int lds_bytes(int DV){return lds_ost(DV)+NW*4096;}
constexpr float C2=0.125f*1.4426950408889634f;
__device__ __forceinline__ void glds16(const void*gsrc,unsigned lds_dst){unsigned keep;
  asm volatile("s_mov_b32 %0, m0\n\ts_mov_b32 m0, %2\n\ts_nop 0\n\tglobal_load_lds_dwordx4 %1, off\n\ts_mov_b32 m0, %0":"=&s"(keep):"v"(gsrc),"s"(lds_dst):"memory");}
__device__ __forceinline__ float max3f(float a,float b,float c){float r;asm("v_max3_f32 %0, %1, %2, %3":"=v"(r):"v"(a),"v"(b),"v"(c));return r;}
__device__ __forceinline__ float max2f(float a,float b){float r;asm("v_max_f32_e32 %0, %1, %2":"=v"(r):"v"(a),"v"(b));return r;}
__device__ __forceinline__ float fadd_s(float a,float b){float r;asm("v_add_f32_e32 %0, %1, %2":"=v"(r):"v"(a),"v"(b));return r;}
__device__ __forceinline__ float fsub_s(float a,float b){float r;asm("v_sub_f32_e32 %0, %1, %2":"=v"(r):"v"(a),"v"(b));return r;}
typedef float f32x2_t __attribute__((ext_vector_type(2))); typedef __bf16 bf16x2_t __attribute__((ext_vector_type(2)));
__device__ __forceinline__ unsigned cvtpk_s(float lo,float hi){f32x2_t v={lo,hi};bf16x2_t b=__builtin_convertvector(v,bf16x2_t);return __builtin_bit_cast(unsigned,b);}
#define WAIT_BAR(N) asm volatile("s_waitcnt vmcnt(" #N ") lgkmcnt(0)\n\ts_barrier":::"memory")

__device__ __forceinline__ void qkt(f32x16&p0,f32x16&p1,const char*Kslot,const bf16x8*qr,const f32x16&negm,int r32,int hi){
  const char*kb=Kslot+hi*1024+r32*16;
  #pragma unroll
  for(int d0=0;d0<4;++d0){
    const bf16x8 b0=*reinterpret_cast<const bf16x8*>(kb+d0*2048);
    const bf16x8 b1=*reinterpret_cast<const bf16x8*>(kb+d0*2048+512);
    if(d0==0){p0=__builtin_amdgcn_mfma_f32_32x32x16_bf16(b0,qr[0],negm,0,0,0);p1=__builtin_amdgcn_mfma_f32_32x32x16_bf16(b1,qr[0],negm,0,0,0);}
    else{p0=__builtin_amdgcn_mfma_f32_32x32x16_bf16(b0,qr[d0],p0,0,0,0);p1=__builtin_amdgcn_mfma_f32_32x32x16_bf16(b1,qr[d0],p1,0,0,0);}}
}
typedef __attribute__((address_space(3))) const char* lds_cptr;
typedef short v4i16_t __attribute__((ext_vector_type(4)));
__device__ __forceinline__ void kload8(bf16x8*kf,lds_cptr kp){
  kf[0]=*(const __attribute__((address_space(3))) bf16x8*)(kp);      kf[1]=*(const __attribute__((address_space(3))) bf16x8*)(kp+512);
  kf[2]=*(const __attribute__((address_space(3))) bf16x8*)(kp+2048); kf[3]=*(const __attribute__((address_space(3))) bf16x8*)(kp+2560);
  kf[4]=*(const __attribute__((address_space(3))) bf16x8*)(kp+4096); kf[5]=*(const __attribute__((address_space(3))) bf16x8*)(kp+4608);
  kf[6]=*(const __attribute__((address_space(3))) bf16x8*)(kp+6144); kf[7]=*(const __attribute__((address_space(3))) bf16x8*)(kp+6656);
}
__device__ __forceinline__ void kload2(bf16x8*kf,lds_cptr kp,int j){ kf[2*j]=*(const __attribute__((address_space(3))) bf16x8*)(kp+j*2048); kf[2*j+1]=*(const __attribute__((address_space(3))) bf16x8*)(kp+j*2048+512); }
__device__ __forceinline__ s16x4 vtr(lds_cptr p){ return __builtin_bit_cast(s16x4,__builtin_amdgcn_ds_read_tr16_b64_v4i16((__attribute__((address_space(3))) v4i16_t*)p)); }
__device__ __forceinline__ float rowmax(const f32x16&p0,const f32x16&p1){
  float a=max3f(p0[0],p0[1],p1[0]),b=max3f(p0[2],p0[3],p1[1]);a=max3f(a,p1[2],p1[3]);
  #pragma unroll
  for(int r=4;r<16;r+=4){a=max3f(a,p0[r],p0[r+1]);b=max3f(b,p0[r+2],p0[r+3]);a=max3f(a,p1[r],p1[r+1]);b=max3f(b,p1[r+2],p1[r+3]);}
  const float m=max2f(a,b);
  auto rr=__builtin_amdgcn_permlane32_swap(__float_as_uint(m),__float_as_uint(m),false,false);
  return max2f(__uint_as_float(rr[0]),__uint_as_float(rr[1]));
}
__device__ __forceinline__ void pv(f32x16*o,int vb,bf16x8 pa0,bf16x8 pa1,bf16x8 pa2,bf16x8 pa3){
  #pragma unroll
  for(int d0=0;d0<2;++d0){s16x4 lo[4],hi[4];
    #pragma unroll
    for(int ks=0;ks<4;++ks){
      asm volatile("ds_read_b64_tr_b16 %0,%1 offset:%c2":"=&v"(lo[ks]):"v"(vb),"i"(d0*4096+ks*1024):"memory");
      asm volatile("ds_read_b64_tr_b16 %0,%1 offset:%c2":"=&v"(hi[ks]):"v"(vb),"i"(d0*4096+ks*1024+512):"memory");}
    asm volatile("s_waitcnt lgkmcnt(0)":::"memory");SBAR();
    #define PK(k) (bf16x8){lo[k][0],lo[k][1],lo[k][2],lo[k][3],hi[k][0],hi[k][1],hi[k][2],hi[k][3]}
    o[d0]=__builtin_amdgcn_mfma_f32_32x32x16_bf16(pa0,PK(0),o[d0],0,0,0);
    o[d0]=__builtin_amdgcn_mfma_f32_32x32x16_bf16(pa1,PK(1),o[d0],0,0,0);
    o[d0]=__builtin_amdgcn_mfma_f32_32x32x16_bf16(pa2,PK(2),o[d0],0,0,0);
    o[d0]=__builtin_amdgcn_mfma_f32_32x32x16_bf16(pa3,PK(3),o[d0],0,0,0);
    #undef PK
  }
}

#ifndef ATTN_STORE16
#define ATTN_STORE16(p,v) asm volatile("global_store_dwordx4 %0, %1, off sc1\n\ts_nop 1" :: "v"(p), "v"(v) : "memory")
#endif
struct AttnJob {
  const bf16* Q; int QP;
  const bf16* K; int KP;
  const bf16* V; int VP;
  bf16* O; int OP;
  int NT;
  int comb; unsigned* flag; unsigned target; float lam, oml; const float* sw;
};
template<int THRL,int DV> __device__ __forceinline__ void attn_unit(const AttnJob& J,char*shm,const int wave_id){
  constexpr int NV=DV/64, ND=DV/32, LDS_WS=lds_ws(DV), LDS_OST=lds_ost(DV);
  int tid_=wave_id*64+lane_id_opaque(); asm volatile("":"+v"(tid_));
  const int tid=tid_,lane=tid&63,r32=lane&31,hi=lane>>5; const int wid=__builtin_amdgcn_readfirstlane(tid>>6);
  const int QP=J.QP,KP=J.KP,VP=J.VP,OP=J.OP;
  const bf16*Qw=J.Q+(long)(wid*QBLK)*QP;
  const bf16*Kh=J.K,*Vh=J.V;
  const unsigned lds0=(unsigned)(uintptr_t)shm;
  float*wsf=(float*)(shm+LDS_WS)+wid*64;
  const bf16*ksrc=Kh+(long)lane*KP+wid*8;
  const bf16*vsrc=Vh+(long)(16*(wid&3)+(lane>>2))*VP+(wid>>2)*32+(lane&3)*8;
  const unsigned kdst=lds0+LDS_K+wid*1024, vdst=lds0+LDS_V+wid*1024;
  #define DMA_K(t,slot) glds16(ksrc+(long)(t)*KVBLK*KP,(unsigned)__builtin_amdgcn_readfirstlane(kdst+(slot)))
  #define DMA_V(t,slot) do{ _Pragma("unroll") for(int k_=0;k_<NV;++k_) glds16(vsrc+(long)(t)*KVBLK*VP+k_*64,(unsigned)__builtin_amdgcn_readfirstlane(vdst+NV*(slot)+k_*8192)); }while(0)
  const int vb0=(int)(lds0+LDS_V)+((lane>>4)&1)*32+(lane&3)*8+(4*hi+((lane&15)>>2))*64;
  const char*Kbase=shm+LDS_K; bf16x8 kf[8];
  const lds_cptr shm3=(lds_cptr)shm; const lds_cptr kp0=shm3+LDS_K+hi*1024+r32*16; const lds_cptr vp0=shm3+LDS_V+((lane>>4)&1)*32+(lane&3)*8+(4*hi+((lane&15)>>2))*64;
  const int NT=J.NT;
  DMA_K(0,0);DMA_V(0,0);DMA_K(1,SLOTB);
  bf16x8 qr[4];
  #pragma unroll
  for(int d0=0;d0<4;++d0)qr[d0]=*reinterpret_cast<const bf16x8*>(&Qw[(long)r32*QP+d0*16+hi*8]);
  float mhat=0.f,l_reg=0.f;f32x16 o[ND]; _Pragma("unroll") for(int d_=0;d_<ND;++d_)o[d_]=f32x16{};f32x16 negm=f32x16{};asm volatile("":"+v"(negm)); const f32x16 zero16=f32x16{};
  const u32x4 kone_u=(u32x4){hi==0?0x3f803f80u:0u,0u,0u,0u}; const bf16x8 kone=__builtin_bit_cast(bf16x8,kone_u); bf16x8 qm=__builtin_bit_cast(bf16x8,(u32x4){0u,0u,0u,0u});
  #define SETQM() do{ if constexpr(DV==128){ const float nm_=-mhat; const float hf_=__uint_as_float(cvtpk_s(nm_,0.f)<<16); const unsigned w_=cvtpk_s(hf_,nm_-hf_); \
      qm=__builtin_bit_cast(bf16x8,(u32x4){hi==0?w_:0u,0u,0u,0u}); } }while(0)
  #define CIN (DV==64?negm:zero16)
  #define CIN0(C) (DV==64?negm:C)
  #define CMASK(P0,P1,t) do{}while(0)
  bool resc=false;
  #define START(P0,P1) do{ const float rm=rowmax(P0,P1); resc=false; \
    { const float dl=rm; mhat=fadd_s(mhat,dl); \
      _Pragma("unroll") for(int r=0;r<16;++r){P0[r]=fsub_s(P0[r],dl);P1[r]=fsub_s(P1[r],dl);} \
      if constexpr(DV==64){ _Pragma("unroll") for(int r=0;r<16;++r)negm[r]=-mhat; asm volatile("":"+v"(negm)); } SETQM(); } \
    _Pragma("unroll") for(int r=0;r<16;++r)P0[r]=__builtin_amdgcn_exp2f(P0[r]); }while(0)
  #define RESC() do{ if(resc){ asm volatile("s_waitcnt lgkmcnt(0)":::"memory"); \
      _Pragma("unroll") for(int d_=0;d_<ND;++d_) _Pragma("unroll") for(int r=0;r<16;++r)o[d_][r]*=wsf[crow(r,hi)]; } }while(0)
  f32x16 pA0,pA1,pB0,pB1;
  int sl_prev=0,sl_cur=0,sl_next=SLOTB;
  #define ROT() do{sl_prev=sl_cur;sl_cur=sl_next;sl_next=(sl_next==(NSLOT-1)*SLOTB)?0:sl_next+SLOTB;}while(0)
  DMA_K(2,2*SLOTB);
  if constexpr(NV==2){WAIT_BAR(4);}else{WAIT_BAR(3);}
  qkt(pA0,pA1,Kbase,qr,CIN,r32,hi);asm volatile("s_nop 15\n\ts_nop 7":"+v"(pA0),"+v"(pA1));CMASK(pA0,pA1,0);
  START(pA0,pA1);
  _Pragma("unroll") for(int r=0;r<16;++r)pA1[r]=__builtin_amdgcn_exp2f(pA1[r]);
  WAIT_BAR(0);
  DMA_K(3,0);DMA_V(1,SLOTB);
  ROT();
  kload8(kf,kp0+sl_cur);
  if constexpr(NV==2){WAIT_BAR(3);}else{WAIT_BAR(2);}
  s16x4 vlo[8],vhi[8]; u32x4 pw0,pw1,pw2,pw3;
  #define PKW(P,B) cvtpk_s(P[B],P[B+1])
  #define PAF(k) __builtin_bit_cast(bf16x8,pw##k)
  #define VFR(i) (bf16x8){vlo[i][0],vlo[i][1],vlo[i][2],vlo[i][3],vhi[i][0],vhi[i][1],vhi[i][2],vhi[i][3]}
  #define PIN(x) asm volatile("":"+v"(x))
  #define MX3(a,b,c) __builtin_fmaxf(__builtin_fmaxf((a),(b)),(c))
  #define GAPA(MF,A0,A1,A2,A3,W0,W1,PW) do{ MF; sacc+=A0; sacc+=A1; sacc+=A2; sacc+=A3; PIN(sacc); W0; W1; PIN(PW); SBAR(); }while(0)
  #define EX(v) __builtin_amdgcn_exp2f(v)
  #define GAPB(MF,X,B) do{ MF; X[B]=EX(X[B]); X[B+1]=EX(X[B+1]); X[B+2]=EX(X[B+2]); X[B+3]=EX(X[B+3]); PIN(X); SBAR(); }while(0)
  #define VRD(i) do{ vlo[i]=vtr(vp_+(((i)>>2)*4096+((i)&3)*1024)); vhi[i]=vtr(vp_+(((i)>>2)*4096+((i)&3)*1024+512)); }while(0)
  #define VRD2(i) do{ vlo[i]=vtr(vp_+8192+(((i)>>2)*4096+((i)&3)*1024)); vhi[i]=vtr(vp_+8192+(((i)>>2)*4096+((i)&3)*1024+512)); }while(0)
  #define GAPC(MF) do{ MF; SBAR(); }while(0)
  #define KRD(G,j) do{ if(G){ kload2(kf,kp0+sl_next,j); SBAR(); } }while(0)
  #define STEP(C0,C1,P0,P1,t,GK,GV,GL) do{ SBAR(); \
    const lds_cptr vp_=vp0+NV*sl_prev; \
    VRD(0); SBAR(); float sacc=(P0[0]+P0[1]); \
    if constexpr(DV==128){ C0=__builtin_amdgcn_mfma_f32_32x32x16_bf16(kone,qm,zero16,0,0,0); C1=__builtin_amdgcn_mfma_f32_32x32x16_bf16(kone,qm,zero16,0,0,0); SBAR(); } \
    GAPA(C0=__builtin_amdgcn_mfma_f32_32x32x16_bf16(kf[0],qr[0],CIN0(C0),0,0,0), P0[2],P0[3],P0[4],P0[5],     pw0[0]=PKW(P0,0), pw0[1]=PKW(P0,2), pw0); \
    VRD(4); SBAR(); GAPA(C1=__builtin_amdgcn_mfma_f32_32x32x16_bf16(kf[1],qr[0],CIN0(C1),0,0,0), P0[6],P0[7],P0[8],P0[9],     pw0[2]=PKW(P0,4), pw0[3]=PKW(P0,6), pw0); \
    VRD(1); SBAR(); GAPA(C0=__builtin_amdgcn_mfma_f32_32x32x16_bf16(kf[2],qr[1],C0,0,0,0),   P0[10],P0[11],P0[12],P0[13], pw1[0]=PKW(P0,8), pw1[1]=PKW(P0,10), pw1); \
    VRD(5); SBAR(); GAPA(C1=__builtin_amdgcn_mfma_f32_32x32x16_bf16(kf[3],qr[1],C1,0,0,0),   P0[14],P0[15],P1[0],P1[1],   pw1[2]=PKW(P0,12),pw1[3]=PKW(P0,14), pw1); \
    VRD(2); SBAR(); GAPA(C0=__builtin_amdgcn_mfma_f32_32x32x16_bf16(kf[4],qr[2],C0,0,0,0),   P1[2],P1[3],P1[4],P1[5],     pw2[0]=PKW(P1,0), pw2[1]=PKW(P1,2), pw2); \
    VRD(6); SBAR(); GAPA(C1=__builtin_amdgcn_mfma_f32_32x32x16_bf16(kf[5],qr[2],C1,0,0,0),   P1[6],P1[7],P1[8],P1[9],     pw2[2]=PKW(P1,4), pw2[3]=PKW(P1,6), pw2); \
    VRD(3); SBAR(); GAPA(C0=__builtin_amdgcn_mfma_f32_32x32x16_bf16(kf[6],qr[3],C0,0,0,0),   P1[10],P1[11],P1[12],P1[13], pw3[0]=PKW(P1,8), pw3[1]=PKW(P1,10), pw3); \
    VRD(7); SBAR(); GAPA(C1=__builtin_amdgcn_mfma_f32_32x32x16_bf16(kf[7],qr[3],C1,0,0,0),   P1[14],P1[15],0.f,0.f,       pw3[2]=PKW(P1,12),pw3[3]=PKW(P1,14), pw3); \
    l_reg+=sacc; \
    if(GK){DMA_K((t)+3,sl_cur);} if(GV){DMA_V((t)+1,sl_next);} \
    CMASK(C0,C1,t); \
    { float a=MX3(C0[0],C0[1],C1[0]),b=MX3(C0[2],C0[3],C1[1]); a=MX3(a,C1[2],C1[3]); \
      _Pragma("unroll") for(int r=4;r<16;r+=4){a=MX3(a,C0[r],C0[r+1]);b=MX3(b,C0[r+2],C0[r+3]);a=MX3(a,C1[r],C1[r+1]);b=MX3(b,C1[r+2],C1[r+3]);} \
      float rm=__builtin_fmaxf(a,b); { auto rr=__builtin_amdgcn_permlane32_swap(__float_as_uint(rm),__float_as_uint(rm),false,false); rm=__builtin_fmaxf(__uint_as_float(rr[0]),__uint_as_float(rr[1])); } \
      resc=false; \
      if(__builtin_expect(__any(rm>(float)THRL),0)){ const float dl=__builtin_fmaxf(rm,0.f); mhat+=dl; \
        _Pragma("unroll") for(int r=0;r<16;++r){C0[r]-=dl;C1[r]-=dl;} \
        if constexpr(DV==64){ _Pragma("unroll") for(int r=0;r<16;++r)negm[r]=-mhat; asm volatile("":"+v"(negm)); } SETQM(); \
        const float f=__builtin_amdgcn_exp2f(-dl); l_reg*=f; if(hi==0)wsf[r32]=f; resc=true; } } \
    SBAR(); \
    GAPB(o[0]=__builtin_amdgcn_mfma_f32_32x32x16_bf16(PAF(0),VFR(0),o[0],0,0,0), C0,0); \
    GAPB(o[1]=__builtin_amdgcn_mfma_f32_32x32x16_bf16(PAF(0),VFR(4),o[1],0,0,0), C0,4); \
    KRD(GL,0); GAPB(o[0]=__builtin_amdgcn_mfma_f32_32x32x16_bf16(PAF(1),VFR(1),o[0],0,0,0), C0,8); \
    KRD(GL,1); GAPB(o[1]=__builtin_amdgcn_mfma_f32_32x32x16_bf16(PAF(1),VFR(5),o[1],0,0,0), C0,12); \
    KRD(GL,2); GAPB(o[0]=__builtin_amdgcn_mfma_f32_32x32x16_bf16(PAF(2),VFR(2),o[0],0,0,0), C1,0); \
    KRD(GL,3); GAPB(o[1]=__builtin_amdgcn_mfma_f32_32x32x16_bf16(PAF(2),VFR(6),o[1],0,0,0), C1,4); \
    GAPB(o[0]=__builtin_amdgcn_mfma_f32_32x32x16_bf16(PAF(3),VFR(3),o[0],0,0,0), C1,8); \
    GAPB(o[1]=__builtin_amdgcn_mfma_f32_32x32x16_bf16(PAF(3),VFR(7),o[1],0,0,0), C1,12); \
    if constexpr(DV==128){   \
      VRD2(0); VRD2(4); SBAR(); \
      VRD2(1); SBAR(); GAPC(o[2]=__builtin_amdgcn_mfma_f32_32x32x16_bf16(PAF(0),VFR(0),o[2],0,0,0)); \
      VRD2(5); SBAR(); GAPC(o[3]=__builtin_amdgcn_mfma_f32_32x32x16_bf16(PAF(0),VFR(4),o[3],0,0,0)); \
      VRD2(2); SBAR(); GAPC(o[2]=__builtin_amdgcn_mfma_f32_32x32x16_bf16(PAF(1),VFR(1),o[2],0,0,0)); \
      VRD2(6); SBAR(); GAPC(o[3]=__builtin_amdgcn_mfma_f32_32x32x16_bf16(PAF(1),VFR(5),o[3],0,0,0)); \
      VRD2(3); SBAR(); GAPC(o[2]=__builtin_amdgcn_mfma_f32_32x32x16_bf16(PAF(2),VFR(2),o[2],0,0,0)); \
      VRD2(7); SBAR(); GAPC(o[3]=__builtin_amdgcn_mfma_f32_32x32x16_bf16(PAF(2),VFR(6),o[3],0,0,0)); \
      GAPC(o[2]=__builtin_amdgcn_mfma_f32_32x32x16_bf16(PAF(3),VFR(3),o[2],0,0,0)); \
      GAPC(o[3]=__builtin_amdgcn_mfma_f32_32x32x16_bf16(PAF(3),VFR(7),o[3],0,0,0)); } \
    }while(0)
  #define WAIT_KV() do{ if constexpr(NV==2){WAIT_BAR(3);}else{WAIT_BAR(2);} }while(0)
  #define WAIT_V() do{ if constexpr(NV==2){WAIT_BAR(2);}else{WAIT_BAR(1);} }while(0)
  int t=1;
  for(;t+5<NT;t+=2){
    STEP(pB0,pB1,pA0,pA1,t,true,true,true);     WAIT_KV(); RESC(); ROT();
    STEP(pA0,pA1,pB0,pB1,t+1,true,true,true);   WAIT_KV(); RESC(); ROT();
  }
  #define ENDW(tt) do{ if((tt)+3<NT){WAIT_KV();} else if((tt)+2<NT){WAIT_V();} else {WAIT_BAR(0);} }while(0)
  for(;t+1<NT;t+=2){
    STEP(pB0,pB1,pA0,pA1,t,(t+3<NT),(t+1<NT),(t+1<NT));       ENDW(t);   RESC(); ROT();
    STEP(pA0,pA1,pB0,pB1,t+1,(t+4<NT),(t+2<NT),(t+2<NT));     ENDW(t+1); RESC(); ROT();
  }
  STEP(pB0,pB1,pA0,pA1,NT-1,false,false,false); RESC();
  { float sacc=pB0[0]+pB0[1]; _Pragma("unroll") for(int r=2;r<16;++r)sacc+=pB0[r]; _Pragma("unroll") for(int r=0;r<16;++r)sacc+=pB1[r]; l_reg+=sacc;
    pw0=(u32x4){PKW(pB0,0),PKW(pB0,2),PKW(pB0,4),PKW(pB0,6)};pw1=(u32x4){PKW(pB0,8),PKW(pB0,10),PKW(pB0,12),PKW(pB0,14)};pw2=(u32x4){PKW(pB1,0),PKW(pB1,2),PKW(pB1,4),PKW(pB1,6)};pw3=(u32x4){PKW(pB1,8),PKW(pB1,10),PKW(pB1,12),PKW(pB1,14)};
    SBAR(); pv(o,vb0+NV*sl_cur,PAF(0),PAF(1),PAF(2),PAF(3)); if constexpr(DV==128){ pv(o+2,vb0+NV*sl_cur+8192,PAF(0),PAF(1),PAF(2),PAF(3)); } }
  #undef PKW
  #undef PAF
  #undef VFR
  #undef PIN
  #undef MX3
  #undef GAPA
  #undef GAPB
  #undef EX
  #undef VRD
  #undef VRD2
  #undef CIN
  #undef CIN0
  #undef SETQM
  #undef GAPC
  #undef WAIT_KV
  #undef WAIT_V
  #undef KRD
  #undef STEP
  #undef ENDW
  {auto rr=__builtin_amdgcn_permlane32_swap(__float_as_uint(l_reg),__float_as_uint(l_reg),false,false);l_reg=__uint_as_float(rr[0])+__uint_as_float(rr[1]);}
  if(hi==0)wsf[32+r32]=l_reg;asm volatile("s_waitcnt lgkmcnt(0)":::"memory");
  float rli[16];
  #pragma unroll
  for(int r=0;r<16;++r)rli[r]=__builtin_amdgcn_rcpf(wsf[32+crow(r,hi)]);
  {
    bf16*Ow=J.O+(long)(wid*QBLK)*OP;
    bf16*stg=(bf16*)(shm+LDS_OST)+wid*2048;
    bool comb=false; if constexpr(DV==128) comb=J.comb!=0;
    if(!comb){
    #pragma unroll
    for(int hf=0;hf<NV;++hf){
      #pragma unroll
      for(int r=0;r<16;++r){const int orow=crow(r,hi);
        #pragma unroll
        for(int d0=0;d0<2;++d0)stg[orow*64+d0*32+r32]=__float2bfloat16(o[2*hf+d0][r]*rli[r]);}
      asm volatile("s_waitcnt lgkmcnt(0)":::"memory");
      #pragma unroll
      for(int i=0;i<4;++i){const int row=i*8+(lane>>3),ch=lane&7; const u32x4 v=*(const u32x4*)(stg+row*64+ch*8); ATTN_STORE16(Ow+(long)row*OP+hf*64+ch*8,v);}
      asm volatile("s_waitcnt lgkmcnt(0)":::"memory");
    }
    if constexpr(DV==128){ if(J.flag){
      asm volatile("s_waitcnt vmcnt(0) lgkmcnt(0)\n\ts_barrier":::"memory");
      if(wid==0&&lane==0) (void)__hip_atomic_fetch_add(J.flag,1u,__ATOMIC_RELAXED,__HIP_MEMORY_SCOPE_AGENT); } }
    } else { if constexpr(DV==128){
      u32x4 q2[2][4],q1[2][4];
      #pragma unroll
      for(int hf=0;hf<2;++hf){
        #pragma unroll
        for(int r=0;r<16;++r){const int orow=crow(r,hi);
          #pragma unroll
          for(int d0=0;d0<2;++d0)stg[orow*64+d0*32+r32]=__float2bfloat16(o[2*hf+d0][r]*rli[r]);}
        asm volatile("s_waitcnt lgkmcnt(0)":::"memory");
        #pragma unroll
        for(int i=0;i<4;++i){const int row=i*8+(lane>>3),ch=lane&7; q2[hf][i]=*(const u32x4*)(stg+row*64+ch*8);}
        asm volatile("s_waitcnt lgkmcnt(0)":::"memory");
      }
      if(wid==0&&lane==0){ unsigned sp_=0; while(__hip_atomic_load(J.flag,__ATOMIC_RELAXED,__HIP_MEMORY_SCOPE_AGENT)<J.target){ __builtin_amdgcn_s_sleep(1); if(++sp_>(1u<<20))break; } }
      asm volatile("s_waitcnt vmcnt(0) lgkmcnt(0)\n\ts_barrier":::"memory");
      #pragma unroll
      for(int hf=0;hf<2;++hf)
        #pragma unroll
        for(int i=0;i<4;++i){const int row=i*8+(lane>>3),ch=lane&7; const bf16*src=Ow+(long)row*OP+hf*64+ch*8;
          asm volatile("global_load_dwordx4 %0, %1, off sc1":"=v"(q1[hf][i]):"v"(src):"memory");}
      asm volatile("s_waitcnt vmcnt(0)":"+v"(q1[0][0]),"+v"(q1[0][1]),"+v"(q1[0][2]),"+v"(q1[0][3]),"+v"(q1[1][0]),"+v"(q1[1][1]),"+v"(q1[1][2]),"+v"(q1[1][3])::"memory");
      int lam_i=__builtin_amdgcn_readfirstlane(__float_as_int(J.lam)),oml_i=__builtin_amdgcn_readfirstlane(__float_as_int(J.oml)); asm volatile("":"+s"(lam_i),"+s"(oml_i)); const float lam=__int_as_float(lam_i),oml=__int_as_float(oml_i); const int ch=lane&7;
      f32x4_t w4[4];
      #pragma unroll
      for(int hf=0;hf<2;++hf){ w4[2*hf]=*(const f32x4_t*)(J.sw+hf*64+ch*8)*oml; w4[2*hf+1]=*(const f32x4_t*)(J.sw+hf*64+ch*8+4)*oml; }
      #pragma unroll
      for(int i=0;i<4;++i){ float d[16]; float ss=0.f;
        #pragma unroll
        for(int hf=0;hf<2;++hf)
          #pragma unroll
          for(int q=0;q<4;++q){ const unsigned a=q1[hf][i][q],b=q2[hf][i][q];
            d[8*hf+2*q]=__uint_as_float(a<<16)-lam*__uint_as_float(b<<16); d[8*hf+2*q+1]=__uint_as_float(a&0xffff0000u)-lam*__uint_as_float(b&0xffff0000u); }
        #pragma unroll
        for(int e=0;e<16;++e)ss+=d[e]*d[e];
        ss+=__shfl_xor(ss,1); ss+=__shfl_xor(ss,2); ss+=__shfl_xor(ss,4);
        const float rs=__builtin_amdgcn_rsqf(ss*(1.0f/128.0f)+1e-6f);
        #pragma unroll
        for(int hf=0;hf<2;++hf){ u32x4 v;
          #pragma unroll
          for(int q=0;q<4;++q) v[q]=cvtpk_s(d[8*hf+2*q]*rs*w4[2*hf+(q>>1)][(2*q)&3], d[8*hf+2*q+1]*rs*w4[2*hf+(q>>1)][(2*q+1)&3]);
          const int row=i*8+(lane>>3); ATTN_STORE16(Ow+(long)row*OP+hf*64+ch*8,v); } }
    } }
  }
  asm volatile("s_waitcnt lgkmcnt(0)\n\ts_barrier":::"memory");
  #undef DMA_K
  #undef DMA_V
  #undef CMASK
  #undef START
  #undef RESC
  #undef ROT
}
constexpr int ATTN_LDS_BYTES=lds_bytes(128);
#undef SBAR
#undef WAIT_BAR
}
constexpr int NWAVES = 8;
constexpr int NTOK = 8192, NPROMPT = 4096, DM = 1024, DFF = 2816, NUP = 5632, DEPTH = 4, NPART = 32;
constexpr int KVROWS = 4096 + 2 * 2304;
constexpr float NORM_EPS = 1e-6f;
enum { I_XP = 0, I_XS, I_CKD, I_CVD, I_CKG, I_CVG, I_C, I_CCTX, I_MODW, I_MODB, I_NATT, I_NFFN, I_WQD, I_WOD, I_LAMD, I_SUBLN, I_WQG, I_WOG, I_QNG, I_KNG, I_WUP, I_CONVW, I_CONVB, I_WDN, I_FNORM, N_IN };
constexpr size_t OUT_Y = 0, OUT_NKD = 8388608, OUT_NVD = 16777216, OUT_NKG = 25165824, OUT_NVG = 27262976, OUT_TOTAL = 29360128;
constexpr size_t MiB = 1u << 20;
constexpr size_t WS_CTL = 0, CTL_ZERO_BYTES = 65536;
constexpr size_t WS_TAB = 1 * MiB;
constexpr size_t T_MOD = 0;
constexpr size_t T_GA = T_MOD + 4 * 3 * 6144;
constexpr size_t T_GF = T_GA + 4 * 3 * 1024;
constexpr size_t T_BQD = T_GF + 4 * 3 * 1024;
constexpr size_t T_BQG = T_BQD + 2 * 3 * 3072;
constexpr size_t T_BUP = T_BQG + 2 * 3 * 1536;
constexpr size_t T_ROPE = T_BUP + 4 * 3 * 5632;
constexpr size_t T_LAM = T_ROPE + 64 * 16 * 2;
constexpr size_t T_ROWSS = T_LAM + 64;
constexpr size_t T_SSD = T_ROWSS + (size_t)NPART * NTOK;
constexpr size_t T_END = T_SSD + (size_t)NTOK * 16;
static_assert(T_END * 4 <= 8 * MiB, "tables fit their region");
constexpr size_t WS_W = 16 * MiB;
constexpr size_t W_QD = WS_W, W_OD = W_QD + 2 * 6 * MiB, W_QG = W_OD + 2 * 2 * MiB, W_OG = W_QG + 2 * 3 * MiB, W_UP = W_OG + 2 * 2 * MiB, W_DN = W_UP + 4 * 11 * MiB, W_END = W_DN + 4 * 11 * MiB / 2;
static_assert(W_END == 108 * MiB, "weight map");
constexpr size_t WS_X = 112 * MiB, WS_XG = 144 * MiB, WS_Q = 160 * MiB, WS_O = 176 * MiB, WS_K = 192 * MiB, WS_V = 210 * MiB, WS_U = 228 * MiB, WS_H = 316 * MiB, WS_STASH = 360 * MiB, WS_END = 376 * MiB;
constexpr size_t WS_MODP = WS_U + 16 * MiB;
static_assert((size_t)KVROWS * DM * 2 <= 18 * MiB && (size_t)NTOK * NUP * 2 == 88 * MiB && (size_t)NTOK * DFF * 2 == 44 * MiB, "activation map");
constexpr int RING_OFF = 0, RING_BYTES = 131072, LDSCTL_OFF = RING_BYTES, MISC_OFF = LDSCTL_OFF + 320, RSTD_OFF = LDSCTL_OFF + 1024, EDGE_OFF = RSTD_OFF + 8192, LDS_BYTES = 155648;

#define GAS __attribute__((address_space(1)))
#define LAS __attribute__((address_space(3)))
typedef unsigned short bf16;
typedef unsigned v4u __attribute__((ext_vector_type(4)));
typedef float f32x4 __attribute__((ext_vector_type(4)));
typedef short bf16x8 __attribute__((ext_vector_type(8)));
typedef GAS unsigned gu32;
typedef GAS unsigned long long gu64;
#define RLX_AGENT __ATOMIC_RELAXED, __HIP_MEMORY_SCOPE_AGENT
#define LDS_WAIT() asm volatile("s_waitcnt lgkmcnt(0)" ::: "memory")
#define VM_WAIT() asm volatile("s_waitcnt vmcnt(0)" ::: "memory")
__device__ __forceinline__ unsigned long long rt() { return __builtin_amdgcn_s_memrealtime(); }
__device__ __forceinline__ unsigned f2bf(float f) { unsigned u = __builtin_bit_cast(unsigned, f); return (u + 0x7fffu + ((u >> 16) & 1u)) >> 16; }
__device__ __forceinline__ unsigned pk2(float lo, float hi) { return f2bf(lo) | (f2bf(hi) << 16); }

#define XB_TMO      128
#define XB_XCNT(j)  (256  + 64 * (j))
#define XB_XSUB(j)  (1280 + 64 * (j))
#define XB_XGEN(j)  (2304 + 64 * (j))
#define XB_TOP      3328
#define XB_TOPGEN   3392
#define XCD_BAR_WORDS 3456
#define XL_SUB(j)   (3456 + 64 * (j))
#define XL_GEN(j)   (4480 + 64 * (j))
#define XL_UPD(j)   (5504 + 64 * (j))
#define XB_SPIN_CAP (1u << 18)

__device__ __forceinline__ unsigned xb_ld(unsigned* p)              { return __hip_atomic_load(p, __ATOMIC_RELAXED, __HIP_MEMORY_SCOPE_AGENT); }
__device__ __forceinline__ unsigned xb_add(unsigned* p, unsigned v) { return __hip_atomic_fetch_add(p, v, __ATOMIC_RELAXED, __HIP_MEMORY_SCOPE_AGENT); }
__device__ __forceinline__ unsigned xb_xcc_id() { return (unsigned)__builtin_amdgcn_s_getreg((3 << 11) | 20) & 0xFu; }
#define XB_SPIN(cond, bar) do { unsigned _sp = 0; while (cond) { __builtin_amdgcn_s_sleep(1); \
    if ((++_sp & 255u) == 0u) { if (xb_ld(&(bar)[XB_TMO])) break; if (_sp > XB_SPIN_CAP) { atomicAdd(&(bar)[XB_TMO], 1u); break; } } } } while (0)

struct XcdBarrier {
    unsigned* bar; unsigned x;
    volatile LAS unsigned* st;
};

__device__ __forceinline__ XcdBarrier xcd_barrier_post(unsigned* bar, volatile LAS unsigned* st, const bool leader) {
    XcdBarrier b; b.bar = bar; b.x = xb_xcc_id(); b.st = st;
    if (leader) st[2] = xb_add(&bar[XB_XCNT(b.x)], 1u);
    return b;
}
__device__ __forceinline__ void xcd_barrier_complete(unsigned* bar, unsigned x, unsigned& nloc, unsigned& nx, unsigned& vx) {
    const unsigned G = gridDim.x * gridDim.y * gridDim.z;
    unsigned sum, cnt, mine, below, sp = 0u;
    for (;;) {
        sum = 0u; cnt = 0u; mine = 0u; below = 0u;
#pragma unroll
        for (unsigned j = 0; j < 16; ++j) { const unsigned c = xb_ld(&bar[XB_XCNT(j)]); sum += c; cnt += (c > 0u) ? 1u : 0u; mine = (j == x) ? c : mine; below += (c > 0u && j < x) ? 1u : 0u; }
        if (sum == G) break;
        __builtin_amdgcn_s_sleep(1);
        if ((++sp & 255u) == 0u) { if (xb_ld(&bar[XB_TMO])) break; if (sp > XB_SPIN_CAP) { atomicAdd(&bar[XB_TMO], 1u); break; } }
    }
    nloc = mine > 0u ? mine : 1u; nx = cnt > 0u ? cnt : 1u; vx = below;
}

__device__ __forceinline__ void xcd_barrier(const XcdBarrier& b, const bool leader) {
    asm volatile("s_waitcnt vmcnt(0)" ::: "memory");
    __syncthreads();
    if (leader) {
        unsigned* bar = b.bar;
        __builtin_amdgcn_s_waitcnt(0);
        unsigned nloc = b.st[0], nx = b.st[1];
        if (nloc == 0u) { unsigned vx; xcd_barrier_complete(bar, b.x, nloc, nx, vx); b.st[0] = nloc; b.st[1] = nx; b.st[3] = vx; }
        asm volatile("buffer_inv sc1" ::: "memory");
        const unsigned old = xb_add(&bar[XB_XSUB(b.x)], 1u);
        const unsigned gen = old / nloc;
        if (old + 1u == (gen + 1u) * nloc) {
            __builtin_amdgcn_fence(__ATOMIC_RELEASE, "agent");
            asm volatile("s_waitcnt vmcnt(0)" ::: "memory");
            const unsigned og = xb_add(&bar[XB_TOP], 1u);
            const unsigned tg = og / nx;
            if (og + 1u == (tg + 1u) * nx) xb_add(&bar[XB_TOPGEN], 1u);
            else XB_SPIN(xb_ld(&bar[XB_TOPGEN]) == tg, bar);
            xb_add(&bar[XB_XGEN(b.x)], 1u);
        } else {
            XB_SPIN(xb_ld(&bar[XB_XGEN(b.x)]) == gen, bar);
            asm volatile("s_waitcnt vmcnt(0)" ::: "memory");
        }
    }
    __syncthreads();
}

__device__ __forceinline__ void xcd_local_barrier(const XcdBarrier& b, const bool leader, const int flag_word, const int wait0 = -1, const int wait1 = -1, const unsigned target = 0u) {
    asm volatile("s_waitcnt vmcnt(0)" ::: "memory");
    __syncthreads();
    if (leader) {
        unsigned* bar = b.bar;
        __builtin_amdgcn_s_waitcnt(0);
        const unsigned nloc = b.st[0];
        asm volatile("buffer_inv sc1" ::: "memory");
        const unsigned old = xb_add(&bar[XL_SUB(b.x)], 1u);
        const unsigned gen = old / nloc;
        if (old + 1u == (gen + 1u) * nloc) { if (flag_word >= 0) (void)xb_add(&bar[flag_word], 1u); xb_add(&bar[XL_GEN(b.x)], 1u); }
        else XB_SPIN(xb_ld(&bar[XL_GEN(b.x)]) == gen, bar);
        if (wait0 >= 0) { XB_SPIN(xb_ld(&bar[wait0]) < target, bar); XB_SPIN(xb_ld(&bar[wait1]) < target, bar); }
        asm volatile("s_waitcnt vmcnt(0)" ::: "memory");
    }
    __syncthreads();
}
__device__ __forceinline__ void xcd_flag_wait(const XcdBarrier& b, const bool leader, const int w0, const int w1, const unsigned target) {
    if (leader) {
        unsigned* bar = b.bar;
        XB_SPIN(xb_ld(&bar[w0]) < target, bar);
        XB_SPIN(xb_ld(&bar[w1]) < target, bar);
        __builtin_amdgcn_fence(__ATOMIC_ACQUIRE, "agent");
        asm volatile("s_waitcnt vmcnt(0)" ::: "memory");
    }
    __syncthreads();
}

typedef unsigned u32x2v __attribute__((ext_vector_type(2)));
__device__ __forceinline__ float wave_sum(float v) {
#pragma unroll
    for (int o = 1; o < 64; o <<= 1) v += __shfl_xor(v, o);
    return v;
}
__device__ __forceinline__ float bf_lo(unsigned w) { return __uint_as_float(w << 16); }
__device__ __forceinline__ float bf_hi(unsigned w) { return __uint_as_float(w & 0xffff0000u); }
__device__ __forceinline__ float silu_f(float x) { return x / (1.0f + __expf(-x)); }

struct P0Item { const float* W; bf16* WT; int K, N, k0, n0, prow0; };
__device__ __forceinline__ void p0_load(const P0Item& t, int lane, f32x4 (&v)[8]) {
    const int kr = lane >> 3, n4 = (lane & 7) * 4;
#pragma unroll
    for (int i = 0; i < 8; ++i) v[i] = *(const GAS f32x4*)(t.W + (size_t)(t.k0 + kr + 8 * i) * t.N + t.n0 + n4);
}
__device__ __forceinline__ void p0_finish(const P0Item& t, int lane, const f32x4 (&v)[8], LAS float* scr) {
    const int kr = lane >> 3, n4 = (lane & 7) * 4;
#pragma unroll
    for (int i = 0; i < 8; ++i)
#pragma unroll
        for (int e = 0; e < 4; ++e) scr[(n4 + e) * 65 + kr + 8 * i] = v[i][e];
    LDS_WAIT(); asm volatile("" ::: "memory");
    const int c = lane & 7;
#pragma unroll
    for (int j = 0; j < 4; ++j) { const int n = (lane >> 3) + 8 * j; const LAS float* s = scr + n * 65 + 8 * c;
        v4u o; o.x = pk2(s[0], s[1]); o.y = pk2(s[2], s[3]); o.z = pk2(s[4], s[5]); o.w = pk2(s[6], s[7]);
        *(GAS v4u*)(t.WT + (size_t)(t.prow0 + n) * t.K + t.k0 + 8 * c) = o; }
    LDS_WAIT(); asm volatile("" ::: "memory");
}
__device__ __forceinline__ int phys_gqa(int n0) { const int w = n0 & 255; return (n0 & ~255) + 128 * ((w & 63) >> 5) + 32 * (w >> 6); }
__device__ __forceinline__ int phys_up(int n0) { return n0 < DFF ? 256 * (n0 >> 7) + (n0 & 127) : 256 * ((n0 - DFF) >> 7) + 128 + ((n0 - DFF) & 127); }

#ifndef PH_MASK
#define PH_MASK 0xfff
#endif
#define PH_EN(b) ((PH_MASK >> (b)) & 1)

#define FILL_RSTD(S) do { _Pragma("unroll") for (int h_ = 0; h_ < 2; ++h_) {     \
        const int iA_ = __builtin_amdgcn_readfirstlane((h_ * 1024 + tid) >> 8), iB_ = iA_ + 2; pg8::Unit uA_, uB_; const bool vA_ = (S).next(iA_, uA_), vB_ = (S).next(iB_, uB_); if (!vA_) break; \
        const int rA_ = uA_.pm * 256 + (tid & 255), rB_ = (vB_ ? uB_.pm : uA_.pm) * 256 + (tid & 255); float sA_ = 0.f, sB_ = 0.f; \
        { f32x4 qa_[NPART / 4], qb_[NPART / 4]; _Pragma("unroll") for (int p_ = 0; p_ < NPART / 4; ++p_) { qa_[p_] = *(const f32x4*)(rowss + (size_t)rA_ * NPART + 4 * p_); qb_[p_] = *(const f32x4*)(rowss + (size_t)rB_ * NPART + 4 * p_); } \
          _Pragma("unroll") for (int p_ = 0; p_ < NPART / 4; ++p_) { sA_ += (qa_[p_][0] + qa_[p_][1]) + (qa_[p_][2] + qa_[p_][3]); sB_ += (qb_[p_][0] + qb_[p_][1]) + (qb_[p_][2] + qb_[p_][3]); } } \
        ((LAS float*)(L + RSTD_OFF))[iA_ * 256 + (tid & 255)] = __builtin_amdgcn_rsqf(sA_ * (1.0f / DM) + NORM_EPS); \
        if (vB_) ((LAS float*)(L + RSTD_OFF))[iB_ * 256 + (tid & 255)] = __builtin_amdgcn_rsqf(sB_ * (1.0f / DM) + NORM_EPS); } __syncthreads(); } while (0)
struct Args { const float* in[N_IN]; float* out; unsigned char* ws; int ph_lo, ph_hi; };
static_assert(sizeof(Args) == (N_IN + 2) * 8 + 8, "Args has no padding");

constexpr int PH_LAYER0 = 3, PH_PER_LAYER = 7, PH_FINAL = PH_LAYER0 + DEPTH * PH_PER_LAYER, N_PHASES = PH_FINAL + 1;

__global__ void __launch_bounds__(NWAVES * 64, 2) skel_fwd(Args args) {
    extern __shared__ __attribute__((aligned(16))) unsigned char lds[];
    LAS unsigned char* const L = (LAS unsigned char*)lds;
    volatile LAS unsigned* const MISC = (volatile LAS unsigned*)(L + MISC_OFF);
    const int tid0 = threadIdx.x; const int wave0 = __builtin_amdgcn_readfirstlane(tid0 >> 6);
    const int G = gridDim.x; const int vcu = (G % 8 == 0) ? ((int)blockIdx.x % 8) * (G / 8) + (int)blockIdx.x / 8 : (int)blockIdx.x;
    const int NGW = G * NWAVES, NGT = G * NWAVES * 64;
    gu32* const ctl = (gu32*)(args.ws + WS_CTL);
    for (int u = tid0; u < (LDS_BYTES - LDSCTL_OFF) / 4; u += NWAVES * 64) ((LAS unsigned*)(L + LDSCTL_OFF))[u] = 0u;
    __syncthreads();
    const bool single = (args.ph_hi - args.ph_lo) > 1;
    XcdBarrier bar; bar.bar = (unsigned*)(ctl + 1024); bar.x = 0; bar.st = nullptr;
    if (single) bar = xcd_barrier_post((unsigned*)(ctl + 1024), MISC + 8, tid0 == 0);


#define PHASE_BEGIN(IDX, KIND) { int lo_ = args.ph_lo, hi_ = args.ph_hi; asm volatile("" : "+s"(lo_), "+s"(hi_));     \
    if (lo_ <= (IDX) && (IDX) < hi_) { \
        if ((IDX) > lo_) { int w0_ = wave0; asm volatile("" : "+s"(w0_)); const bool leader_ = w0_ == 0 && lane_id_opaque() == 0; \
            if ((KIND) == 0) xcd_barrier(bar, leader_); else if ((KIND) == 1) xcd_local_barrier(bar, leader_, -1); \
            else {   \
                const int nx_ = (int)MISC[9], vx_ = (int)MISC[11], pl_ = (16 * vx_ + nx_ - 1) / nx_, ph_ = (16 * (vx_ + 1) + nx_ - 1) / nx_; \
                const int below_ = (pl_ & 7) ? (pl_ - 1) : pl_, above_ = (ph_ & 7) ? ph_ : pl_;                             \
                xcd_local_barrier(bar, leader_, (int)XL_UPD(vx_), (int)XL_UPD((below_ * nx_) >> 4), (int)XL_UPD((above_ * nx_) >> 4), (unsigned)(KIND) - 1u); } } \
        int tid = wave0 * 64 + lane_id_opaque(); asm volatile("" : "+v"(tid)); \
        GAS unsigned char* wsg = (GAS unsigned char*)args.ws; asm volatile("" : "+s"(wsg)); unsigned char* const ws = (unsigned char*)wsg; \
        const int lane = tid & 63, wave = __builtin_amdgcn_readfirstlane(tid >> 6); \
        const int gw = vcu * NWAVES + wave, gt = vcu * (NWAVES * 64) + tid; (void)lane; (void)gw; (void)gt; \
        float* const TAB = (float*)(ws + WS_TAB); \
        bf16* const X16 = (bf16*)(ws + WS_X); bf16* const XG = (bf16*)(ws + WS_XG); bf16* const Qb = (bf16*)(ws + WS_Q); bf16* const Ob = (bf16*)(ws + WS_O); \
        bf16* const Kb = (bf16*)(ws + WS_K); bf16* const Vb = (bf16*)(ws + WS_V); bf16* const Ub = (bf16*)(ws + WS_U); bf16* const Hb = (bf16*)(ws + WS_H); \
        float* const rowss = TAB + T_ROWSS; float* const ssd = TAB + T_SSD; (void)X16; (void)XG; (void)Qb; (void)Ob; (void)Kb; (void)Vb; (void)Ub; (void)Hb; (void)rowss; (void)ssd;
#define PHASE_END } }
#define XCD_IDS int nloc = __builtin_amdgcn_readfirstlane((int)MISC[8]), nxc = __builtin_amdgcn_readfirstlane((int)MISC[9]), rk = __builtin_amdgcn_readfirstlane((int)MISC[10]), vx = __builtin_amdgcn_readfirstlane((int)MISC[11]); \
        if (nloc == 0) { nloc = G >> 3; nxc = 8; rk = (int)blockIdx.x >> 3; vx = (int)blockIdx.x & 7; }     \
        const int plo = (16 * vx + nxc - 1) / nxc, pn16 = (16 * (vx + 1) + nxc - 1) / nxc - plo; (void)rk; (void)nloc; (void)pn16
#define XCD_ROW(IDX_) ((((IDX_) >> 8) < pn16 ? plo + ((IDX_) >> 8) : 16 + plo + ((IDX_) >> 8) - pn16) * 256 + ((IDX_) & 255))
    PHASE_BEGIN(0, 0) if (PH_EN(0)) {
            LAS float* scr = (LAS float*)(L + RING_OFF + wave * 16384);
            constexpr int IQD = 16 * 96, IOD = 16 * 32, IQG = 16 * 48, IUP = 16 * 176, IDN = 44 * 32;
            constexpr int NITEMS = 2 * IQD + 2 * IOD + 2 * IQG + 2 * IOD + 4 * IUP + 4 * IDN;
#define P0_DECODE(IT, T) do { int r = (IT); \
                if (r < 2 * IQD) { const int j = r / IQD; r -= j * IQD; T = P0Item{args.in[I_WQD] + (size_t)j * DM * 3072, (bf16*)(ws + W_QD) + (size_t)j * 3072 * DM, DM, 3072, 64 * (r / 96), 32 * (r % 96), 32 * (r % 96)}; break; } r -= 2 * IQD; \
                if (r < 2 * IOD) { const int j = r / IOD; r -= j * IOD; T = P0Item{args.in[I_WOD] + (size_t)j * DM * DM, (bf16*)(ws + W_OD) + (size_t)j * DM * DM, DM, DM, 64 * (r / 32), 32 * (r % 32), 32 * (r % 32)}; break; } r -= 2 * IOD; \
                if (r < 2 * IQG) { const int j = r / IQG; r -= j * IQG; T = P0Item{args.in[I_WQG] + (size_t)j * DM * 1536, (bf16*)(ws + W_QG) + (size_t)j * 1536 * DM, DM, 1536, 64 * (r / 48), 32 * (r % 48), phys_gqa(32 * (r % 48))}; break; } r -= 2 * IQG; \
                if (r < 2 * IOD) { const int j = r / IOD; r -= j * IOD; T = P0Item{args.in[I_WOG] + (size_t)j * DM * DM, (bf16*)(ws + W_OG) + (size_t)j * DM * DM, DM, DM, 64 * (r / 32), 32 * (r % 32), 32 * (r % 32)}; break; } r -= 2 * IOD; \
                if (r < 4 * IUP) { const int l_ = r / IUP; r -= l_ * IUP; T = P0Item{args.in[I_WUP] + (size_t)l_ * DM * NUP, (bf16*)(ws + W_UP) + (size_t)l_ * NUP * DM, DM, NUP, 64 * (r / 176), 32 * (r % 176), phys_up(32 * (r % 176))}; break; } r -= 4 * IUP; \
                { const int l_ = r / IDN; r -= l_ * IDN; T = P0Item{args.in[I_WDN] + (size_t)l_ * DFF * DM, (bf16*)(ws + W_DN) + (size_t)l_ * DM * DFF, DFF, DM, 64 * (r / 32), 32 * (r % 32), 32 * (r % 32)}; } } while (0)
            { P0Item tA, tB; f32x4 vA[8], vB[8]; int it = gw < NITEMS ? gw : NITEMS - 1;
              P0_DECODE(it, tA); p0_load(tA, lane, vA);
              for (int i0 = gw; i0 < NITEMS; i0 += 2 * NGW) {
                  const int iB = i0 + NGW, iA = i0 + 2 * NGW;
                  { const int j = iB < NITEMS ? iB : NITEMS - 1; P0_DECODE(j, tB); p0_load(tB, lane, vB); }
                  p0_finish(tA, lane, vA, scr);
                  { const int j = iA < NITEMS ? iA : NITEMS - 1; P0_DECODE(j, tA); p0_load(tA, lane, vA); }
                  if (iB < NITEMS) p0_finish(tB, lane, vB, scr); } }
#undef P0_DECODE
            for (int it = gw; it < 4 * 24 * 32; it += NGW) {
                const int kc = it & 31, nb = (it >> 5) % 24, l = it / (32 * 24);
                const int k = kc * 32 + (lane & 31);
                const float sv0 = silu_f(args.in[I_CCTX][k]), sv1 = silu_f(args.in[I_C][k]), sv2 = silu_f(args.in[I_C][DM + k]);
                const float* wp = args.in[I_MODW] + ((size_t)l * DM + kc * 32) * 6144 + nb * 256 + lane * 4;
                f32x4 w[32];
#pragma unroll
                for (int kk = 0; kk < 32; ++kk) w[kk] = *(const GAS f32x4*)(wp + (size_t)kk * 6144);
                f32x4 a0 = {0.f, 0.f, 0.f, 0.f}, a1 = a0, a2 = a0;
#pragma unroll
                for (int kk = 0; kk < 32; ++kk) { a0 += w[kk] * __shfl(sv0, kk); a1 += w[kk] * __shfl(sv1, kk); a2 += w[kk] * __shfl(sv2, kk); }
                float* pp = (float*)(ws + WS_MODP) + ((size_t)(kc * 4 + l) * 3) * 6144 + nb * 256 + lane * 4;
                *(f32x4*)pp = a0; *(f32x4*)(pp + 6144) = a1; *(f32x4*)(pp + 2 * 6144) = a2;
            }
            for (int e = gt; e < 64 * 16; e += NGT) { const int pos = e >> 4, i = e & 15; const float inv = powf(10000.0f, -(float)i * (1.0f / 16.0f)); const float ang = (float)pos * inv;
                TAB[T_ROPE + 2 * e] = cosf(ang); TAB[T_ROPE + 2 * e + 1] = sinf(ang); }
            if (gw < 2) { const float* lp = args.in[I_LAMD] + gw * 256; const float a = wave_sum(lp[lane] * lp[64 + lane]), b = wave_sum(lp[128 + lane] * lp[192 + lane]);
                const float lam_init = 0.8f - 0.6f * expf(-0.3f * (float)(2 * gw)); if (lane == 0) TAB[T_LAM + gw] = expf(a) - expf(b) + lam_init; }
    } PHASE_END
    PHASE_BEGIN(1, 0) if (PH_EN(1)) {
            for (int e = gt; e < 4 * 3 * 6144; e += NGT) { const int n = e % 6144, lv = e / 6144, l = lv / 3;
                float s = args.in[I_MODB][l * 6144 + n];
#pragma unroll
                for (int kc = 0; kc < 32; ++kc) s += ((const float*)(ws + WS_MODP))[(size_t)kc * (4 * 3 * 6144) + e];
                TAB[T_MOD + e] = s;
                if (n >= 1024 && n < 2048) TAB[T_GA + lv * 1024 + (n - 1024)] = args.in[I_NATT][l * 1024 + (n - 1024)] * (1.0f + s);
                if (n >= 4096 && n < 5120) TAB[T_GF + lv * 1024 + (n - 4096)] = args.in[I_NFFN][l * 1024 + (n - 4096)] * (1.0f + s); }
    } PHASE_END
    PHASE_BEGIN(2, 0) if (PH_EN(2)) {
            for (int mat = 0; mat < 8; ++mat) {
                const int kind = mat < 2 ? 0 : (mat < 4 ? 1 : 2), idx = mat < 2 ? mat : (mat < 4 ? mat - 2 : mat - 4);
                const int nrows = kind == 0 ? 3072 : (kind == 1 ? 1536 : NUP), l = kind == 0 ? 2 * idx : (kind == 1 ? 2 * idx + 1 : idx);
                const bf16* WT = kind == 0 ? (const bf16*)(ws + W_QD) + (size_t)idx * 3072 * DM : (kind == 1 ? (const bf16*)(ws + W_QG) + (size_t)idx * 1536 * DM : (const bf16*)(ws + W_UP) + (size_t)idx * NUP * DM);
                float* outb = TAB + (kind == 0 ? T_BQD + (size_t)idx * 3 * 3072 : (kind == 1 ? T_BQG + (size_t)idx * 3 * 1536 : T_BUP + (size_t)idx * 3 * NUP));
                const float* sh = TAB + T_MOD + (size_t)l * 3 * 6144 + (kind == 2 ? 3072 : 0) + lane * 16;
                f32x4 s[3][4];
#pragma unroll
                for (int v = 0; v < 3; ++v)
#pragma unroll
                    for (int q = 0; q < 4; ++q) s[v][q] = *(const f32x4*)(sh + v * 6144 + 4 * q);
                for (int p0 = gw; p0 < nrows; p0 += 3 * NGW) {
                    v4u w0[3], w1[3]; float d[3][3];
#pragma unroll
                    for (int r = 0; r < 3; ++r) { const int p = (p0 + r * NGW < nrows) ? p0 + r * NGW : nrows - 1;
                        w0[r] = *(const GAS v4u*)(WT + (size_t)p * DM + lane * 16); w1[r] = *(const GAS v4u*)(WT + (size_t)p * DM + lane * 16 + 8); }
#pragma unroll
                    for (int r = 0; r < 3; ++r) { float wf[16];
#pragma unroll
                        for (int q = 0; q < 4; ++q) { wf[2 * q] = bf_lo(w0[r][q]); wf[2 * q + 1] = bf_hi(w0[r][q]); wf[8 + 2 * q] = bf_lo(w1[r][q]); wf[8 + 2 * q + 1] = bf_hi(w1[r][q]); }
#pragma unroll
                        for (int v = 0; v < 3; ++v) { float a = 0.f;
#pragma unroll
                            for (int q = 0; q < 4; ++q) a += (s[v][q][0] * wf[4 * q] + s[v][q][1] * wf[4 * q + 1]) + (s[v][q][2] * wf[4 * q + 2] + s[v][q][3] * wf[4 * q + 3]);
                            d[r][v] = a; } }
#pragma unroll
                    for (int o = 1; o < 64; o <<= 1)
#pragma unroll
                        for (int r = 0; r < 3; ++r)
#pragma unroll
                            for (int v = 0; v < 3; ++v) d[r][v] += __shfl_xor(d[r][v], o);
                    if (lane == 0) {
#pragma unroll
                        for (int r = 0; r < 3; ++r) { const int p = p0 + r * NGW; if (p < nrows) { outb[p] = d[r][0]; outb[nrows + p] = d[r][1]; outb[2 * nrows + p] = d[r][2]; } } }
                }
            }
            for (int mb = gw; mb < NTOK; mb += 4 * NGW) { f32x4 x[4][4], g[4][4]; int mr[4];
#pragma unroll
                for (int r = 0; r < 4; ++r) { const int m = (mb + r * NGW < NTOK) ? mb + r * NGW : mb; mr[r] = m;
                    const float* xr = (m < NPROMPT ? args.in[I_XP] + (size_t)m * DM : args.in[I_XS] + (size_t)(m - NPROMPT) * DM);
                    const float* ga = TAB + T_GA + (m < NPROMPT ? 0 : 1 + ((m - NPROMPT) >> 11)) * 1024;
#pragma unroll
                    for (int j = 0; j < 4; ++j) { x[r][j] = *(const GAS f32x4*)(xr + 256 * j + 4 * lane); g[r][j] = *(const f32x4*)(ga + 256 * j + 4 * lane); } }
#pragma unroll
                for (int r = 0; r < 4; ++r) { if (r > 0 && mb + r * NGW >= NTOK) break; const int m = mr[r]; float ss = 0.f;
#pragma unroll
                    for (int j = 0; j < 4; ++j) { const f32x4 xv = x[r][j], gv = g[r][j];
                        { u32x2v w0; w0.x = pk2(xv[0], xv[1]); w0.y = pk2(xv[2], xv[3]); *(GAS u32x2v*)(X16 + (size_t)m * DM + 256 * j + 4 * lane) = w0; } ss += (xv[0] * xv[0] + xv[1] * xv[1]) + (xv[2] * xv[2] + xv[3] * xv[3]);
                        u32x2v w; w.x = pk2(xv[0] * gv[0], xv[1] * gv[1]); w.y = pk2(xv[2] * gv[2], xv[3] * gv[3]); *(GAS u32x2v*)(XG + (size_t)m * DM + 256 * j + 4 * lane) = w; }
                    ss = wave_sum(ss);
                    if (lane < NPART) rowss[(size_t)m * NPART + lane] = lane == 0 ? ss : 0.f; } }
    } PHASE_END
    for (int l = 0; l < DEPTH; ++l) { const int j = l >> 1, pb = PH_LAYER0 + PH_PER_LAYER * l; const bool diff = (l & 1) == 0;
        PHASE_BEGIN(pb + 0, (l == 0 ? 0 : 1))
                XCD_IDS;
                if (diff) { if (PH_EN(3)) {
                    if (l == 0) for (int e = gt; e < 2 * 8 * 256 * 32; e += NGT) { const int d4 = e & 31, p = (e >> 5) & 255, h = (e >> 13) & 7, b = e >> 16;
                        const size_t src = ((((size_t)b * 2 + j) * 8 + h) * 256 + p) * 128 + d4 * 4, dst = ((size_t)(4096 + b * 2304 + p)) * DM + h * 128 + d4 * 4;
                        const f32x4 k = *(const GAS f32x4*)(args.in[I_CKD] + src), vv = *(const GAS f32x4*)(args.in[I_CVD] + src);
                        u32x2v w; w.x = pk2(k[0], k[1]); w.y = pk2(k[2], k[3]); *(GAS u32x2v*)(Kb + dst) = w; w.x = pk2(vv[0], vv[1]); w.y = pk2(vv[2], vv[3]); *(GAS u32x2v*)(Vb + dst) = w; }
                    pg8::Gemm g{XG, (const bf16*)(ws + W_QD) + (size_t)j * 3072 * DM, NTOK, 3072, DM};
                    pg8::XcdOrder S{plo, pn16, 24, rk, nloc, (pn16 == 2 && nloc == 32) ? 1 : 0};

                    FILL_RSTD(S);
                    pg8::EpiQkvDiff E{Qb, Kb, Vb, TAB + T_BQD + (size_t)j * 3 * 3072, (const LAS float*)(L + RSTD_OFF), TAB + T_ROPE, args.out + OUT_NKD + (size_t)j * 8 * 256 * 128, args.out + OUT_NVD + (size_t)j * 8 * 256 * 128};
                    pg8::gemm_phase<pg8::EpiQkvDiff, pg8::XcdOrder, true, true, true>(L + RING_OFF, g, S, E, wave0);
                } } else if (PH_EN(4)) {
                    if (l == 0) for (int e = gt; e < 2 * 4 * 256 * 16; e += NGT) { const int d4 = e & 15, p = (e >> 4) & 255, h = (e >> 12) & 3, b = e >> 14;
                        const size_t src = ((((size_t)b * 2 + j) * 4 + h) * 256 + p) * 64 + d4 * 4, dst = ((size_t)(4096 + b * 2304 + p)) * 256 + h * 64 + d4 * 4;
                        const f32x4 k = *(const GAS f32x4*)(args.in[I_CKG] + src), vv = *(const GAS f32x4*)(args.in[I_CVG] + src);
                        u32x2v w; w.x = pk2(k[0], k[1]); w.y = pk2(k[2], k[3]); *(GAS u32x2v*)(Kb + dst) = w; w.x = pk2(vv[0], vv[1]); w.y = pk2(vv[2], vv[3]); *(GAS u32x2v*)(Vb + dst) = w; }
                    pg8::Gemm g{XG, (const bf16*)(ws + W_QG) + (size_t)j * 1536 * DM, NTOK, 1536, DM}; pg8::XcdOrder S{plo, pn16, 6, rk, nloc, 0};
                    FILL_RSTD(S);
                    pg8::EpiQkvGqa E{Qb, Kb, Vb, TAB + T_BQG + (size_t)j * 3 * 1536, (const LAS float*)(L + RSTD_OFF), TAB + T_ROPE, args.in[I_QNG] + j * 64, args.in[I_KNG] + j * 64,
                                     args.out + OUT_NKG + (size_t)j * 4 * 256 * 64, args.out + OUT_NVG + (size_t)j * 4 * 256 * 64};
                    pg8::gemm_phase<pg8::EpiQkvGqa, pg8::XcdOrder, true, true>(L + RING_OFF, g, S, E, wave0);
                }
        PHASE_END
        PHASE_BEGIN(pb + 1, 0) if (PH_EN(5)) {
                static_assert(attn_body::ATTN_LDS_BYTES <= RING_BYTES, "attention LDS inside the ring region");
                const float oml = __int_as_float(__builtin_amdgcn_readfirstlane(__float_as_int(1.0f - (0.8f - 0.6f * expf(-0.3f * (float)l))))), lam = __int_as_float(__builtin_amdgcn_readfirstlane(__float_as_int(diff ? TAB[T_LAM + j] : 0.f)));
                for (int u = vcu; u < 512; u += G) {
                    attn_body::AttnJob J; const bool lat = u < 256; const int uu = u & 255; int m0, k0; J.comb = 0; J.flag = nullptr; J.target = 0u; J.lam = lam; J.oml = oml; J.sw = args.in[I_SUBLN] + j * 128;
                    if (diff) { int b, h, p; if (lat) { b = uu >> 7; h = (uu >> 4) & 7; const int qb = (uu >> 1) & 7; p = uu & 1; m0 = NPROMPT + b * 2048 + qb * 256; k0 = NPROMPT + b * 2304; }
                                else { b = uu >> 4; h = (uu >> 1) & 7; p = uu & 1; m0 = b * 256; k0 = m0; }
                        J.Q = (const attn_body::bf16*)Qb + (size_t)m0 * DM + h * 128 + p * 64; J.QP = DM; J.K = (const attn_body::bf16*)Kb + (size_t)k0 * DM + h * 128 + p * 64; J.KP = DM;
                        J.V = (const attn_body::bf16*)Vb + (size_t)k0 * DM + h * 128; J.VP = DM; J.O = (attn_body::bf16*)Ob + (size_t)m0 * DM + h * 128; J.OP = DM; J.NT = lat ? 36 : 4;
                        J.comb = p; J.flag = (unsigned*)(ws + WS_CTL) + 8192 + (u >> 1); J.target = (unsigned)(j + 1);
                        attn_body::attn_unit<8, 128>(J, (char*)lds + RING_OFF, wave0); }
                    else { int b, hq; if (lat) { b = uu >> 7; hq = (uu >> 3) & 15; const int qb = uu & 7; m0 = NPROMPT + b * 2048 + qb * 256; k0 = NPROMPT + b * 2304; } else { b = uu >> 4; hq = uu & 15; m0 = b * 256; k0 = m0; }
                        J.Q = (const attn_body::bf16*)Qb + (size_t)m0 * DM + hq * 64; J.QP = DM; J.K = (const attn_body::bf16*)Kb + (size_t)k0 * 256 + (hq >> 2) * 64; J.KP = 256;
                        J.V = (const attn_body::bf16*)Vb + (size_t)k0 * 256 + (hq >> 2) * 64; J.VP = 256; J.O = (attn_body::bf16*)Ob + (size_t)m0 * DM + hq * 64; J.OP = DM; J.NT = lat ? 36 : 4;
                        attn_body::attn_unit<8, 64>(J, (char*)lds + RING_OFF, wave0); }
                }
        } PHASE_END
        PHASE_BEGIN(pb + 3, 0) if (PH_EN(7)) { XCD_IDS;
                pg8::Gemm g{Ob, (const bf16*)(ws + (diff ? W_OD : W_OG)) + (size_t)j * DM * DM, NTOK, DM, DM}; pg8::XcdOrder S{plo, pn16, 8, rk, nloc, 0};
                pg8::EpiResid E{X16, XG, TAB + T_MOD + (size_t)l * 3 * 6144 + 2048, 6144, TAB + T_GF + (size_t)l * 3 * 1024, rowss};
                const int ln_ = l + 1, jn_ = ln_ >> 1; const bool dn_ = (ln_ & 1) == 0; const int nit_ = ln_ < DEPTH ? (dn_ ? 2 * 8 * 256 * 32 : 2 * 4 * 256 * 16) : 0;
#define KV_ITEM(E_, SRC_, DST_) do { if (dn_) { const int d4 = (E_) & 31, p = ((E_) >> 5) & 255, h = ((E_) >> 13) & 7, b = (E_) >> 16; \
                        SRC_ = ((((size_t)b * 2 + jn_) * 8 + h) * 256 + p) * 128 + d4 * 4; DST_ = ((size_t)(4096 + b * 2304 + p)) * DM + h * 128 + d4 * 4; } \
                    else { const int d4 = (E_) & 15, p = ((E_) >> 4) & 255, h = ((E_) >> 12) & 3, b = (E_) >> 14; \
                        SRC_ = ((((size_t)b * 2 + jn_) * 4 + h) * 256 + p) * 64 + d4 * 4; DST_ = ((size_t)(4096 + b * 2304 + p)) * 256 + h * 64 + d4 * 4; } } while (0)
                const float* cks_ = args.in[dn_ ? I_CKD : I_CKG]; const float* cvs_ = args.in[dn_ ? I_CVD : I_CVG];
                f32x4 ck_ = {0.f, 0.f, 0.f, 0.f}, cv_ = ck_; size_t cdst_ = 0; const bool cok_ = gt < nit_;
                if (cok_) { size_t src_; KV_ITEM(gt, src_, cdst_); ck_ = *(const GAS f32x4*)(cks_ + src_); cv_ = *(const GAS f32x4*)(cvs_ + src_); }
                pg8::gemm_phase<pg8::EpiResid, pg8::XcdOrder, true, true, true>(L + RING_OFF, g, S, E, wave0);
                if (cok_) { u32x2v w; w.x = pk2(ck_[0], ck_[1]); w.y = pk2(ck_[2], ck_[3]); *(GAS u32x2v*)(Kb + cdst_) = w; w.x = pk2(cv_[0], cv_[1]); w.y = pk2(cv_[2], cv_[3]); *(GAS u32x2v*)(Vb + cdst_) = w; }
                for (int e = gt + NGT; e < nit_; e += NGT) { size_t src_, dst_; KV_ITEM(e, src_, dst_); const f32x4 k = *(const GAS f32x4*)(cks_ + src_), vv = *(const GAS f32x4*)(cvs_ + src_);
                    u32x2v w; w.x = pk2(k[0], k[1]); w.y = pk2(k[2], k[3]); *(GAS u32x2v*)(Kb + dst_) = w; w.x = pk2(vv[0], vv[1]); w.y = pk2(vv[2], vv[3]); *(GAS u32x2v*)(Vb + dst_) = w; }
#undef KV_ITEM
        } PHASE_END
        PHASE_BEGIN(pb + 4, 1) if (PH_EN(8)) { XCD_IDS;
                pg8::Gemm g{XG, (const bf16*)(ws + W_UP) + (size_t)l * NUP * DM, NTOK, NUP, DM}; pg8::XcdOrder S{plo, pn16, 22, rk, nloc, 0};
                FILL_RSTD(S);
                pg8::EpiUpConv E{Hb, TAB + T_BUP + (size_t)l * 3 * NUP, args.in[I_CONVW] + (size_t)l * 3 * NUP, args.in[I_CONVB] + (size_t)l * NUP, (const LAS float*)(L + RSTD_OFF), (LAS float*)(L + EDGE_OFF), (float*)Ub};
                pg8::gemm_phase<pg8::EpiUpConv, pg8::XcdOrder, true, true>(L + RING_OFF, g, S, E, wave0);
        } PHASE_END
        PHASE_BEGIN(pb + 6, (2 + l)) if (PH_EN(10)) { XCD_IDS;
                pg8::Gemm g{Hb, (const bf16*)(ws + W_DN) + (size_t)l * DM * DFF, NTOK, DM, DFF}; pg8::XcdOrder S{plo, pn16, 8, rk, nloc, 0};
                { pg8::Unit uu; const float* ue = (const float*)Ub; const float* cw = args.in[I_CONVW] + (size_t)l * 3 * NUP; const float* cb = args.in[I_CONVB] + (size_t)l * NUP;
                  for (int i = 0; S.next(i, uu); ++i) { if (uu.pm < 16) continue; const int qb = (uu.pm - 16) & 7;
                    u32x2v hq[3]; bool doit[3]; size_t hoff[3];
#pragma unroll
                    for (int k = 0; k < 3; ++k) { int idx = tid + NWAVES * 64 * k; const bool ok_ = idx < 2 * (DFF / 4); idx = ok_ ? idx : 2 * (DFF / 4) - 1;
                        const int which = idx >= DFF / 4 ? 1 : 0, c4 = 4 * (idx - (DFF / 4) * which);
                        doit[k] = ok_ && !(which == 0 ? qb == 0 : qb == 7);
                        const int pc = 256 * (c4 >> 7) + (c4 & 127);
                        const float* r0 = ue + ((size_t)(which == 0 ? (uu.pm - 1) * 4 + 3 : uu.pm * 4 + 2)) * NUP + pc;
                        const float* r1 = ue + ((size_t)(which == 0 ? uu.pm * 4 + 0 : uu.pm * 4 + 3)) * NUP + pc;
                        const float* r2 = ue + ((size_t)(which == 0 ? uu.pm * 4 + 1 : (uu.pm + 1) * 4 + 0)) * NUP + pc;
                        const f32x4 a0 = *(const f32x4*)r0, a1 = *(const f32x4*)r1, a2 = *(const f32x4*)r2, b0 = *(const f32x4*)(r0 + 128), b1 = *(const f32x4*)(r1 + 128), b2 = *(const f32x4*)(r2 + 128);
                        const f32x4 wg0 = *(const f32x4*)(cw + c4), wg1 = *(const f32x4*)(cw + NUP + c4), wg2 = *(const f32x4*)(cw + 2 * NUP + c4), cg = *(const f32x4*)(cb + c4);
                        const f32x4 wv0 = *(const f32x4*)(cw + DFF + c4), wv1 = *(const f32x4*)(cw + NUP + DFF + c4), wv2 = *(const f32x4*)(cw + 2 * NUP + DFF + c4), cv = *(const f32x4*)(cb + DFF + c4);
                        const f32x4 gg = a0 * wg0 + a1 * wg1 + a2 * wg2 + cg, vv = b0 * wv0 + b1 * wv1 + b2 * wv2 + cv;
                        hq[k].x = pk2(silu_f(gg[0]) * vv[0], silu_f(gg[1]) * vv[1]); hq[k].y = pk2(silu_f(gg[2]) * vv[2], silu_f(gg[3]) * vv[3]);
                        hoff[k] = (size_t)(uu.pm * 256 + (which ? 255 : 0)) * DFF + c4; }
#pragma unroll
                    for (int k = 0; k < 3; ++k) if (doit[k]) *(GAS u32x2v*)(Hb + hoff[k]) = hq[k]; }
                  VM_WAIT(); __syncthreads(); }
                pg8::EpiResid E{X16, XG, TAB + T_MOD + (size_t)l * 3 * 6144 + 5120, 6144, l + 1 < DEPTH ? TAB + T_GA + (size_t)(l + 1) * 3 * 1024 : nullptr, rowss};
                pg8::gemm_phase<pg8::EpiResid, pg8::XcdOrder, true, true, true>(L + RING_OFF, g, S, E, wave0);
        } PHASE_END
    }
    PHASE_BEGIN(PH_FINAL, 1) if (PH_EN(11)) { XCD_IDS;
            { const int nrow = 2 * pn16 * 256, st = nloc * NWAVES; f32x4 w4[4];
#pragma unroll
              for (int jj = 0; jj < 4; ++jj) w4[jj] = *(const f32x4*)(args.in[I_FNORM] + 256 * jj + 4 * lane);
              for (int rb = rk * NWAVES + wave; rb < nrow; rb += 4 * st) { float sv[4]; u32x2v xb[4][4]; int mr[4];
#pragma unroll
                for (int r = 0; r < 4; ++r) { const int ri = (rb + r * st < nrow) ? rb + r * st : rb; const int m = XCD_ROW(ri); mr[r] = m; sv[r] = lane < NPART ? rowss[(size_t)m * NPART + lane] : 0.f;
#pragma unroll
                    for (int jj = 0; jj < 4; ++jj) xb[r][jj] = *(const GAS u32x2v*)(X16 + (size_t)m * DM + 256 * jj + 4 * lane); }
#pragma unroll
                for (int r = 0; r < 4; ++r) { if (r > 0 && rb + r * st >= nrow) break; const float rs = __builtin_amdgcn_rsqf(wave_sum(sv[r]) * (1.0f / DM) + NORM_EPS);
#pragma unroll
                    for (int jj = 0; jj < 4; ++jj) { const f32x4 x = (f32x4){bf_lo(xb[r][jj].x), bf_hi(xb[r][jj].x), bf_lo(xb[r][jj].y), bf_hi(xb[r][jj].y)};
                        *(GAS f32x4*)(args.out + OUT_Y + (size_t)mr[r] * DM + 256 * jj + 4 * lane) = x * rs * w4[jj]; } } } }
    } PHASE_END
#undef PHASE_BEGIN
#undef PHASE_END
}
#ifndef MK_MULTI
#define MK_MULTI 0
#endif
extern "C" void kernel_launch(void* const* d_in, const int* in_sizes, int n_in, void* d_out, int out_size, void* d_ws, size_t ws_size, hipStream_t stream) {
    static int grid = 0;
    if (grid == 0) {
        if (n_in != N_IN || out_size != (int)OUT_TOTAL || ws_size < WS_END) { fprintf(stderr, "kernel_launch: unexpected problem: n_in %d out %d ws %zu (need %zu)\n", n_in, out_size, ws_size, (size_t)WS_END); grid = -1; return; }
        int dev = 0, cus = 0, per_cu = 0;
        if (hipGetDevice(&dev) != hipSuccess || hipDeviceGetAttribute(&cus, hipDeviceAttributeMultiprocessorCount, dev) != hipSuccess) { grid = -1; return; }
        if (hipFuncSetAttribute((const void*)skel_fwd, hipFuncAttributeMaxDynamicSharedMemorySize, LDS_BYTES) != hipSuccess) { fprintf(stderr, "kernel_launch: hipFuncSetAttribute failed\n"); grid = -1; return; }
        if (hipOccupancyMaxActiveBlocksPerMultiprocessor(&per_cu, (const void*)skel_fwd, NWAVES * 64, LDS_BYTES) != hipSuccess || per_cu < 1) { fprintf(stderr, "kernel_launch: occupancy query says %d\n", per_cu); per_cu = 1; }
        (void)hipGetLastError();
        grid = cus;
        if (grid % 8 != 0) grid -= grid % 8;
    }
    if (grid < 0) return;
    (void)hipMemsetAsync((char*)d_ws + WS_CTL, 0, CTL_ZERO_BYTES, stream);
    Args a{};
    for (int i = 0; i < N_IN; ++i) a.in[i] = (const float*)d_in[i];
    a.out = (float*)d_out; a.ws = (unsigned char*)d_ws;
#if MK_MULTI
    for (int ph = 0; ph < N_PHASES; ++ph) {
        if (ph >= PH_LAYER0 && ph < PH_FINAL) { const int l_ = (ph - PH_LAYER0) / PH_PER_LAYER, sub_ = (ph - PH_LAYER0) % PH_PER_LAYER; if (sub_ == 5 || sub_ == 2) continue; }
        a.ph_lo = ph; a.ph_hi = ph + 1;
        int nrep = 1;
        for (int rep = 0; rep < nrep; ++rep)
        hipLaunchKernelGGL(skel_fwd, dim3(grid), dim3(NWAVES * 64), LDS_BYTES, stream, a);
    }
#else
    a.ph_lo = 0; a.ph_hi = N_PHASES;
    hipLaunchKernelGGL(skel_fwd, dim3(grid), dim3(NWAVES * 64), LDS_BYTES, stream, a);
#endif
    const hipError_t le = hipPeekAtLastError();
    if (le != hipSuccess) fprintf(stderr, "kernel_launch: launch failed: %s\n", hipGetErrorName(le));
}
```

```cpp
#include <hip/hip_runtime.h>
#include <hip/hip_bf16.h>
#include <cstdio>
#include <cstdint>
#include <cmath>
#define MK_MULTI 0
__device__ __forceinline__ int lane_id_opaque() { unsigned m_ = ~0u; asm volatile("" : "+s"(m_)); return (int)__builtin_amdgcn_mbcnt_hi(m_, __builtin_amdgcn_mbcnt_lo(m_, 0u)); }
namespace pg8 {
#define PG8_LAS __attribute__((address_space(3)))
typedef unsigned short bf16_t;
typedef short bf16x8 __attribute__((ext_vector_type(8)));
typedef float f32x4 __attribute__((ext_vector_type(4)));
typedef unsigned u32x4 __attribute__((ext_vector_type(4)));
constexpr int BM = 256, BK = 64, HALF = 128, HTB = HALF * BK * 2  , STAGE_BYTES = 8 * HTB, NXCD = 8, WGM = 8;

__host__ __device__ __forceinline__ int lds_byte(int r, int c) { const int st = (r >> 4) * 2 + (c >> 5), rr = r & 15, cc = c & 31, ob = rr * 64 + cc * 2; return st * 1024 + (ob ^ (((ob >> 9) & 1) << 5)); }
__host__ __device__ __forceinline__ void stage_rc(int b, int& R, int& C) { const int st = b / 1024, sb = b % 1024, swz = sb ^ (((sb >> 9) & 1) << 5); R = (st >> 1) * 16 + swz / 64; C = (st & 1) * 32 + (swz % 64) / 2; }
__host__ __device__ __forceinline__ int perm32(int rho) { const int n = rho >> 4, i = rho & 15; return 8 * (i >> 2) + 4 * n + (i & 3); }

struct Unit { int pm, pn, idx; };
struct Gemm { const bf16_t* A; const bf16_t* Bt; int M, N, K; };

struct StaticOrder {
    int nM, nN, nwg, G, c;
    __host__ __device__ void init(int M, int N, int G_, int c_, int bn = BM) { nM = M / BM; nN = N / bn; nwg = nM * nN; G = G_; c = c_; }
    __host__ __device__ bool next(int i, Unit& u) const {
        const long L = (long)i * G + c; if (L >= nwg) return false;
        int wgid = (int)L; { const int q = nwg / NXCD, r = nwg % NXCD, xcd = wgid % NXCD, off = wgid / NXCD; wgid = (xcd < r ? xcd * (q + 1) : r * (q + 1) + (xcd - r) * q) + off; }
        const int nig = WGM * nN, gid = wgid / nig, fm = gid * WGM, gsz = (nM - fm) < WGM ? (nM - fm) : WGM;
        u.pm = fm + ((wgid % nig) % gsz); u.pn = (wgid % nig) / gsz; u.idx = i; return true;
    }
    __device__ __forceinline__ void a_ready(const Unit&) const {}
    __device__ __forceinline__ void done(const Unit&) const {}
};

struct DiffQkvOrder {
    int vcu, G;
    __host__ __device__ bool next(int i, Unit& u) const {
        const int e = i * G + vcu; if (e >= 768) return false;
        const int vc = e & 255, r = e >> 8, x = vc >> 5, c = vc & 31, rh = c % 3;
        if (r == rh) { u.pm = 2 * x + (c >> 4); u.pn = 8 + (c & 15); }
        else { const int li = c + 32 * ((r > rh) ? r - 1 : r);
            if (li < 16) { u.pm = 2 * x + (li >> 3); u.pn = li & 7; } else { const int t = li - 16; u.pm = 16 + 2 * x + t / 24; u.pn = t % 24; } }
        u.idx = i; return true;
    }
    __device__ __forceinline__ void a_ready(const Unit&) const {}
    __device__ __forceinline__ void done(const Unit&) const {}
};


struct XcdOrder {
    int lo, n16, nN, r, nloc, dq;
    __device__ __forceinline__ bool next(int i, Unit& u) const {
        const int e = i * nloc + r;
        if (dq) { if (e >= 96) return false; const int rh = r % 3;
            if (i == rh) { u.pm = lo + (r >> 4); u.pn = 8 + (r & 15); }
            else { const int li = r + 32 * ((i > rh) ? i - 1 : i);
                if (li < 16) { u.pm = lo + (li >> 3); u.pn = li & 7; } else { const int t = li - 16; u.pm = 16 + lo + t / 24; u.pn = t % 24; } } }
        else { const int np = 2 * n16; if (e >= np * nN) return false; const int pn = e / np, pi = e - pn * np; u.pn = pn; u.pm = pi < n16 ? lo + pi : 16 + lo + (pi - n16); }
        u.idx = i; return true;
    }
    __device__ __forceinline__ void a_ready(const Unit&) const {}
    __device__ __forceinline__ void done(const Unit&) const {}
};
__device__ __forceinline__ unsigned cvt_pk_bf16(float lo, float hi) { unsigned r; asm volatile("v_cvt_pk_bf16_f32 %0, %1, %2" : "=v"(r) : "v"(lo), "v"(hi)); return r; }
typedef float f32x2 __attribute__((ext_vector_type(2)));
template <class Epi, class Sched, bool ALIGN_EPI = false, bool SP2 = false, bool NARROW = false>
__device__ __forceinline__ void gemm_phase(PG8_LAS unsigned char* lds, const Gemm g, const Sched& S, const Epi& E, const int wave_id) {
    int tid_ = wave_id * 64 + lane_id_opaque(); asm volatile("" : "+v"(tid_));
    const int tid = tid_, wid = __builtin_amdgcn_readfirstlane(tid >> 6), lane = tid & 63, wr = wid >> 2, wc = wid & 3, fr = lane & 15, fq = lane >> 4;
    const int K = g.K, nt = K / BK;
    unsigned voffA[2], voffB[2];
#pragma unroll
    for (int i = 0; i < 2; ++i) { int R, C; stage_rc(tid * 16 + i * 8192, R, C); const int Rb = Epi::PERM ? ((R & ~31) + perm32(R & 31)) : R;
        voffA[i] = (unsigned)(R * K + C) * 2u; voffB[i] = (unsigned)(Rb * K + C) * 2u; }
    const size_t kstep = (size_t)(BK * 2);
    const size_t hstep = (size_t)HALF * K * 2;
    const size_t tstep = 2 * hstep;
    const size_t tstepB = NARROW ? hstep : tstep;
    static_assert(!NARROW || SP2, "NARROW is an SP2 variant");
    const unsigned ldsw = (unsigned)wid * 1024u;
    const int aoff = lds_byte(wr * 64 + fr, fq * 8), boff = lds_byte(wc * 32 + fr, fq * 8);
#define PG8_SA(b, h) (((b) * 2 + (h)) * HTB)
#define PG8_SB(b, h) ((4 + (b) * 2 + (h)) * HTB)
#define PG8_STAGE(bufoff, gbase, voff) do { _Pragma("unroll") for (int _i = 0; _i < 2; ++_i) \
        __builtin_amdgcn_global_load_lds((const unsigned*)((const char*)(gbase) + (voff)[_i]), (PG8_LAS unsigned*)(lds + (bufoff) + ldsw + _i * 8192), 16, 0, 0); } while (0)
#define PG8_LDA(dst, b, h) do { _Pragma("unroll") for (int m = 0; m < 4; ++m) _Pragma("unroll") for (int k = 0; k < 2; ++k) dst[m][k] = *(const PG8_LAS bf16x8*)(lds + PG8_SA(b, h) + aoff + m * 2048 + k * 1024); } while (0)
#define PG8_LDB(dst, b, h) do { _Pragma("unroll") for (int n = 0; n < 2; ++n) _Pragma("unroll") for (int k = 0; k < 2; ++k) dst[n][k] = *(const PG8_LAS bf16x8*)(lds + PG8_SB(b, h) + boff + n * 2048 + k * 1024); } while (0)
#define PG8_MMA(ai, bj, At, Bt) do { __builtin_amdgcn_s_setprio(1); _Pragma("unroll") for (int m = 0; m < 4; ++m) _Pragma("unroll") for (int n = 0; n < 2; ++n) _Pragma("unroll") for (int k = 0; k < 2; ++k) \
        acc[ai][bj][m][n] = __builtin_amdgcn_mfma_f32_16x16x32_bf16(Bt[n][k], At[m][k], acc[ai][bj][m][n], 0, 0, 0); __builtin_amdgcn_s_setprio(0); } while (0)
#define PG8_WAIT_V(n) asm volatile("s_waitcnt vmcnt(" #n ")" ::: "memory")
#define PG8_WAIT_L(n) asm volatile("s_waitcnt lgkmcnt(" #n ")" ::: "memory")
#define PG8_BAR __builtin_amdgcn_s_barrier()
#define PG8_SCHED __builtin_amdgcn_sched_barrier(0)
    Unit cur, nxt; int ui = 0;
    if (!S.next(0, cur)) return;
    f32x4 acc[2][2][4][2];
#pragma unroll
    for (int a = 0; a < 2; ++a)
#pragma unroll
        for (int b = 0; b < 2; ++b)
#pragma unroll
            for (int m = 0; m < 4; ++m)
#pragma unroll
                for (int n = 0; n < 2; ++n) acc[a][b][m][n] = (f32x4){0.f, 0.f, 0.f, 0.f};
    bf16x8 At[4][2], B0[2][2], B1[2][2];
    const char* cA = (const char*)g.A + (size_t)cur.pm * tstep; const char* cB = (const char*)g.Bt + (size_t)cur.pn * tstepB;
    S.a_ready(cur);
    if constexpr (SP2) {
        if constexpr (NARROW) {
        PG8_STAGE(PG8_SB(0, 0), cB, voffB); PG8_STAGE(PG8_SA(0, 0), cA, voffA); PG8_STAGE(PG8_SA(0, 1), cA + hstep, voffA);
        if (wr == 1) PG8_BAR;
        PG8_WAIT_V(2); PG8_BAR;
        PG8_STAGE(PG8_SB(1, 0), cB + kstep, voffB); PG8_STAGE(PG8_SA(1, 0), cA + kstep, voffA);
        PG8_WAIT_V(4); PG8_BAR;
        } else {
        PG8_STAGE(PG8_SB(0, 0), cB, voffB); PG8_STAGE(PG8_SB(0, 1), cB + hstep, voffB); PG8_STAGE(PG8_SA(0, 0), cA, voffA); PG8_STAGE(PG8_SA(0, 1), cA + hstep, voffA);
        if (wr == 1) PG8_BAR;
        PG8_WAIT_V(2); PG8_BAR;
        PG8_STAGE(PG8_SB(1, 0), cB + kstep, voffB); PG8_STAGE(PG8_SA(1, 0), cA + kstep, voffA); PG8_STAGE(PG8_SB(1, 1), cB + hstep + kstep, voffB);
        PG8_WAIT_V(6); PG8_BAR;
        }
    } else {
        PG8_STAGE(PG8_SB(0, 0), cB, voffB); PG8_STAGE(PG8_SA(0, 0), cA, voffA); PG8_STAGE(PG8_SB(0, 1), cB + hstep, voffB); PG8_STAGE(PG8_SA(0, 1), cA + hstep, voffA);
        if (wr == 1) PG8_BAR;
        PG8_WAIT_V(4); PG8_BAR;
        PG8_STAGE(PG8_SB(1, 0), cB + kstep, voffB); PG8_STAGE(PG8_SA(1, 0), cA + kstep, voffA); PG8_STAGE(PG8_SB(1, 1), cB + hstep + kstep, voffB);
        PG8_WAIT_V(6); PG8_BAR;
    }
    for (;;) {
        const bool has_next = S.next(ui + 1, nxt);
        const char* nA = has_next ? (const char*)g.A + (size_t)nxt.pm * tstep : cA; const char* nB = has_next ? (const char*)g.Bt + (size_t)nxt.pn * tstepB : cB;
        for (int t = 0; t < nt; t += 2) {
            const bool last = (t == nt - 2);
            const char* a1 = cA + (size_t)(t + 1) * kstep;
            const char* a2 = last ? nA : cA + (size_t)(t + 2) * kstep; const char* b2 = last ? nB : cB + (size_t)(t + 2) * kstep;
            const char* a3 = a2 + kstep; const char* b3 = b2 + kstep;
            if (last && has_next) S.a_ready(nxt);
            if constexpr (SP2 && NARROW) {
            PG8_LDB(B0, 0, 0); PG8_SCHED; PG8_LDA(At, 0, 0); PG8_STAGE(PG8_SA(1, 1), a1 + hstep, voffA);
            PG8_WAIT_V(6); PG8_WAIT_L(0); PG8_BAR; PG8_MMA(0, 0, At, B0); PG8_BAR; PG8_SCHED;
            PG8_LDA(At, 0, 1); PG8_STAGE(PG8_SB(0, 0), b2, voffB); PG8_STAGE(PG8_SA(0, 0), a2, voffA);
            PG8_WAIT_V(6); PG8_WAIT_L(0); PG8_BAR; PG8_MMA(1, 0, At, B0); PG8_BAR; PG8_SCHED;
            PG8_LDB(B0, 1, 0); PG8_SCHED; PG8_LDA(At, 1, 0); PG8_STAGE(PG8_SA(0, 1), a2 + hstep, voffA);
            PG8_WAIT_V(6); PG8_WAIT_L(0); PG8_BAR; PG8_MMA(0, 0, At, B0); PG8_BAR; PG8_SCHED;
            PG8_LDA(At, 1, 1); PG8_STAGE(PG8_SB(1, 0), b3, voffB); PG8_STAGE(PG8_SA(1, 0), a3, voffA);
            PG8_WAIT_V(6); PG8_WAIT_L(0); PG8_BAR; PG8_MMA(1, 0, At, B0); PG8_BAR; PG8_SCHED;
            } else if constexpr (SP2) {
            PG8_LDB(B0, 0, 0); PG8_LDB(B1, 0, 1); PG8_SCHED; PG8_LDA(At, 0, 0); PG8_STAGE(PG8_SA(1, 1), a1 + hstep, voffA);
            PG8_WAIT_V(8); PG8_WAIT_L(0); PG8_BAR; PG8_MMA(0, 0, At, B0); PG8_MMA(0, 1, At, B1); PG8_BAR; PG8_SCHED;
            PG8_LDA(At, 0, 1); PG8_STAGE(PG8_SB(0, 0), b2, voffB); PG8_STAGE(PG8_SB(0, 1), b2 + hstep, voffB); PG8_STAGE(PG8_SA(0, 0), a2, voffA);
            PG8_WAIT_V(8); PG8_WAIT_L(0); PG8_BAR; PG8_MMA(1, 0, At, B0); PG8_MMA(1, 1, At, B1); PG8_BAR; PG8_SCHED;
            PG8_LDB(B0, 1, 0); PG8_LDB(B1, 1, 1); PG8_SCHED; PG8_LDA(At, 1, 0); PG8_STAGE(PG8_SA(0, 1), a2 + hstep, voffA);
            PG8_WAIT_V(8); PG8_WAIT_L(0); PG8_BAR; PG8_MMA(0, 0, At, B0); PG8_MMA(0, 1, At, B1); PG8_BAR; PG8_SCHED;
            PG8_LDA(At, 1, 1); PG8_STAGE(PG8_SB(1, 0), b3, voffB); PG8_STAGE(PG8_SB(1, 1), b3 + hstep, voffB); PG8_STAGE(PG8_SA(1, 0), a3, voffA);
            PG8_WAIT_V(8); PG8_WAIT_L(0); PG8_BAR; PG8_MMA(1, 0, At, B0); PG8_MMA(1, 1, At, B1); PG8_BAR; PG8_SCHED;
            } else {
            PG8_LDB(B0, 0, 0); PG8_SCHED; PG8_LDA(At, 0, 0); PG8_STAGE(PG8_SA(1, 1), a1 + hstep, voffA);
            PG8_WAIT_L(8); PG8_BAR; PG8_WAIT_L(0); PG8_MMA(0, 0, At, B0); PG8_BAR; PG8_SCHED;
            PG8_LDB(B1, 0, 1); PG8_STAGE(PG8_SB(0, 0), b2, voffB);
            PG8_BAR; PG8_WAIT_L(0); PG8_MMA(0, 1, At, B1); PG8_BAR;
            PG8_LDA(At, 0, 1); PG8_STAGE(PG8_SA(0, 0), a2, voffA);
            PG8_BAR; PG8_WAIT_L(0); PG8_MMA(1, 0, At, B0); PG8_BAR; PG8_SCHED;
            PG8_STAGE(PG8_SB(0, 1), b2 + hstep, voffB);
            PG8_WAIT_V(6); PG8_BAR; PG8_MMA(1, 1, At, B1); PG8_BAR;
            PG8_LDB(B0, 1, 0); PG8_SCHED; PG8_LDA(At, 1, 0); PG8_STAGE(PG8_SA(0, 1), a2 + hstep, voffA);
            PG8_WAIT_L(8); PG8_BAR; PG8_WAIT_L(0); PG8_MMA(0, 0, At, B0); PG8_BAR; PG8_SCHED;
            PG8_LDB(B1, 1, 1); PG8_STAGE(PG8_SB(1, 0), b3, voffB);
            PG8_BAR; PG8_WAIT_L(0); PG8_MMA(0, 1, At, B1); PG8_BAR;
            PG8_LDA(At, 1, 1); PG8_STAGE(PG8_SA(1, 0), a3, voffA);
            PG8_BAR; PG8_WAIT_L(0); PG8_MMA(1, 0, At, B0); PG8_BAR; PG8_SCHED;
            PG8_STAGE(PG8_SB(1, 1), b3 + hstep, voffB);
            PG8_WAIT_V(6); PG8_BAR; PG8_MMA(1, 1, At, B1); PG8_BAR;
            }
        }
        if constexpr (ALIGN_EPI) { if (wr == 0) PG8_BAR; }
        if constexpr (!Epi::AFTER_DRAIN) { E(acc, cur, wr, wc, fr, fq);
            S.done(cur); }
        if (!has_next) break;
#pragma unroll
        for (int a = 0; a < 2; ++a)
#pragma unroll
            for (int b = 0; b < 2; ++b)
#pragma unroll
                for (int m = 0; m < 4; ++m)
#pragma unroll
                    for (int n = 0; n < 2; ++n) acc[a][b][m][n] = (f32x4){0.f, 0.f, 0.f, 0.f};
        cur = nxt; cA = nA; cB = nB; ++ui;
        if constexpr (ALIGN_EPI) { if (wr == 1) PG8_BAR; }
    }
    PG8_WAIT_V(0);
    if constexpr (!ALIGN_EPI) { if (wr == 0) PG8_BAR; }
    PG8_BAR;
    if constexpr (Epi::AFTER_DRAIN) { E.fused(acc, cur, wr, wc, fr, fq, lds, wid, lane); S.done(cur); }
#undef PG8_SA
#undef PG8_SB
#undef PG8_STAGE
#undef PG8_LDA
#undef PG8_LDB
#undef PG8_MMA
#undef PG8_WAIT_V
#undef PG8_WAIT_L
#undef PG8_BAR
#undef PG8_SCHED
}
}
namespace pg8 {
typedef unsigned u32x2 __attribute__((ext_vector_type(2)));
__device__ __forceinline__ void store16f_wt(void* p, f32x4 v) { asm volatile("global_store_dwordx4 %0, %1, off sc1\n\ts_nop 1" :: "v"(p), "v"(v) : "memory"); }
__device__ __forceinline__ void store16_wt(void* p, u32x4 v) { asm volatile("global_store_dwordx4 %0, %1, off sc1\n\ts_nop 1" :: "v"(p), "v"(v) : "memory"); }
constexpr int NTOK = 8192, NPROMPT = 4096, DMODEL = 1024, NPART = 32;
constexpr float C2Q = 0.125f * 1.4426950408889634f;
__device__ __forceinline__ u32x2 pack4(const f32x4 v) { u32x2 w; w.x = cvt_pk_bf16(v[0], v[1]); w.y = cvt_pk_bf16(v[2], v[3]); return w; }
__device__ __forceinline__ void store_pair16_wt(bf16_t* p, const u32x2 A, const u32x2 B, const int fq) {
    const auto r0 = __builtin_amdgcn_permlane16_swap(A.x, B.x, false, false), r1 = __builtin_amdgcn_permlane16_swap(A.y, B.y, false, false);
    u32x4 w; w.x = r0[0]; w.y = r1[0]; w.z = r0[1]; w.w = r1[1];
    store16_wt(p + ((fq & 1) ? 12 : 0), w);
}
__device__ __forceinline__ int mod_index(int pm) { return pm < 16 ? 0 : 1 + ((pm - 16) >> 3); }
__device__ __forceinline__ int kv_row(int m) { return m < NPROMPT ? m : m + 256 * (((m - NPROMPT) >> 11) + 1); }
__device__ __forceinline__ float row_rstd(const float* rowss, int row) {
    float s = 0.f;
#pragma unroll
    for (int p = 0; p < NPART; ++p) s += rowss[row * NPART + p];
    return __builtin_amdgcn_rsqf(s * (1.0f / DMODEL) + 1e-6f);
}

struct EpiResid {
    static constexpr bool PERM = true, AFTER_DRAIN = false, IDEMPOTENT = false;
    bf16_t* X16; bf16_t* XG; const float* gate; int gate_ld; const float* gain; float* rowss; PG8_LAS float* sst;
    __device__ __forceinline__ void operator()(const f32x4 (&acc)[2][2][4][2], const Unit& u, int wr, int wc, int fr_, int fq_) const {
        int fr, fq; { int ln_ = lane_id_opaque(); asm volatile("" : "+v"(ln_)); fr = ln_ & 15; fq = ln_ >> 4; } (void)fr_; (void)fq_;
        const int v = mod_index(u.pm), col0 = u.pn * HALF + wc * 32 + 8 * fq;
        f32x4 gt[2], gn[2];
#pragma unroll
        for (int n = 0; n < 2; ++n) { gt[n] = *(const f32x4*)(gate + v * gate_ld + col0 + 4 * n);
            gn[n] = gain ? *(const f32x4*)(gain + v * DMODEL + col0 + 4 * n) : (f32x4){0.f, 0.f, 0.f, 0.f}; }
        u32x4 xold[2][4];
#pragma unroll
        for (int ai = 0; ai < 2; ++ai)
#pragma unroll
            for (int m = 0; m < 4; ++m) xold[ai][m] = *(const u32x4*)(X16 + (size_t)(u.pm * BM + ai * HALF + wr * 64 + m * 16 + fr) * DMODEL + col0);
#pragma unroll
        for (int ai = 0; ai < 2; ++ai)
#pragma unroll
            for (int m = 0; m < 4; ++m) { const int row = u.pm * BM + ai * HALF + wr * 64 + m * 16 + fr; const size_t off = (size_t)row * DMODEL + col0; float ss = 0.f; const u32x4 xo = xold[ai][m];
                f32x4 xn[2];
#pragma unroll
                for (int n = 0; n < 2; ++n) { const f32x4 xf = (f32x4){__uint_as_float(xo[2 * n] << 16), __uint_as_float(xo[2 * n] & 0xffff0000u), __uint_as_float(xo[2 * n + 1] << 16), __uint_as_float(xo[2 * n + 1] & 0xffff0000u)};
                    xn[n] = xf + gt[n] * acc[ai][0][m][n]; ss += (xn[n][0] * xn[n][0] + xn[n][1] * xn[n][1]) + (xn[n][2] * xn[n][2] + xn[n][3] * xn[n][3]); }
                { u32x4 w; w.x = cvt_pk_bf16(xn[0][0], xn[0][1]); w.y = cvt_pk_bf16(xn[0][2], xn[0][3]); w.z = cvt_pk_bf16(xn[1][0], xn[1][1]); w.w = cvt_pk_bf16(xn[1][2], xn[1][3]); store16_wt(X16 + off, w); }
                if (gain) { const f32x4 g0 = xn[0] * gn[0], g1 = xn[1] * gn[1]; u32x4 w; w.x = cvt_pk_bf16(g0[0], g0[1]); w.y = cvt_pk_bf16(g0[2], g0[3]); w.z = cvt_pk_bf16(g1[0], g1[1]); w.w = cvt_pk_bf16(g1[2], g1[3]); store16_wt(XG + off, w); }
                ss += __shfl_xor(ss, 16); ss += __shfl_xor(ss, 32);
                if (fq == 0) sst[wc * 256 + ai * HALF + wr * 64 + m * 16 + fr] = ss; }
        asm volatile("s_waitcnt lgkmcnt(0)\n\ts_barrier" ::: "memory");
        { const int t = (wr * 4 + wc) * 64 + fq * 16 + fr; if (t < 256) { const f32x4 q = (f32x4){sst[t], sst[256 + t], sst[512 + t], sst[768 + t]}; *(f32x4*)(rowss + (size_t)(u.pm * BM + t) * NPART + u.pn * 4) = q; } }
    }
};

template <int CTRL> __device__ __forceinline__ f32x4 dpp4(const f32x4 oldv, const f32x4 src) {
    f32x4 r;
#pragma unroll
    for (int e = 0; e < 4; ++e) { const float o_ = oldv[e], s_ = src[e];
        r[e] = __int_as_float(__builtin_amdgcn_update_dpp(__float_as_int(o_), __float_as_int(s_), CTRL, 0xf, 0xf, false)); }
    return r;
}
template <int CTRL> __device__ __forceinline__ f32x4 dpp4r(const f32x4 src) {
    f32x4 r;
#pragma unroll
    for (int e = 0; e < 4; ++e) { const float s_ = src[e]; r[e] = __int_as_float(__builtin_amdgcn_mov_dpp(__float_as_int(s_), CTRL, 0xf, 0xf, false)); }
    return r;
}
struct EpiUpConv {
    static constexpr bool PERM = true, AFTER_DRAIN = false, IDEMPOTENT = false;
    bf16_t* H; const float* bias; const float* cw; const float* cb; const PG8_LAS float* rstd; PG8_LAS float* edge; float* uedge;
    __device__ __forceinline__ void operator()(f32x4 (&acc)[2][2][4][2], const Unit& u, int wr, int wc, int fr_, int fq_) const {
        int fr, fq; { int ln_ = lane_id_opaque(); asm volatile("" : "+v"(ln_)); fr = ln_ & 15; fq = ln_ >> 4; } (void)fr_; (void)fq_;

        const int v = mod_index(u.pm), cbase = wc * 32 + 8 * fq;
        { float rs[2][4];
#pragma unroll
          for (int ai = 0; ai < 2; ++ai)
#pragma unroll
              for (int m = 0; m < 4; ++m) rs[ai][m] = rstd[(u.idx & 7) * 256 + ai * HALF + wr * 64 + m * 16 + fr];
#pragma unroll
          for (int bj = 0; bj < 2; ++bj)
#pragma unroll
              for (int n = 0; n < 2; ++n) { const f32x4 b4 = *(const f32x4*)(bias + (size_t)v * 5632 + u.pn * BM + bj * HALF + cbase + 4 * n);
#pragma unroll
                  for (int ai = 0; ai < 2; ++ai)
#pragma unroll
                      for (int m = 0; m < 4; ++m) { acc[ai][bj][m][n] = acc[ai][bj][m][n] * rs[ai][m] + b4; asm volatile("" : "+v"(acc[ai][bj][m][n])); } } }
        { const unsigned ebase = (unsigned)(uintptr_t)edge + (unsigned)(cbase * 4);
#pragma unroll
          for (int ai = 0; ai < 2; ++ai) { const unsigned a0 = ebase + (unsigned)(((ai * 2 + wr) * 2) * 1024);
            if (fr == 0) {
#pragma unroll
                for (int bj = 0; bj < 2; ++bj)
#pragma unroll
                    for (int n = 0; n < 2; ++n) asm volatile("ds_write_b128 %0, %1 offset:%c2" :: "v"(a0), "v"(acc[ai][bj][0][n]), "i"(bj * 512 + n * 16) : "memory"); }
            if (fr == 15) {
#pragma unroll
                for (int bj = 0; bj < 2; ++bj)
#pragma unroll
                    for (int n = 0; n < 2; ++n) asm volatile("ds_write_b128 %0, %1 offset:%c2" :: "v"(a0), "v"(acc[ai][bj][3][n]), "i"(1024 + bj * 512 + n * 16) : "memory"); } } }
        if (u.pm >= 16) {
            if (wr == 0 && fr < 2) { float* o = uedge + ((size_t)u.pm * 4 + fr) * 5632 + u.pn * BM + cbase;
#pragma unroll
                for (int bj = 0; bj < 2; ++bj)
#pragma unroll
                    for (int n = 0; n < 2; ++n) store16f_wt(o + bj * HALF + 4 * n, acc[0][bj][0][n]); }
            if (wr == 1 && fr >= 14) { float* o = uedge + ((size_t)u.pm * 4 + 2 + (fr - 14)) * 5632 + u.pn * BM + cbase;
#pragma unroll
                for (int bj = 0; bj < 2; ++bj)
#pragma unroll
                    for (int n = 0; n < 2; ++n) store16f_wt(o + bj * HALF + 4 * n, acc[1][bj][3][n]); } }
        asm volatile("s_waitcnt lgkmcnt(0)\n\ts_barrier" ::: "memory"); __builtin_amdgcn_sched_barrier(0);
#pragma unroll
        for (int bj = 0; bj < 2; ++bj) {
#pragma unroll
          for (int n = 0; n < 2; ++n) {
            int fr2 = fr, cb2 = cbase; asm volatile("" : "+v"(fr2), "+v"(cb2));
            const float* wp = cw + bj * 2816 + u.pn * HALF + cb2 + 4 * n;
            const f32x4 w0 = *(const f32x4*)wp, w1 = *(const f32x4*)(wp + 5632), w2 = *(const f32x4*)(wp + 2 * 5632), cbv = *(const f32x4*)(cb + bj * 2816 + u.pn * HALF + cb2 + 4 * n);
#pragma unroll
            for (int ai = 0; ai < 2; ++ai) { const int blk = ai * 2 + wr;
                f32x4 carry = *(const PG8_LAS f32x4*)(edge + ((blk > 0 ? blk - 1 : 0) * 2 + 1) * 256 + bj * HALF + cb2 + 4 * n) * (blk > 0 ? 1.0f : 0.0f);
                const f32x4 en = *(const PG8_LAS f32x4*)(edge + ((blk < 3 ? blk + 1 : 3) * 2 + 0) * 256 + bj * HALF + cb2 + 4 * n) * (blk < 3 ? 1.0f : 0.0f);
#pragma unroll
                for (int m = 0; m < 4; ++m) { const f32x4 cur = acc[ai][bj][m][n];
                    const f32x4 nold = m < 3 ? dpp4r<0x12F>(acc[ai][bj][m < 3 ? m + 1 : 3][n]) : en;
                    const f32x4 prev = dpp4<0x111>(carry, cur);
                    const f32x4 next = dpp4<0x101>(nold, cur);
                    carry = dpp4r<0x121>(cur);
                    const f32x4 o = w0 * prev + w1 * cur + w2 * next + cbv;
                    if (bj == 0) {
#pragma unroll
                        for (int e = 0; e < 4; ++e) acc[ai][0][m][n][e] = o[e] * __builtin_amdgcn_rcpf(1.0f + __expf(-o[e]));
                    } else { const f32x4 h = acc[ai][0][m][n] * o; const unsigned p0 = cvt_pk_bf16(h[0], h[1]), p1 = cvt_pk_bf16(h[2], h[3]);
                        if (n == 0) { acc[ai][0][m][0][0] = __uint_as_float(p0); acc[ai][0][m][0][1] = __uint_as_float(p1); }
                        else { u32x4 w; w.x = __float_as_uint(acc[ai][0][m][0][0]); w.y = __float_as_uint(acc[ai][0][m][0][1]); w.z = p0; w.w = p1;

                            store16_wt(H + (size_t)(u.pm * BM + ai * HALF + wr * 64 + m * 16 + fr2) * 2816 + u.pn * HALF + cb2, w); } }
                    __builtin_amdgcn_sched_barrier(0); } }
            asm volatile("" ::: "memory"); __builtin_amdgcn_sched_barrier(0); } }
    }
};


struct EpiQkvDiff {
    static constexpr bool PERM = false, AFTER_DRAIN = false, IDEMPOTENT = true;
    bf16_t *Q, *K, *V; const float* bias; const PG8_LAS float* rstd; const float* rope;
    float *newk, *newv;
    __device__ __forceinline__ void operator()(const f32x4 (&acc)[2][2][4][2], const Unit& u, int wr, int wc, int fr_, int fq_) const {
        int fr, fq; { int ln_ = lane_id_opaque(); asm volatile("" : "+v"(ln_)); fr = ln_ & 15; fq = ln_ >> 4; } (void)fr_; (void)fq_;
        const int v = mod_index(u.pm), sec = u.pn >> 3, hd = u.pn & 7, cs = hd * HALF + wc * 32 + 4 * fq;
        const bool latent = u.pm >= 16; const int qb = (u.pm - 16) & 7;
        const float* biasp = bias + v * 3072 + sec * 1024 + cs; const f32x4 b0 = *(const f32x4*)biasp, b1 = *(const f32x4*)(biasp + 16);
        f32x4 ra[2][4], rb[2][4];
        const bool roped = latent && sec < 2;
        if (roped) {
#pragma unroll
            for (int ai = 0; ai < 2; ++ai)
#pragma unroll
                for (int m = 0; m < 4; ++m) { const int trow = ai * HALF + wr * 64 + m * 16 + fr; const int pos = (wc & 1) ? (trow & 63) : (4 * qb + (trow >> 6));
                    const float* rp = rope + (pos * 16 + 4 * fq) * 2; ra[ai][m] = *(const f32x4*)rp; rb[ai][m] = *(const f32x4*)(rp + 4); } }
#pragma unroll
        for (int ai = 0; ai < 2; ++ai)
#pragma unroll
            for (int m = 0; m < 4; ++m) { const int trow = ai * HALF + wr * 64 + m * 16 + fr, row = u.pm * BM + trow; const float rs = rstd[(u.idx & 7) * 256 + trow];
                f32x4 c4 = (f32x4){1.f, 1.f, 1.f, 1.f}, s4 = (f32x4){0.f, 0.f, 0.f, 0.f};
                if (roped) { const f32x4 a = ra[ai][m], b = rb[ai][m]; c4 = (f32x4){a[0], a[2], b[0], b[2]}; s4 = (f32x4){a[1], a[3], b[1], b[3]}; }
                const f32x4 x0 = acc[ai][0][m][0] * rs + b0, x1 = acc[ai][0][m][1] * rs + b1;
                if (sec == 0) { const f32x4 y0 = (x0 * c4 - x1 * s4) * C2Q, y1 = (x1 * c4 + x0 * s4) * C2Q; bf16_t* p = Q + (size_t)row * DMODEL + cs;
                    store_pair16_wt(p, pack4(y0), pack4(y1), fq); }
                else { const size_t kr = (size_t)kv_row(row) * DMODEL + cs;
                    if (!latent) { float* o = (sec == 1 ? newk : newv) + ((size_t)(u.pm * 16 + hd) * 256 + trow) * 128 + wc * 32 + 4 * fq; store16f_wt(o, x0); store16f_wt(o + 16, x1); }
                    if (sec == 1) { const f32x4 y0 = x0 * c4 - x1 * s4, y1 = x1 * c4 + x0 * s4; store_pair16_wt(K + kr, pack4(y0), pack4(y1), fq); }
                    else { store_pair16_wt(V + kr, pack4(x0), pack4(x1), fq); } } }
    }
};

struct EpiQkvGqa {
    static constexpr bool PERM = false, AFTER_DRAIN = false, IDEMPOTENT = true;
    bf16_t *Q, *K, *V; const float* bias; const PG8_LAS float* rstd; const float* rope; const float *qnw, *knw;
    float *newk, *newv;
    __device__ __forceinline__ void operator()(const f32x4 (&acc)[2][2][4][2], const Unit& u, int wr, int wc, int fr_, int fq_) const {
        int fr, fq; { int ln_ = lane_id_opaque(); asm volatile("" : "+v"(ln_)); fr = ln_ & 15; fq = ln_ >> 4; } (void)fr_; (void)fq_;
        const int v = mod_index(u.pm), sec = u.pn < 4 ? 0 : u.pn - 3;
        const bool latent = u.pm >= 16; const int qb = (u.pm - 16) & 7;
        const float* biasp = bias + v * 1536 + u.pn * BM + wc * 32 + 4 * fq; const float* nwp = (sec == 0 ? qnw : knw) + 4 * fq;
#pragma unroll
        for (int ai = 0; ai < 2; ++ai)
#pragma unroll
            for (int m = 0; m < 4; ++m) { const int trow = ai * HALF + wr * 64 + m * 16 + fr, row = u.pm * BM + trow; const float rs = rstd[(u.idx & 7) * 256 + trow];
                f32x4 x[2][2]; float ss = 0.f;
#pragma unroll
                for (int bj = 0; bj < 2; ++bj)
#pragma unroll
                    for (int n = 0; n < 2; ++n) { x[bj][n] = acc[ai][bj][m][n] * rs + *(const f32x4*)(biasp + bj * HALF + n * 16); const f32x4 t = x[bj][n]; ss += (t[0] * t[0] + t[1] * t[1]) + (t[2] * t[2] + t[3] * t[3]); }
                if (sec < 2) { ss += __shfl_xor(ss, 16); ss += __shfl_xor(ss, 32); const float hr = __builtin_amdgcn_rsqf(ss * (1.0f / 64.0f) + 1e-6f);
#pragma unroll
                    for (int bj = 0; bj < 2; ++bj)
#pragma unroll
                        for (int n = 0; n < 2; ++n) x[bj][n] = x[bj][n] * hr * *(const f32x4*)(nwp + 32 * bj + 16 * n); }
                if (sec == 0) {
#pragma unroll
                    for (int bj = 0; bj < 2; ++bj) { f32x4 y0 = x[bj][0], y1 = x[bj][1];
                        if (latent) { const int pos = bj ? (trow & 63) : (4 * qb + (trow >> 6)); const float* rp = rope + (pos * 16 + 4 * fq) * 2; const f32x4 a = *(const f32x4*)rp, b = *(const f32x4*)(rp + 4);
                            const f32x4 c4 = (f32x4){a[0], a[2], b[0], b[2]}, s4 = (f32x4){a[1], a[3], b[1], b[3]}; y0 = x[bj][0] * c4 - x[bj][1] * s4; y1 = x[bj][1] * c4 + x[bj][0] * s4; }
                        bf16_t* p = Q + (size_t)row * DMODEL + (u.pn * 4 + wc) * 64 + 32 * bj + 4 * fq; store_pair16_wt(p, pack4(y0 * C2Q), pack4(y1 * C2Q), fq); }
                } else {
                    const size_t kr = (size_t)kv_row(row) * 256 + wc * 64 + 4 * fq;
                    if (!latent) { float* o = (sec == 1 ? newk : newv) + ((size_t)(u.pm * 8 + wc) * 256 + trow) * 64 + 4 * fq;
#pragma unroll
                        for (int bj = 0; bj < 2; ++bj) { store16f_wt(o + 32 * bj, x[bj][0]); store16f_wt(o + 32 * bj + 16, x[bj][1]); } }
#pragma unroll
                    for (int bj = 0; bj < 2; ++bj) { f32x4 y0 = x[bj][0], y1 = x[bj][1];
                        if (latent && sec == 1) { const int pos = bj ? (trow & 63) : (4 * qb + (trow >> 6)); const float* rp = rope + (pos * 16 + 4 * fq) * 2; const f32x4 a = *(const f32x4*)rp, b = *(const f32x4*)(rp + 4);
                            const f32x4 c4 = (f32x4){a[0], a[2], b[0], b[2]}, s4 = (f32x4){a[1], a[3], b[1], b[3]}; y0 = x[bj][0] * c4 - x[bj][1] * s4; y1 = x[bj][1] * c4 + x[bj][0] * s4; }
                        bf16_t* p = (sec == 1 ? K : V) + kr + 32 * bj; store_pair16_wt(p, pack4(y0), pack4(y1), fq); } }
                asm volatile("" ::: "memory");
            }
    }
};

}
namespace attn_body {
using bf16=__hip_bfloat16;
using bf16x8=__attribute__((ext_vector_type(8)))short;
using s16x4=__attribute__((ext_vector_type(4)))short;
using f32x16=__attribute__((ext_vector_type(16)))float;
using u32x4=__attribute__((ext_vector_type(4)))unsigned;
using f32x4_t=__attribute__((ext_vector_type(4)))float;
constexpr int D=64;
constexpr int NW=8,QBLK=32,QB=QBLK*NW,KVBLK=64;
constexpr int ATTN_UNIT_ROWS=QB;
__device__ __forceinline__ int crow(int r,int hi){return (r&3)+8*(r>>2)+4*hi;}
#define SBAR() __builtin_amdgcn_sched_barrier(0)

constexpr int NSLOT=3, SLOTB=8192;
constexpr int LDS_K=0, LDS_V=NSLOT*SLOTB;
__host__ __device__ constexpr int lds_ws(int DV){return LDS_V+NSLOT*SLOTB*(DV/64);} __host__ __device__ constexpr int lds_ost(int DV){return lds_ws(DV)+NW*64*4;} __host__ __device__ constexpr int lds_bytes(int DV){return lds_ost(DV)+NW*4096;}
constexpr float C2=0.125f*1.4426950408889634f;
__device__ __forceinline__ void glds16(const void*gsrc,unsigned lds_dst){unsigned keep;
  asm volatile("s_mov_b32 %0, m0\n\ts_mov_b32 m0, %2\n\ts_nop 0\n\tglobal_load_lds_dwordx4 %1, off\n\ts_mov_b32 m0, %0":"=&s"(keep):"v"(gsrc),"s"(lds_dst):"memory");}
__device__ __forceinline__ float max3f(float a,float b,float c){float r;asm("v_max3_f32 %0, %1, %2, %3":"=v"(r):"v"(a),"v"(b),"v"(c));return r;}
__device__ __forceinline__ float max2f(float a,float b){float r;asm("v_max_f32_e32 %0, %1, %2":"=v"(r):"v"(a),"v"(b));return r;}
__device__ __forceinline__ float fadd_s(float a,float b){float r;asm("v_add_f32_e32 %0, %1, %2":"=v"(r):"v"(a),"v"(b));return r;}
__device__ __forceinline__ float fsub_s(float a,float b){float r;asm("v_sub_f32_e32 %0, %1, %2":"=v"(r):"v"(a),"v"(b));return r;}
typedef float f32x2_t __attribute__((ext_vector_type(2))); typedef __bf16 bf16x2_t __attribute__((ext_vector_type(2)));
__device__ __forceinline__ unsigned cvtpk_s(float lo,float hi){f32x2_t v={lo,hi};bf16x2_t b=__builtin_convertvector(v,bf16x2_t);return __builtin_bit_cast(unsigned,b);}
#define WAIT_BAR(N) asm volatile("s_waitcnt vmcnt(" #N ") lgkmcnt(0)\n\ts_barrier":::"memory")

__device__ __forceinline__ void qkt(f32x16&p0,f32x16&p1,const char*Kslot,const bf16x8*qr,const f32x16&negm,int r32,int hi){
  const char*kb=Kslot+hi*1024+r32*16;
  #pragma unroll
  for(int d0=0;d0<4;++d0){
    const bf16x8 b0=*reinterpret_cast<const bf16x8*>(kb+d0*2048);
    const bf16x8 b1=*reinterpret_cast<const bf16x8*>(kb+d0*2048+512);
    if(d0==0){p0=__builtin_amdgcn_mfma_f32_32x32x16_bf16(b0,qr[0],negm,0,0,0);p1=__builtin_amdgcn_mfma_f32_32x32x16_bf16(b1,qr[0],negm,0,0,0);}
    else{p0=__builtin_amdgcn_mfma_f32_32x32x16_bf16(b0,qr[d0],p0,0,0,0);p1=__builtin_amdgcn_mfma_f32_32x32x16_bf16(b1,qr[d0],p1,0,0,0);}}
}
typedef __attribute__((address_space(3))) const char* lds_cptr;
typedef short v4i16_t __attribute__((ext_vector_type(4)));
__device__ __forceinline__ void kload8(bf16x8*kf,lds_cptr kp){
  kf[0]=*(const __attribute__((address_space(3))) bf16x8*)(kp);      kf[1]=*(const __attribute__((address_space(3))) bf16x8*)(kp+512);
  kf[2]=*(const __attribute__((address_space(3))) bf16x8*)(kp+2048); kf[3]=*(const __attribute__((address_space(3))) bf16x8*)(kp+2560);
  kf[4]=*(const __attribute__((address_space(3))) bf16x8*)(kp+4096); kf[5]=*(const __attribute__((address_space(3))) bf16x8*)(kp+4608);
  kf[6]=*(const __attribute__((address_space(3))) bf16x8*)(kp+6144); kf[7]=*(const __attribute__((address_space(3))) bf16x8*)(kp+6656);
}
__device__ __forceinline__ void kload2(bf16x8*kf,lds_cptr kp,int j){ kf[2*j]=*(const __attribute__((address_space(3))) bf16x8*)(kp+j*2048); kf[2*j+1]=*(const __attribute__((address_space(3))) bf16x8*)(kp+j*2048+512); }
__device__ __forceinline__ s16x4 vtr(lds_cptr p){ return __builtin_bit_cast(s16x4,__builtin_amdgcn_ds_read_tr16_b64_v4i16((__attribute__((address_space(3))) v4i16_t*)p)); }
__device__ __forceinline__ float rowmax(const f32x16&p0,const f32x16&p1){
  float a=max3f(p0[0],p0[1],p1[0]),b=max3f(p0[2],p0[3],p1[1]);a=max3f(a,p1[2],p1[3]);
  #pragma unroll
  for(int r=4;r<16;r+=4){a=max3f(a,p0[r],p0[r+1]);b=max3f(b,p0[r+2],p0[r+3]);a=max3f(a,p1[r],p1[r+1]);b=max3f(b,p1[r+2],p1[r+3]);}
  const float m=max2f(a,b);
  auto rr=__builtin_amdgcn_permlane32_swap(__float_as_uint(m),__float_as_uint(m),false,false);
  return max2f(__uint_as_float(rr[0]),__uint_as_float(rr[1]));
}
__device__ __forceinline__ void pv(f32x16*o,int vb,bf16x8 pa0,bf16x8 pa1,bf16x8 pa2,bf16x8 pa3){
  #pragma unroll
  for(int d0=0;d0<2;++d0){s16x4 lo[4],hi[4];
    #pragma unroll
    for(int ks=0;ks<4;++ks){
      asm volatile("ds_read_b64_tr_b16 %0,%1 offset:%c2":"=&v"(lo[ks]):"v"(vb),"i"(d0*4096+ks*1024):"memory");
      asm volatile("ds_read_b64_tr_b16 %0,%1 offset:%c2":"=&v"(hi[ks]):"v"(vb),"i"(d0*4096+ks*1024+512):"memory");}
    asm volatile("s_waitcnt lgkmcnt(0)":::"memory");SBAR();
    #define PK(k) (bf16x8){lo[k][0],lo[k][1],lo[k][2],lo[k][3],hi[k][0],hi[k][1],hi[k][2],hi[k][3]}
    o[d0]=__builtin_amdgcn_mfma_f32_32x32x16_bf16(pa0,PK(0),o[d0],0,0,0);
    o[d0]=__builtin_amdgcn_mfma_f32_32x32x16_bf16(pa1,PK(1),o[d0],0,0,0);
    o[d0]=__builtin_amdgcn_mfma_f32_32x32x16_bf16(pa2,PK(2),o[d0],0,0,0);
    o[d0]=__builtin_amdgcn_mfma_f32_32x32x16_bf16(pa3,PK(3),o[d0],0,0,0);
    #undef PK
  }
}

#ifndef ATTN_STORE16
#define ATTN_STORE16(p,v) asm volatile("global_store_dwordx4 %0, %1, off sc1\n\ts_nop 1" :: "v"(p), "v"(v) : "memory")
#endif
struct AttnJob {
  const bf16* Q; int QP;
  const bf16* K; int KP;
  const bf16* V; int VP;
  bf16* O; int OP;
  int NT;
  int comb; unsigned* flag; unsigned target; float lam, oml; const float* sw;
};
template<int THRL,int DV> __device__ __forceinline__ void attn_unit(const AttnJob& J,char*shm,const int wave_id){
  constexpr int NV=DV/64, ND=DV/32, LDS_WS=lds_ws(DV), LDS_OST=lds_ost(DV);
  int tid_=wave_id*64+lane_id_opaque(); asm volatile("":"+v"(tid_));
  const int tid=tid_,lane=tid&63,r32=lane&31,hi=lane>>5; const int wid=__builtin_amdgcn_readfirstlane(tid>>6);
  const int QP=J.QP,KP=J.KP,VP=J.VP,OP=J.OP;
  const bf16*Qw=J.Q+(long)(wid*QBLK)*QP;
  const bf16*Kh=J.K,*Vh=J.V;
  const unsigned lds0=(unsigned)(uintptr_t)shm;
  float*wsf=(float*)(shm+LDS_WS)+wid*64;
  const bf16*ksrc=Kh+(long)lane*KP+wid*8;
  const bf16*vsrc=Vh+(long)(16*(wid&3)+(lane>>2))*VP+(wid>>2)*32+(lane&3)*8;
  const unsigned kdst=lds0+LDS_K+wid*1024, vdst=lds0+LDS_V+wid*1024;
  #define DMA_K(t,slot) glds16(ksrc+(long)(t)*KVBLK*KP,(unsigned)__builtin_amdgcn_readfirstlane(kdst+(slot)))
  #define DMA_V(t,slot) do{ _Pragma("unroll") for(int k_=0;k_<NV;++k_) glds16(vsrc+(long)(t)*KVBLK*VP+k_*64,(unsigned)__builtin_amdgcn_readfirstlane(vdst+NV*(slot)+k_*8192)); }while(0)
  const int vb0=(int)(lds0+LDS_V)+((lane>>4)&1)*32+(lane&3)*8+(4*hi+((lane&15)>>2))*64;
  const char*Kbase=shm+LDS_K; bf16x8 kf[8];
  const lds_cptr shm3=(lds_cptr)shm; const lds_cptr kp0=shm3+LDS_K+hi*1024+r32*16; const lds_cptr vp0=shm3+LDS_V+((lane>>4)&1)*32+(lane&3)*8+(4*hi+((lane&15)>>2))*64;
  const int NT=J.NT;
  DMA_K(0,0);DMA_V(0,0);DMA_K(1,SLOTB);
  bf16x8 qr[4];
  #pragma unroll
  for(int d0=0;d0<4;++d0)qr[d0]=*reinterpret_cast<const bf16x8*>(&Qw[(long)r32*QP+d0*16+hi*8]);
  float mhat=0.f,l_reg=0.f;f32x16 o[ND]; _Pragma("unroll") for(int d_=0;d_<ND;++d_)o[d_]=f32x16{};f32x16 negm=f32x16{};asm volatile("":"+v"(negm)); const f32x16 zero16=f32x16{};
  const u32x4 kone_u=(u32x4){hi==0?0x3f803f80u:0u,0u,0u,0u}; const bf16x8 kone=__builtin_bit_cast(bf16x8,kone_u); bf16x8 qm=__builtin_bit_cast(bf16x8,(u32x4){0u,0u,0u,0u});
  #define SETQM() do{ if constexpr(DV==128){ const float nm_=-mhat; const float hf_=__uint_as_float(cvtpk_s(nm_,0.f)<<16); const unsigned w_=cvtpk_s(hf_,nm_-hf_); \
      qm=__builtin_bit_cast(bf16x8,(u32x4){hi==0?w_:0u,0u,0u,0u}); } }while(0)
  #define CIN (DV==64?negm:zero16)
  #define CIN0(C) (DV==64?negm:C)
  #define CMASK(P0,P1,t) do{}while(0)
  bool resc=false;
  #define START(P0,P1) do{ const float rm=rowmax(P0,P1); resc=false; \
    { const float dl=rm; mhat=fadd_s(mhat,dl); \
      _Pragma("unroll") for(int r=0;r<16;++r){P0[r]=fsub_s(P0[r],dl);P1[r]=fsub_s(P1[r],dl);} \
      if constexpr(DV==64){ _Pragma("unroll") for(int r=0;r<16;++r)negm[r]=-mhat; asm volatile("":"+v"(negm)); } SETQM(); } \
    _Pragma("unroll") for(int r=0;r<16;++r)P0[r]=__builtin_amdgcn_exp2f(P0[r]); }while(0)
  #define RESC() do{ if(resc){ asm volatile("s_waitcnt lgkmcnt(0)":::"memory"); \
      _Pragma("unroll") for(int d_=0;d_<ND;++d_) _Pragma("unroll") for(int r=0;r<16;++r)o[d_][r]*=wsf[crow(r,hi)]; } }while(0)
  f32x16 pA0,pA1,pB0,pB1;
  int sl_prev=0,sl_cur=0,sl_next=SLOTB;
  #define ROT() do{sl_prev=sl_cur;sl_cur=sl_next;sl_next=(sl_next==(NSLOT-1)*SLOTB)?0:sl_next+SLOTB;}while(0)
  DMA_K(2,2*SLOTB);
  if constexpr(NV==2){WAIT_BAR(4);}else{WAIT_BAR(3);}
  qkt(pA0,pA1,Kbase,qr,CIN,r32,hi);asm volatile("s_nop 15\n\ts_nop 7":"+v"(pA0),"+v"(pA1));CMASK(pA0,pA1,0);
  START(pA0,pA1);
  _Pragma("unroll") for(int r=0;r<16;++r)pA1[r]=__builtin_amdgcn_exp2f(pA1[r]);
  WAIT_BAR(0);
  DMA_K(3,0);DMA_V(1,SLOTB);
  ROT();
  kload8(kf,kp0+sl_cur);
  if constexpr(NV==2){WAIT_BAR(3);}else{WAIT_BAR(2);}
  s16x4 vlo[8],vhi[8]; u32x4 pw0,pw1,pw2,pw3;
  #define PKW(P,B) cvtpk_s(P[B],P[B+1])
  #define PAF(k) __builtin_bit_cast(bf16x8,pw##k)
  #define VFR(i) (bf16x8){vlo[i][0],vlo[i][1],vlo[i][2],vlo[i][3],vhi[i][0],vhi[i][1],vhi[i][2],vhi[i][3]}
  #define PIN(x) asm volatile("":"+v"(x))
  #define MX3(a,b,c) __builtin_fmaxf(__builtin_fmaxf((a),(b)),(c))
  #define GAPA(MF,A0,A1,A2,A3,W0,W1,PW) do{ MF; sacc+=A0; sacc+=A1; sacc+=A2; sacc+=A3; PIN(sacc); W0; W1; PIN(PW); SBAR(); }while(0)
  #define EX(v) __builtin_amdgcn_exp2f(v)
  #define GAPB(MF,X,B) do{ MF; X[B]=EX(X[B]); X[B+1]=EX(X[B+1]); X[B+2]=EX(X[B+2]); X[B+3]=EX(X[B+3]); PIN(X); SBAR(); }while(0)
  #define VRD(i) do{ vlo[i]=vtr(vp_+(((i)>>2)*4096+((i)&3)*1024)); vhi[i]=vtr(vp_+(((i)>>2)*4096+((i)&3)*1024+512)); }while(0)
  #define VRD2(i) do{ vlo[i]=vtr(vp_+8192+(((i)>>2)*4096+((i)&3)*1024)); vhi[i]=vtr(vp_+8192+(((i)>>2)*4096+((i)&3)*1024+512)); }while(0)
  #define GAPC(MF) do{ MF; SBAR(); }while(0)
  #define KRD(G,j) do{ if(G){ kload2(kf,kp0+sl_next,j); SBAR(); } }while(0)
  #define STEP(C0,C1,P0,P1,t,GK,GV,GL) do{ SBAR(); \
    const lds_cptr vp_=vp0+NV*sl_prev; \
    VRD(0); SBAR(); float sacc=(P0[0]+P0[1]); \
    if constexpr(DV==128){ C0=__builtin_amdgcn_mfma_f32_32x32x16_bf16(kone,qm,zero16,0,0,0); C1=__builtin_amdgcn_mfma_f32_32x32x16_bf16(kone,qm,zero16,0,0,0); SBAR(); } \
    GAPA(C0=__builtin_amdgcn_mfma_f32_32x32x16_bf16(kf[0],qr[0],CIN0(C0),0,0,0), P0[2],P0[3],P0[4],P0[5],     pw0[0]=PKW(P0,0), pw0[1]=PKW(P0,2), pw0); \
    VRD(4); SBAR(); GAPA(C1=__builtin_amdgcn_mfma_f32_32x32x16_bf16(kf[1],qr[0],CIN0(C1),0,0,0), P0[6],P0[7],P0[8],P0[9],     pw0[2]=PKW(P0,4), pw0[3]=PKW(P0,6), pw0); \
    VRD(1); SBAR(); GAPA(C0=__builtin_amdgcn_mfma_f32_32x32x16_bf16(kf[2],qr[1],C0,0,0,0),   P0[10],P0[11],P0[12],P0[13], pw1[0]=PKW(P0,8), pw1[1]=PKW(P0,10), pw1); \
    VRD(5); SBAR(); GAPA(C1=__builtin_amdgcn_mfma_f32_32x32x16_bf16(kf[3],qr[1],C1,0,0,0),   P0[14],P0[15],P1[0],P1[1],   pw1[2]=PKW(P0,12),pw1[3]=PKW(P0,14), pw1); \
    VRD(2); SBAR(); GAPA(C0=__builtin_amdgcn_mfma_f32_32x32x16_bf16(kf[4],qr[2],C0,0,0,0),   P1[2],P1[3],P1[4],P1[5],     pw2[0]=PKW(P1,0), pw2[1]=PKW(P1,2), pw2); \
    VRD(6); SBAR(); GAPA(C1=__builtin_amdgcn_mfma_f32_32x32x16_bf16(kf[5],qr[2],C1,0,0,0),   P1[6],P1[7],P1[8],P1[9],     pw2[2]=PKW(P1,4), pw2[3]=PKW(P1,6), pw2); \
    VRD(3); SBAR(); GAPA(C0=__builtin_amdgcn_mfma_f32_32x32x16_bf16(kf[6],qr[3],C0,0,0,0),   P1[10],P1[11],P1[12],P1[13], pw3[0]=PKW(P1,8), pw3[1]=PKW(P1,10), pw3); \
    VRD(7); SBAR(); GAPA(C1=__builtin_amdgcn_mfma_f32_32x32x16_bf16(kf[7],qr[3],C1,0,0,0),   P1[14],P1[15],0.f,0.f,       pw3[2]=PKW(P1,12),pw3[3]=PKW(P1,14), pw3); \
    l_reg+=sacc; \
    if(GK){DMA_K((t)+3,sl_cur);} if(GV){DMA_V((t)+1,sl_next);} \
    CMASK(C0,C1,t); \
    { float a=MX3(C0[0],C0[1],C1[0]),b=MX3(C0[2],C0[3],C1[1]); a=MX3(a,C1[2],C1[3]); \
      _Pragma("unroll") for(int r=4;r<16;r+=4){a=MX3(a,C0[r],C0[r+1]);b=MX3(b,C0[r+2],C0[r+3]);a=MX3(a,C1[r],C1[r+1]);b=MX3(b,C1[r+2],C1[r+3]);} \
      float rm=__builtin_fmaxf(a,b); { auto rr=__builtin_amdgcn_permlane32_swap(__float_as_uint(rm),__float_as_uint(rm),false,false); rm=__builtin_fmaxf(__uint_as_float(rr[0]),__uint_as_float(rr[1])); } \
      resc=false; \
      if(__builtin_expect(__any(rm>(float)THRL),0)){ const float dl=__builtin_fmaxf(rm,0.f); mhat+=dl; \
        _Pragma("unroll") for(int r=0;r<16;++r){C0[r]-=dl;C1[r]-=dl;} \
        if constexpr(DV==64){ _Pragma("unroll") for(int r=0;r<16;++r)negm[r]=-mhat; asm volatile("":"+v"(negm)); } SETQM(); \
        const float f=__builtin_amdgcn_exp2f(-dl); l_reg*=f; if(hi==0)wsf[r32]=f; resc=true; } } \
    SBAR(); \
    GAPB(o[0]=__builtin_amdgcn_mfma_f32_32x32x16_bf16(PAF(0),VFR(0),o[0],0,0,0), C0,0); \
    GAPB(o[1]=__builtin_amdgcn_mfma_f32_32x32x16_bf16(PAF(0),VFR(4),o[1],0,0,0), C0,4); \
    KRD(GL,0); GAPB(o[0]=__builtin_amdgcn_mfma_f32_32x32x16_bf16(PAF(1),VFR(1),o[0],0,0,0), C0,8); \
    KRD(GL,1); GAPB(o[1]=__builtin_amdgcn_mfma_f32_32x32x16_bf16(PAF(1),VFR(5),o[1],0,0,0), C0,12); \
    KRD(GL,2); GAPB(o[0]=__builtin_amdgcn_mfma_f32_32x32x16_bf16(PAF(2),VFR(2),o[0],0,0,0), C1,0); \
    KRD(GL,3); GAPB(o[1]=__builtin_amdgcn_mfma_f32_32x32x16_bf16(PAF(2),VFR(6),o[1],0,0,0), C1,4); \
    GAPB(o[0]=__builtin_amdgcn_mfma_f32_32x32x16_bf16(PAF(3),VFR(3),o[0],0,0,0), C1,8); \
    GAPB(o[1]=__builtin_amdgcn_mfma_f32_32x32x16_bf16(PAF(3),VFR(7),o[1],0,0,0), C1,12); \
    if constexpr(DV==128){   \
      VRD2(0); VRD2(4); SBAR(); \
      VRD2(1); SBAR(); GAPC(o[2]=__builtin_amdgcn_mfma_f32_32x32x16_bf16(PAF(0),VFR(0),o[2],0,0,0)); \
      VRD2(5); SBAR(); GAPC(o[3]=__builtin_amdgcn_mfma_f32_32x32x16_bf16(PAF(0),VFR(4),o[3],0,0,0)); \
      VRD2(2); SBAR(); GAPC(o[2]=__builtin_amdgcn_mfma_f32_32x32x16_bf16(PAF(1),VFR(1),o[2],0,0,0)); \
      VRD2(6); SBAR(); GAPC(o[3]=__builtin_amdgcn_mfma_f32_32x32x16_bf16(PAF(1),VFR(5),o[3],0,0,0)); \
      VRD2(3); SBAR(); GAPC(o[2]=__builtin_amdgcn_mfma_f32_32x32x16_bf16(PAF(2),VFR(2),o[2],0,0,0)); \
      VRD2(7); SBAR(); GAPC(o[3]=__builtin_amdgcn_mfma_f32_32x32x16_bf16(PAF(2),VFR(6),o[3],0,0,0)); \
      GAPC(o[2]=__builtin_amdgcn_mfma_f32_32x32x16_bf16(PAF(3),VFR(3),o[2],0,0,0)); \
      GAPC(o[3]=__builtin_amdgcn_mfma_f32_32x32x16_bf16(PAF(3),VFR(7),o[3],0,0,0)); } \
    }while(0)
  #define WAIT_KV() do{ if constexpr(NV==2){WAIT_BAR(3);}else{WAIT_BAR(2);} }while(0)
  #define WAIT_V() do{ if constexpr(NV==2){WAIT_BAR(2);}else{WAIT_BAR(1);} }while(0)
  int t=1;
  for(;t+5<NT;t+=2){
    STEP(pB0,pB1,pA0,pA1,t,true,true,true);     WAIT_KV(); RESC(); ROT();
    STEP(pA0,pA1,pB0,pB1,t+1,true,true,true);   WAIT_KV(); RESC(); ROT();
  }
  #define ENDW(tt) do{ if((tt)+3<NT){WAIT_KV();} else if((tt)+2<NT){WAIT_V();} else {WAIT_BAR(0);} }while(0)
  for(;t+1<NT;t+=2){
    STEP(pB0,pB1,pA0,pA1,t,(t+3<NT),(t+1<NT),(t+1<NT));       ENDW(t);   RESC(); ROT();
    STEP(pA0,pA1,pB0,pB1,t+1,(t+4<NT),(t+2<NT),(t+2<NT));     ENDW(t+1); RESC(); ROT();
  }
  STEP(pB0,pB1,pA0,pA1,NT-1,false,false,false); RESC();
  { float sacc=pB0[0]+pB0[1]; _Pragma("unroll") for(int r=2;r<16;++r)sacc+=pB0[r]; _Pragma("unroll") for(int r=0;r<16;++r)sacc+=pB1[r]; l_reg+=sacc;
    pw0=(u32x4){PKW(pB0,0),PKW(pB0,2),PKW(pB0,4),PKW(pB0,6)};pw1=(u32x4){PKW(pB0,8),PKW(pB0,10),PKW(pB0,12),PKW(pB0,14)};pw2=(u32x4){PKW(pB1,0),PKW(pB1,2),PKW(pB1,4),PKW(pB1,6)};pw3=(u32x4){PKW(pB1,8),PKW(pB1,10),PKW(pB1,12),PKW(pB1,14)};
    SBAR(); pv(o,vb0+NV*sl_cur,PAF(0),PAF(1),PAF(2),PAF(3)); if constexpr(DV==128){ pv(o+2,vb0+NV*sl_cur+8192,PAF(0),PAF(1),PAF(2),PAF(3)); } }
  #undef PKW
  #undef PAF
  #undef VFR
  #undef PIN
  #undef MX3
  #undef GAPA
  #undef GAPB
  #undef EX
  #undef VRD
  #undef VRD2
  #undef CIN
  #undef CIN0
  #undef SETQM
  #undef GAPC
  #undef WAIT_KV
  #undef WAIT_V
  #undef KRD
  #undef STEP
  #undef ENDW
  {auto rr=__builtin_amdgcn_permlane32_swap(__float_as_uint(l_reg),__float_as_uint(l_reg),false,false);l_reg=__uint_as_float(rr[0])+__uint_as_float(rr[1]);}
  if(hi==0)wsf[32+r32]=l_reg;asm volatile("s_waitcnt lgkmcnt(0)":::"memory");
  float rli[16];
  #pragma unroll
  for(int r=0;r<16;++r)rli[r]=__builtin_amdgcn_rcpf(wsf[32+crow(r,hi)]);
  {
    bf16*Ow=J.O+(long)(wid*QBLK)*OP;
    bf16*stg=(bf16*)(shm+LDS_OST)+wid*2048;
    bool comb=false; if constexpr(DV==128) comb=J.comb!=0;
    if(!comb){
    #pragma unroll
    for(int hf=0;hf<NV;++hf){
      #pragma unroll
      for(int r=0;r<16;++r){const int orow=crow(r,hi);
        #pragma unroll
        for(int d0=0;d0<2;++d0)stg[orow*64+d0*32+r32]=__float2bfloat16(o[2*hf+d0][r]*rli[r]);}
      asm volatile("s_waitcnt lgkmcnt(0)":::"memory");
      #pragma unroll
      for(int i=0;i<4;++i){const int row=i*8+(lane>>3),ch=lane&7; const u32x4 v=*(const u32x4*)(stg+row*64+ch*8); ATTN_STORE16(Ow+(long)row*OP+hf*64+ch*8,v);}
      asm volatile("s_waitcnt lgkmcnt(0)":::"memory");
    }
    if constexpr(DV==128){ if(J.flag){
      asm volatile("s_waitcnt vmcnt(0) lgkmcnt(0)\n\ts_barrier":::"memory");
      if(wid==0&&lane==0) (void)__hip_atomic_fetch_add(J.flag,1u,__ATOMIC_RELAXED,__HIP_MEMORY_SCOPE_AGENT); } }
    } else { if constexpr(DV==128){
      u32x4 q2[2][4],q1[2][4];
      #pragma unroll
      for(int hf=0;hf<2;++hf){
        #pragma unroll
        for(int r=0;r<16;++r){const int orow=crow(r,hi);
          #pragma unroll
          for(int d0=0;d0<2;++d0)stg[orow*64+d0*32+r32]=__float2bfloat16(o[2*hf+d0][r]*rli[r]);}
        asm volatile("s_waitcnt lgkmcnt(0)":::"memory");
        #pragma unroll
        for(int i=0;i<4;++i){const int row=i*8+(lane>>3),ch=lane&7; q2[hf][i]=*(const u32x4*)(stg+row*64+ch*8);}
        asm volatile("s_waitcnt lgkmcnt(0)":::"memory");
      }
      if(wid==0&&lane==0){ unsigned sp_=0; while(__hip_atomic_load(J.flag,__ATOMIC_RELAXED,__HIP_MEMORY_SCOPE_AGENT)<J.target){ __builtin_amdgcn_s_sleep(1); if(++sp_>(1u<<20))break; } }
      asm volatile("s_waitcnt vmcnt(0) lgkmcnt(0)\n\ts_barrier":::"memory");
      #pragma unroll
      for(int hf=0;hf<2;++hf)
        #pragma unroll
        for(int i=0;i<4;++i){const int row=i*8+(lane>>3),ch=lane&7; const bf16*src=Ow+(long)row*OP+hf*64+ch*8;
          asm volatile("global_load_dwordx4 %0, %1, off sc1":"=v"(q1[hf][i]):"v"(src):"memory");}
      asm volatile("s_waitcnt vmcnt(0)":"+v"(q1[0][0]),"+v"(q1[0][1]),"+v"(q1[0][2]),"+v"(q1[0][3]),"+v"(q1[1][0]),"+v"(q1[1][1]),"+v"(q1[1][2]),"+v"(q1[1][3])::"memory");
      int lam_i=__builtin_amdgcn_readfirstlane(__float_as_int(J.lam)),oml_i=__builtin_amdgcn_readfirstlane(__float_as_int(J.oml)); asm volatile("":"+s"(lam_i),"+s"(oml_i)); const float lam=__int_as_float(lam_i),oml=__int_as_float(oml_i); const int ch=lane&7;
      f32x4_t w4[4];
      #pragma unroll
      for(int hf=0;hf<2;++hf){ w4[2*hf]=*(const f32x4_t*)(J.sw+hf*64+ch*8)*oml; w4[2*hf+1]=*(const f32x4_t*)(J.sw+hf*64+ch*8+4)*oml; }
      #pragma unroll
      for(int i=0;i<4;++i){ float d[16]; float ss=0.f;
        #pragma unroll
        for(int hf=0;hf<2;++hf)
          #pragma unroll
          for(int q=0;q<4;++q){ const unsigned a=q1[hf][i][q],b=q2[hf][i][q];
            d[8*hf+2*q]=__uint_as_float(a<<16)-lam*__uint_as_float(b<<16); d[8*hf+2*q+1]=__uint_as_float(a&0xffff0000u)-lam*__uint_as_float(b&0xffff0000u); }
        #pragma unroll
        for(int e=0;e<16;++e)ss+=d[e]*d[e];
        ss+=__shfl_xor(ss,1); ss+=__shfl_xor(ss,2); ss+=__shfl_xor(ss,4);
        const float rs=__builtin_amdgcn_rsqf(ss*(1.0f/128.0f)+1e-6f);
        #pragma unroll
        for(int hf=0;hf<2;++hf){ u32x4 v;
          #pragma unroll
          for(int q=0;q<4;++q) v[q]=cvtpk_s(d[8*hf+2*q]*rs*w4[2*hf+(q>>1)][(2*q)&3], d[8*hf+2*q+1]*rs*w4[2*hf+(q>>1)][(2*q+1)&3]);
          const int row=i*8+(lane>>3); ATTN_STORE16(Ow+(long)row*OP+hf*64+ch*8,v); } }
    } }
  }
  asm volatile("s_waitcnt lgkmcnt(0)\n\ts_barrier":::"memory");
  #undef DMA_K
  #undef DMA_V
  #undef CMASK
  #undef START
  #undef RESC
  #undef ROT
}
constexpr int ATTN_LDS_BYTES=lds_bytes(128);
#undef SBAR
#undef WAIT_BAR
}
constexpr int NWAVES = 8;
constexpr int NTOK = 8192, NPROMPT = 4096, DM = 1024, DFF = 2816, NUP = 5632, DEPTH = 4, NPART = 32;
constexpr int KVROWS = 4096 + 2 * 2304;
constexpr float NORM_EPS = 1e-6f;
enum { I_XP = 0, I_XS, I_CKD, I_CVD, I_CKG, I_CVG, I_C, I_CCTX, I_MODW, I_MODB, I_NATT, I_NFFN, I_WQD, I_WOD, I_LAMD, I_SUBLN, I_WQG, I_WOG, I_QNG, I_KNG, I_WUP, I_CONVW, I_CONVB, I_WDN, I_FNORM, N_IN };
constexpr size_t OUT_Y = 0, OUT_NKD = 8388608, OUT_NVD = 16777216, OUT_NKG = 25165824, OUT_NVG = 27262976, OUT_TOTAL = 29360128;
constexpr size_t MiB = 1u << 20;
constexpr size_t WS_CTL = 0, CTL_ZERO_BYTES = 65536;
constexpr size_t WS_TAB = 1 * MiB;
constexpr size_t T_MOD = 0;
constexpr size_t T_GA = T_MOD + 4 * 3 * 6144;
constexpr size_t T_GF = T_GA + 4 * 3 * 1024;
constexpr size_t T_BQD = T_GF + 4 * 3 * 1024;
constexpr size_t T_BQG = T_BQD + 2 * 3 * 3072;
constexpr size_t T_BUP = T_BQG + 2 * 3 * 1536;
constexpr size_t T_ROPE = T_BUP + 4 * 3 * 5632;
constexpr size_t T_LAM = T_ROPE + 64 * 16 * 2;
constexpr size_t T_ROWSS = T_LAM + 64;
constexpr size_t T_SSD = T_ROWSS + (size_t)NPART * NTOK;
constexpr size_t T_END = T_SSD + (size_t)NTOK * 16;
static_assert(T_END * 4 <= 8 * MiB, "tables fit their region");
constexpr size_t WS_W = 16 * MiB;
constexpr size_t W_QD = WS_W, W_OD = W_QD + 2 * 6 * MiB, W_QG = W_OD + 2 * 2 * MiB, W_OG = W_QG + 2 * 3 * MiB, W_UP = W_OG + 2 * 2 * MiB, W_DN = W_UP + 4 * 11 * MiB, W_END = W_DN + 4 * 11 * MiB / 2;
static_assert(W_END == 108 * MiB, "weight map");
constexpr size_t WS_X = 112 * MiB, WS_XG = 144 * MiB, WS_Q = 160 * MiB, WS_O = 176 * MiB, WS_K = 192 * MiB, WS_V = 210 * MiB, WS_U = 228 * MiB, WS_H = 316 * MiB, WS_STASH = 360 * MiB, WS_END = 376 * MiB;
constexpr size_t WS_MODP = WS_U + 16 * MiB;
static_assert((size_t)KVROWS * DM * 2 <= 18 * MiB && (size_t)NTOK * NUP * 2 == 88 * MiB && (size_t)NTOK * DFF * 2 == 44 * MiB, "activation map");
constexpr int RING_OFF = 0, RING_BYTES = 131072, LDSCTL_OFF = RING_BYTES, MISC_OFF = LDSCTL_OFF + 320, RSTD_OFF = LDSCTL_OFF + 1024, EDGE_OFF = RSTD_OFF + 8192, LDS_BYTES = 155648;

#define GAS __attribute__((address_space(1)))
#define LAS __attribute__((address_space(3)))
typedef unsigned short bf16;
typedef unsigned v4u __attribute__((ext_vector_type(4)));
typedef float f32x4 __attribute__((ext_vector_type(4)));
typedef short bf16x8 __attribute__((ext_vector_type(8)));
typedef GAS unsigned gu32;
typedef GAS unsigned long long gu64;
#define RLX_AGENT __ATOMIC_RELAXED, __HIP_MEMORY_SCOPE_AGENT
#define LDS_WAIT() asm volatile("s_waitcnt lgkmcnt(0)" ::: "memory")
#define VM_WAIT() asm volatile("s_waitcnt vmcnt(0)" ::: "memory")
__device__ __forceinline__ unsigned long long rt() { return __builtin_amdgcn_s_memrealtime(); }
__device__ __forceinline__ unsigned f2bf(float f) { unsigned u = __builtin_bit_cast(unsigned, f); return (u + 0x7fffu + ((u >> 16) & 1u)) >> 16; }
__device__ __forceinline__ unsigned pk2(float lo, float hi) { return f2bf(lo) | (f2bf(hi) << 16); }

#define XB_TMO      128
#define XB_XCNT(j)  (256  + 64 * (j))
#define XB_XSUB(j)  (1280 + 64 * (j))
#define XB_XGEN(j)  (2304 + 64 * (j))
#define XB_TOP      3328
#define XB_TOPGEN   3392
#define XCD_BAR_WORDS 3456
#define XL_SUB(j)   (3456 + 64 * (j))
#define XL_GEN(j)   (4480 + 64 * (j))
#define XL_UPD(j)   (5504 + 64 * (j))
#define XB_SPIN_CAP (1u << 18)

__device__ __forceinline__ unsigned xb_ld(unsigned* p)              { return __hip_atomic_load(p, __ATOMIC_RELAXED, __HIP_MEMORY_SCOPE_AGENT); }
__device__ __forceinline__ unsigned xb_add(unsigned* p, unsigned v) { return __hip_atomic_fetch_add(p, v, __ATOMIC_RELAXED, __HIP_MEMORY_SCOPE_AGENT); }
__device__ __forceinline__ unsigned xb_xcc_id() { return (unsigned)__builtin_amdgcn_s_getreg((3 << 11) | 20) & 0xFu; }
#define XB_SPIN(cond, bar) do { unsigned _sp = 0; while (cond) { __builtin_amdgcn_s_sleep(1); \
    if ((++_sp & 255u) == 0u) { if (xb_ld(&(bar)[XB_TMO])) break; if (_sp > XB_SPIN_CAP) { atomicAdd(&(bar)[XB_TMO], 1u); break; } } } } while (0)

struct XcdBarrier {
    unsigned* bar; unsigned x;
    volatile LAS unsigned* st;
};

__device__ __forceinline__ XcdBarrier xcd_barrier_post(unsigned* bar, volatile LAS unsigned* st, const bool leader) {
    XcdBarrier b; b.bar = bar; b.x = xb_xcc_id(); b.st = st;
    if (leader) st[2] = xb_add(&bar[XB_XCNT(b.x)], 1u);
    return b;
}
__device__ __forceinline__ void xcd_barrier_complete(unsigned* bar, unsigned x, unsigned& nloc, unsigned& nx, unsigned& vx) {
    const unsigned G = gridDim.x * gridDim.y * gridDim.z;
    unsigned sum, cnt, mine, below, sp = 0u;
    for (;;) {
        sum = 0u; cnt = 0u; mine = 0u; below = 0u;
#pragma unroll
        for (unsigned j = 0; j < 16; ++j) { const unsigned c = xb_ld(&bar[XB_XCNT(j)]); sum += c; cnt += (c > 0u) ? 1u : 0u; mine = (j == x) ? c : mine; below += (c > 0u && j < x) ? 1u : 0u; }
        if (sum == G) break;
        __builtin_amdgcn_s_sleep(1);
        if ((++sp & 255u) == 0u) { if (xb_ld(&bar[XB_TMO])) break; if (sp > XB_SPIN_CAP) { atomicAdd(&bar[XB_TMO], 1u); break; } }
    }
    nloc = mine > 0u ? mine : 1u; nx = cnt > 0u ? cnt : 1u; vx = below;
}

__device__ __forceinline__ void xcd_barrier(const XcdBarrier& b, const bool leader) {
    asm volatile("s_waitcnt vmcnt(0)" ::: "memory");
    __syncthreads();
    if (leader) {
        unsigned* bar = b.bar;
        __builtin_amdgcn_s_waitcnt(0);
        unsigned nloc = b.st[0], nx = b.st[1];
        if (nloc == 0u) { unsigned vx; xcd_barrier_complete(bar, b.x, nloc, nx, vx); b.st[0] = nloc; b.st[1] = nx; b.st[3] = vx; }
        asm volatile("buffer_inv sc1" ::: "memory");
        const unsigned old = xb_add(&bar[XB_XSUB(b.x)], 1u);
        const unsigned gen = old / nloc;
        if (old + 1u == (gen + 1u) * nloc) {
            __builtin_amdgcn_fence(__ATOMIC_RELEASE, "agent");
            asm volatile("s_waitcnt vmcnt(0)" ::: "memory");
            const unsigned og = xb_add(&bar[XB_TOP], 1u);
            const unsigned tg = og / nx;
            if (og + 1u == (tg + 1u) * nx) xb_add(&bar[XB_TOPGEN], 1u);
            else XB_SPIN(xb_ld(&bar[XB_TOPGEN]) == tg, bar);
            xb_add(&bar[XB_XGEN(b.x)], 1u);
        } else {
            XB_SPIN(xb_ld(&bar[XB_XGEN(b.x)]) == gen, bar);
            asm volatile("s_waitcnt vmcnt(0)" ::: "memory");
        }
    }
    __syncthreads();
}

__device__ __forceinline__ void xcd_local_barrier(const XcdBarrier& b, const bool leader, const int flag_word, const int wait0 = -1, const int wait1 = -1, const unsigned target = 0u) {
    asm volatile("s_waitcnt vmcnt(0)" ::: "memory");
    __syncthreads();
    if (leader) {
        unsigned* bar = b.bar;
        __builtin_amdgcn_s_waitcnt(0);
        const unsigned nloc = b.st[0];
        asm volatile("buffer_inv sc1" ::: "memory");
        const unsigned old = xb_add(&bar[XL_SUB(b.x)], 1u);
        const unsigned gen = old / nloc;
        if (old + 1u == (gen + 1u) * nloc) { if (flag_word >= 0) (void)xb_add(&bar[flag_word], 1u); xb_add(&bar[XL_GEN(b.x)], 1u); }
        else XB_SPIN(xb_ld(&bar[XL_GEN(b.x)]) == gen, bar);
        if (wait0 >= 0) { XB_SPIN(xb_ld(&bar[wait0]) < target, bar); XB_SPIN(xb_ld(&bar[wait1]) < target, bar); }
        asm volatile("s_waitcnt vmcnt(0)" ::: "memory");
    }
    __syncthreads();
}
__device__ __forceinline__ void xcd_flag_wait(const XcdBarrier& b, const bool leader, const int w0, const int w1, const unsigned target) {
    if (leader) {
        unsigned* bar = b.bar;
        XB_SPIN(xb_ld(&bar[w0]) < target, bar);
        XB_SPIN(xb_ld(&bar[w1]) < target, bar);
        __builtin_amdgcn_fence(__ATOMIC_ACQUIRE, "agent");
        asm volatile("s_waitcnt vmcnt(0)" ::: "memory");
    }
    __syncthreads();
}

typedef unsigned u32x2v __attribute__((ext_vector_type(2)));
__device__ __forceinline__ float wave_sum(float v) {
#pragma unroll
    for (int o = 1; o < 64; o <<= 1) v += __shfl_xor(v, o);
    return v;
}
__device__ __forceinline__ float bf_lo(unsigned w) { return __uint_as_float(w << 16); }
__device__ __forceinline__ float bf_hi(unsigned w) { return __uint_as_float(w & 0xffff0000u); }
__device__ __forceinline__ float silu_f(float x) { return x / (1.0f + __expf(-x)); }

struct P0Item { const float* W; bf16* WT; int K, N, k0, n0, prow0; };
__device__ __forceinline__ void p0_load(const P0Item& t, int lane, f32x4 (&v)[8]) {
    const int kr = lane >> 3, n4 = (lane & 7) * 4;
#pragma unroll
    for (int i = 0; i < 8; ++i) v[i] = *(const GAS f32x4*)(t.W + (size_t)(t.k0 + kr + 8 * i) * t.N + t.n0 + n4);
}
__device__ __forceinline__ void p0_finish(const P0Item& t, int lane, const f32x4 (&v)[8], LAS float* scr) {
    const int kr = lane >> 3, n4 = (lane & 7) * 4;
#pragma unroll
    for (int i = 0; i < 8; ++i)
#pragma unroll
        for (int e = 0; e < 4; ++e) scr[(n4 + e) * 65 + kr + 8 * i] = v[i][e];
    LDS_WAIT(); asm volatile("" ::: "memory");
    const int c = lane & 7;
#pragma unroll
    for (int j = 0; j < 4; ++j) { const int n = (lane >> 3) + 8 * j; const LAS float* s = scr + n * 65 + 8 * c;
        v4u o; o.x = pk2(s[0], s[1]); o.y = pk2(s[2], s[3]); o.z = pk2(s[4], s[5]); o.w = pk2(s[6], s[7]);
        *(GAS v4u*)(t.WT + (size_t)(t.prow0 + n) * t.K + t.k0 + 8 * c) = o; }
    LDS_WAIT(); asm volatile("" ::: "memory");
}
__device__ __forceinline__ int phys_gqa(int n0) { const int w = n0 & 255; return (n0 & ~255) + 128 * ((w & 63) >> 5) + 32 * (w >> 6); }
__device__ __forceinline__ int phys_up(int n0) { return n0 < DFF ? 256 * (n0 >> 7) + (n0 & 127) : 256 * ((n0 - DFF) >> 7) + 128 + ((n0 - DFF) & 127); }

#ifndef PH_MASK
#define PH_MASK 0xfff
#endif
#define PH_EN(b) ((PH_MASK >> (b)) & 1)

#define FILL_RSTD(S) do { _Pragma("unroll") for (int h_ = 0; h_ < 2; ++h_) {     \
        const int iA_ = __builtin_amdgcn_readfirstlane((h_ * 1024 + tid) >> 8), iB_ = iA_ + 2; pg8::Unit uA_, uB_; const bool vA_ = (S).next(iA_, uA_), vB_ = (S).next(iB_, uB_); if (!vA_) break; \
        const int rA_ = uA_.pm * 256 + (tid & 255), rB_ = (vB_ ? uB_.pm : uA_.pm) * 256 + (tid & 255); float sA_ = 0.f, sB_ = 0.f; \
        { f32x4 qa_[NPART / 4], qb_[NPART / 4]; _Pragma("unroll") for (int p_ = 0; p_ < NPART / 4; ++p_) { qa_[p_] = *(const f32x4*)(rowss + (size_t)rA_ * NPART + 4 * p_); qb_[p_] = *(const f32x4*)(rowss + (size_t)rB_ * NPART + 4 * p_); } \
          _Pragma("unroll") for (int p_ = 0; p_ < NPART / 4; ++p_) { sA_ += (qa_[p_][0] + qa_[p_][1]) + (qa_[p_][2] + qa_[p_][3]); sB_ += (qb_[p_][0] + qb_[p_][1]) + (qb_[p_][2] + qb_[p_][3]); } } \
        ((LAS float*)(L + RSTD_OFF))[iA_ * 256 + (tid & 255)] = __builtin_amdgcn_rsqf(sA_ * (1.0f / DM) + NORM_EPS); \
        if (vB_) ((LAS float*)(L + RSTD_OFF))[iB_ * 256 + (tid & 255)] = __builtin_amdgcn_rsqf(sB_ * (1.0f / DM) + NORM_EPS); } __syncthreads(); } while (0)
struct Args { const float* in[N_IN]; float* out; unsigned char* ws; int ph_lo, ph_hi; };
static_assert(sizeof(Args) == (N_IN + 2) * 8 + 8, "Args has no padding");

constexpr int PH_LAYER0 = 3, PH_PER_LAYER = 7, PH_FINAL = PH_LAYER0 + DEPTH * PH_PER_LAYER, N_PHASES = PH_FINAL + 1;

__global__ void __launch_bounds__(NWAVES * 64, 2) skel_fwd(Args args) {
    extern __shared__ __attribute__((aligned(16))) unsigned char lds[];
    LAS unsigned char* const L = (LAS unsigned char*)lds;
    volatile LAS unsigned* const MISC = (volatile LAS unsigned*)(L + MISC_OFF);
    const int tid0 = threadIdx.x; const int wave0 = __builtin_amdgcn_readfirstlane(tid0 >> 6);
    const int G = gridDim.x; const int vcu = (G % 8 == 0) ? ((int)blockIdx.x % 8) * (G / 8) + (int)blockIdx.x / 8 : (int)blockIdx.x;
    const int NGW = G * NWAVES, NGT = G * NWAVES * 64;
    gu32* const ctl = (gu32*)(args.ws + WS_CTL);
    for (int u = tid0; u < (LDS_BYTES - LDSCTL_OFF) / 4; u += NWAVES * 64) ((LAS unsigned*)(L + LDSCTL_OFF))[u] = 0u;
    __syncthreads();
    const bool single = (args.ph_hi - args.ph_lo) > 1;
    XcdBarrier bar; bar.bar = (unsigned*)(ctl + 1024); bar.x = 0; bar.st = nullptr;
    if (single) bar = xcd_barrier_post((unsigned*)(ctl + 1024), MISC + 8, tid0 == 0);


#define PHASE_BEGIN(IDX, KIND) { int lo_ = args.ph_lo, hi_ = args.ph_hi; asm volatile("" : "+s"(lo_), "+s"(hi_));     \
    if (lo_ <= (IDX) && (IDX) < hi_) { \
        if ((IDX) > lo_) { int w0_ = wave0; asm volatile("" : "+s"(w0_)); const bool leader_ = w0_ == 0 && lane_id_opaque() == 0; \
            if ((KIND) == 0) xcd_barrier(bar, leader_); else if ((KIND) == 1) xcd_local_barrier(bar, leader_, -1); \
            else {   \
                const int nx_ = (int)MISC[9], vx_ = (int)MISC[11], pl_ = (16 * vx_ + nx_ - 1) / nx_, ph_ = (16 * (vx_ + 1) + nx_ - 1) / nx_; \
                const int below_ = (pl_ & 7) ? (pl_ - 1) : pl_, above_ = (ph_ & 7) ? ph_ : pl_;                             \
                xcd_local_barrier(bar, leader_, (int)XL_UPD(vx_), (int)XL_UPD((below_ * nx_) >> 4), (int)XL_UPD((above_ * nx_) >> 4), (unsigned)(KIND) - 1u); } } \
        int tid = wave0 * 64 + lane_id_opaque(); asm volatile("" : "+v"(tid)); \
        GAS unsigned char* wsg = (GAS unsigned char*)args.ws; asm volatile("" : "+s"(wsg)); unsigned char* const ws = (unsigned char*)wsg; \
        const int lane = tid & 63, wave = __builtin_amdgcn_readfirstlane(tid >> 6); \
        const int gw = vcu * NWAVES + wave, gt = vcu * (NWAVES * 64) + tid; (void)lane; (void)gw; (void)gt; \
        float* const TAB = (float*)(ws + WS_TAB); \
        bf16* const X16 = (bf16*)(ws + WS_X); bf16* const XG = (bf16*)(ws + WS_XG); bf16* const Qb = (bf16*)(ws + WS_Q); bf16* const Ob = (bf16*)(ws + WS_O); \
        bf16* const Kb = (bf16*)(ws + WS_K); bf16* const Vb = (bf16*)(ws + WS_V); bf16* const Ub = (bf16*)(ws + WS_U); bf16* const Hb = (bf16*)(ws + WS_H); \
        float* const rowss = TAB + T_ROWSS; float* const ssd = TAB + T_SSD; (void)X16; (void)XG; (void)Qb; (void)Ob; (void)Kb; (void)Vb; (void)Ub; (void)Hb; (void)rowss; (void)ssd;
#define PHASE_END } }
#define XCD_IDS int nloc = __builtin_amdgcn_readfirstlane((int)MISC[8]), nxc = __builtin_amdgcn_readfirstlane((int)MISC[9]), rk = __builtin_amdgcn_readfirstlane((int)MISC[10]), vx = __builtin_amdgcn_readfirstlane((int)MISC[11]); \
        if (nloc == 0) { nloc = G >> 3; nxc = 8; rk = (int)blockIdx.x >> 3; vx = (int)blockIdx.x & 7; }     \
        const int plo = (16 * vx + nxc - 1) / nxc, pn16 = (16 * (vx + 1) + nxc - 1) / nxc - plo; (void)rk; (void)nloc; (void)pn16
#define XCD_ROW(IDX_) ((((IDX_) >> 8) < pn16 ? plo + ((IDX_) >> 8) : 16 + plo + ((IDX_) >> 8) - pn16) * 256 + ((IDX_) & 255))
    PHASE_BEGIN(0, 0) if (PH_EN(0)) {
            LAS float* scr = (LAS float*)(L + RING_OFF + wave * 16384);
            constexpr int IQD = 16 * 96, IOD = 16 * 32, IQG = 16 * 48, IUP = 16 * 176, IDN = 44 * 32;
            constexpr int NITEMS = 2 * IQD + 2 * IOD + 2 * IQG + 2 * IOD + 4 * IUP + 4 * IDN;
#define P0_DECODE(IT, T) do { int r = (IT); \
                if (r < 2 * IQD) { const int j = r / IQD; r -= j * IQD; T = P0Item{args.in[I_WQD] + (size_t)j * DM * 3072, (bf16*)(ws + W_QD) + (size_t)j * 3072 * DM, DM, 3072, 64 * (r / 96), 32 * (r % 96), 32 * (r % 96)}; break; } r -= 2 * IQD; \
                if (r < 2 * IOD) { const int j = r / IOD; r -= j * IOD; T = P0Item{args.in[I_WOD] + (size_t)j * DM * DM, (bf16*)(ws + W_OD) + (size_t)j * DM * DM, DM, DM, 64 * (r / 32), 32 * (r % 32), 32 * (r % 32)}; break; } r -= 2 * IOD; \
                if (r < 2 * IQG) { const int j = r / IQG; r -= j * IQG; T = P0Item{args.in[I_WQG] + (size_t)j * DM * 1536, (bf16*)(ws + W_QG) + (size_t)j * 1536 * DM, DM, 1536, 64 * (r / 48), 32 * (r % 48), phys_gqa(32 * (r % 48))}; break; } r -= 2 * IQG; \
                if (r < 2 * IOD) { const int j = r / IOD; r -= j * IOD; T = P0Item{args.in[I_WOG] + (size_t)j * DM * DM, (bf16*)(ws + W_OG) + (size_t)j * DM * DM, DM, DM, 64 * (r / 32), 32 * (r % 32), 32 * (r % 32)}; break; } r -= 2 * IOD; \
                if (r < 4 * IUP) { const int l_ = r / IUP; r -= l_ * IUP; T = P0Item{args.in[I_WUP] + (size_t)l_ * DM * NUP, (bf16*)(ws + W_UP) + (size_t)l_ * NUP * DM, DM, NUP, 64 * (r / 176), 32 * (r % 176), phys_up(32 * (r % 176))}; break; } r -= 4 * IUP; \
                { const int l_ = r / IDN; r -= l_ * IDN; T = P0Item{args.in[I_WDN] + (size_t)l_ * DFF * DM, (bf16*)(ws + W_DN) + (size_t)l_ * DM * DFF, DFF, DM, 64 * (r / 32), 32 * (r % 32), 32 * (r % 32)}; } } while (0)
            { P0Item tA, tB; f32x4 vA[8], vB[8]; int it = gw < NITEMS ? gw : NITEMS - 1;
              P0_DECODE(it, tA); p0_load(tA, lane, vA);
              for (int i0 = gw; i0 < NITEMS; i0 += 2 * NGW) {
                  const int iB = i0 + NGW, iA = i0 + 2 * NGW;
                  { const int j = iB < NITEMS ? iB : NITEMS - 1; P0_DECODE(j, tB); p0_load(tB, lane, vB); }
                  p0_finish(tA, lane, vA, scr);
                  { const int j = iA < NITEMS ? iA : NITEMS - 1; P0_DECODE(j, tA); p0_load(tA, lane, vA); }
                  if (iB < NITEMS) p0_finish(tB, lane, vB, scr); } }
#undef P0_DECODE
            for (int it = gw; it < 4 * 24 * 32; it += NGW) {
                const int kc = it & 31, nb = (it >> 5) % 24, l = it / (32 * 24);
                const int k = kc * 32 + (lane & 31);
                const float sv0 = silu_f(args.in[I_CCTX][k]), sv1 = silu_f(args.in[I_C][k]), sv2 = silu_f(args.in[I_C][DM + k]);
                const float* wp = args.in[I_MODW] + ((size_t)l * DM + kc * 32) * 6144 + nb * 256 + lane * 4;
                f32x4 w[32];
#pragma unroll
                for (int kk = 0; kk < 32; ++kk) w[kk] = *(const GAS f32x4*)(wp + (size_t)kk * 6144);
                f32x4 a0 = {0.f, 0.f, 0.f, 0.f}, a1 = a0, a2 = a0;
#pragma unroll
                for (int kk = 0; kk < 32; ++kk) { a0 += w[kk] * __shfl(sv0, kk); a1 += w[kk] * __shfl(sv1, kk); a2 += w[kk] * __shfl(sv2, kk); }
                float* pp = (float*)(ws + WS_MODP) + ((size_t)(kc * 4 + l) * 3) * 6144 + nb * 256 + lane * 4;
                *(f32x4*)pp = a0; *(f32x4*)(pp + 6144) = a1; *(f32x4*)(pp + 2 * 6144) = a2;
            }
            for (int e = gt; e < 64 * 16; e += NGT) { const int pos = e >> 4, i = e & 15; const float inv = powf(10000.0f, -(float)i * (1.0f / 16.0f)); const float ang = (float)pos * inv;
                TAB[T_ROPE + 2 * e] = cosf(ang); TAB[T_ROPE + 2 * e + 1] = sinf(ang); }
            if (gw < 2) { const float* lp = args.in[I_LAMD] + gw * 256; const float a = wave_sum(lp[lane] * lp[64 + lane]), b = wave_sum(lp[128 + lane] * lp[192 + lane]);
                const float lam_init = 0.8f - 0.6f * expf(-0.3f * (float)(2 * gw)); if (lane == 0) TAB[T_LAM + gw] = expf(a) - expf(b) + lam_init; }
    } PHASE_END
    PHASE_BEGIN(1, 0) if (PH_EN(1)) {
            for (int e = gt; e < 4 * 3 * 6144; e += NGT) { const int n = e % 6144, lv = e / 6144, l = lv / 3;
                float s = args.in[I_MODB][l * 6144 + n];
#pragma unroll
                for (int kc = 0; kc < 32; ++kc) s += ((const float*)(ws + WS_MODP))[(size_t)kc * (4 * 3 * 6144) + e];
                TAB[T_MOD + e] = s;
                if (n >= 1024 && n < 2048) TAB[T_GA + lv * 1024 + (n - 1024)] = args.in[I_NATT][l * 1024 + (n - 1024)] * (1.0f + s);
                if (n >= 4096 && n < 5120) TAB[T_GF + lv * 1024 + (n - 4096)] = args.in[I_NFFN][l * 1024 + (n - 4096)] * (1.0f + s); }
    } PHASE_END
    PHASE_BEGIN(2, 0) if (PH_EN(2)) {
            for (int mat = 0; mat < 8; ++mat) {
                const int kind = mat < 2 ? 0 : (mat < 4 ? 1 : 2), idx = mat < 2 ? mat : (mat < 4 ? mat - 2 : mat - 4);
                const int nrows = kind == 0 ? 3072 : (kind == 1 ? 1536 : NUP), l = kind == 0 ? 2 * idx : (kind == 1 ? 2 * idx + 1 : idx);
                const bf16* WT = kind == 0 ? (const bf16*)(ws + W_QD) + (size_t)idx * 3072 * DM : (kind == 1 ? (const bf16*)(ws + W_QG) + (size_t)idx * 1536 * DM : (const bf16*)(ws + W_UP) + (size_t)idx * NUP * DM);
                float* outb = TAB + (kind == 0 ? T_BQD + (size_t)idx * 3 * 3072 : (kind == 1 ? T_BQG + (size_t)idx * 3 * 1536 : T_BUP + (size_t)idx * 3 * NUP));
                const float* sh = TAB + T_MOD + (size_t)l * 3 * 6144 + (kind == 2 ? 3072 : 0) + lane * 16;
                f32x4 s[3][4];
#pragma unroll
                for (int v = 0; v < 3; ++v)
#pragma unroll
                    for (int q = 0; q < 4; ++q) s[v][q] = *(const f32x4*)(sh + v * 6144 + 4 * q);
                for (int p0 = gw; p0 < nrows; p0 += 3 * NGW) {
                    v4u w0[3], w1[3]; float d[3][3];
#pragma unroll
                    for (int r = 0; r < 3; ++r) { const int p = (p0 + r * NGW < nrows) ? p0 + r * NGW : nrows - 1;
                        w0[r] = *(const GAS v4u*)(WT + (size_t)p * DM + lane * 16); w1[r] = *(const GAS v4u*)(WT + (size_t)p * DM + lane * 16 + 8); }
#pragma unroll
                    for (int r = 0; r < 3; ++r) { float wf[16];
#pragma unroll
                        for (int q = 0; q < 4; ++q) { wf[2 * q] = bf_lo(w0[r][q]); wf[2 * q + 1] = bf_hi(w0[r][q]); wf[8 + 2 * q] = bf_lo(w1[r][q]); wf[8 + 2 * q + 1] = bf_hi(w1[r][q]); }
#pragma unroll
                        for (int v = 0; v < 3; ++v) { float a = 0.f;
#pragma unroll
                            for (int q = 0; q < 4; ++q) a += (s[v][q][0] * wf[4 * q] + s[v][q][1] * wf[4 * q + 1]) + (s[v][q][2] * wf[4 * q + 2] + s[v][q][3] * wf[4 * q + 3]);
                            d[r][v] = a; } }
#pragma unroll
                    for (int o = 1; o < 64; o <<= 1)
#pragma unroll
                        for (int r = 0; r < 3; ++r)
#pragma unroll
                            for (int v = 0; v < 3; ++v) d[r][v] += __shfl_xor(d[r][v], o);
                    if (lane == 0) {
#pragma unroll
                        for (int r = 0; r < 3; ++r) { const int p = p0 + r * NGW; if (p < nrows) { outb[p] = d[r][0]; outb[nrows + p] = d[r][1]; outb[2 * nrows + p] = d[r][2]; } } }
                }
            }
            for (int mb = gw; mb < NTOK; mb += 4 * NGW) { f32x4 x[4][4], g[4][4]; int mr[4];
#pragma unroll
                for (int r = 0; r < 4; ++r) { const int m = (mb + r * NGW < NTOK) ? mb + r * NGW : mb; mr[r] = m;
                    const float* xr = (m < NPROMPT ? args.in[I_XP] + (size_t)m * DM : args.in[I_XS] + (size_t)(m - NPROMPT) * DM);
                    const float* ga = TAB + T_GA + (m < NPROMPT ? 0 : 1 + ((m - NPROMPT) >> 11)) * 1024;
#pragma unroll
                    for (int j = 0; j < 4; ++j) { x[r][j] = *(const GAS f32x4*)(xr + 256 * j + 4 * lane); g[r][j] = *(const f32x4*)(ga + 256 * j + 4 * lane); } }
#pragma unroll
                for (int r = 0; r < 4; ++r) { if (r > 0 && mb + r * NGW >= NTOK) break; const int m = mr[r]; float ss = 0.f;
#pragma unroll
                    for (int j = 0; j < 4; ++j) { const f32x4 xv = x[r][j], gv = g[r][j];
                        { u32x2v w0; w0.x = pk2(xv[0], xv[1]); w0.y = pk2(xv[2], xv[3]); *(GAS u32x2v*)(X16 + (size_t)m * DM + 256 * j + 4 * lane) = w0; } ss += (xv[0] * xv[0] + xv[1] * xv[1]) + (xv[2] * xv[2] + xv[3] * xv[3]);
                        u32x2v w; w.x = pk2(xv[0] * gv[0], xv[1] * gv[1]); w.y = pk2(xv[2] * gv[2], xv[3] * gv[3]); *(GAS u32x2v*)(XG + (size_t)m * DM + 256 * j + 4 * lane) = w; }
                    ss = wave_sum(ss);
                    if (lane < NPART) rowss[(size_t)m * NPART + lane] = lane == 0 ? ss : 0.f; } }
    } PHASE_END
    for (int l = 0; l < DEPTH; ++l) { const int j = l >> 1, pb = PH_LAYER0 + PH_PER_LAYER * l; const bool diff = (l & 1) == 0;
        PHASE_BEGIN(pb + 0, (l == 0 ? 0 : 1))
                XCD_IDS;
                if (diff) { if (PH_EN(3)) {
                    if (l == 0) for (int e = gt; e < 2 * 8 * 256 * 32; e += NGT) { const int d4 = e & 31, p = (e >> 5) & 255, h = (e >> 13) & 7, b = e >> 16;
                        const size_t src = ((((size_t)b * 2 + j) * 8 + h) * 256 + p) * 128 + d4 * 4, dst = ((size_t)(4096 + b * 2304 + p)) * DM + h * 128 + d4 * 4;
                        const f32x4 k = *(const GAS f32x4*)(args.in[I_CKD] + src), vv = *(const GAS f32x4*)(args.in[I_CVD] + src);
                        u32x2v w; w.x = pk2(k[0], k[1]); w.y = pk2(k[2], k[3]); *(GAS u32x2v*)(Kb + dst) = w; w.x = pk2(vv[0], vv[1]); w.y = pk2(vv[2], vv[3]); *(GAS u32x2v*)(Vb + dst) = w; }
                    pg8::Gemm g{XG, (const bf16*)(ws + W_QD) + (size_t)j * 3072 * DM, NTOK, 3072, DM};
                    pg8::XcdOrder S{plo, pn16, 24, rk, nloc, (pn16 == 2 && nloc == 32) ? 1 : 0};

                    FILL_RSTD(S);
                    pg8::EpiQkvDiff E{Qb, Kb, Vb, TAB + T_BQD + (size_t)j * 3 * 3072, (const LAS float*)(L + RSTD_OFF), TAB + T_ROPE, args.out + OUT_NKD + (size_t)j * 8 * 256 * 128, args.out + OUT_NVD + (size_t)j * 8 * 256 * 128};
                    pg8::gemm_phase<pg8::EpiQkvDiff, pg8::XcdOrder, true, true, true>(L + RING_OFF, g, S, E, wave0);
                } } else if (PH_EN(4)) {
                    if (l == 0) for (int e = gt; e < 2 * 4 * 256 * 16; e += NGT) { const int d4 = e & 15, p = (e >> 4) & 255, h = (e >> 12) & 3, b = e >> 14;
                        const size_t src = ((((size_t)b * 2 + j) * 4 + h) * 256 + p) * 64 + d4 * 4, dst = ((size_t)(4096 + b * 2304 + p)) * 256 + h * 64 + d4 * 4;
                        const f32x4 k = *(const GAS f32x4*)(args.in[I_CKG] + src), vv = *(const GAS f32x4*)(args.in[I_CVG] + src);
                        u32x2v w; w.x = pk2(k[0], k[1]); w.y = pk2(k[2], k[3]); *(GAS u32x2v*)(Kb + dst) = w; w.x = pk2(vv[0], vv[1]); w.y = pk2(vv[2], vv[3]); *(GAS u32x2v*)(Vb + dst) = w; }
                    pg8::Gemm g{XG, (const bf16*)(ws + W_QG) + (size_t)j * 1536 * DM, NTOK, 1536, DM}; pg8::XcdOrder S{plo, pn16, 6, rk, nloc, 0};
                    FILL_RSTD(S);
                    pg8::EpiQkvGqa E{Qb, Kb, Vb, TAB + T_BQG + (size_t)j * 3 * 1536, (const LAS float*)(L + RSTD_OFF), TAB + T_ROPE, args.in[I_QNG] + j * 64, args.in[I_KNG] + j * 64,
                                     args.out + OUT_NKG + (size_t)j * 4 * 256 * 64, args.out + OUT_NVG + (size_t)j * 4 * 256 * 64};
                    pg8::gemm_phase<pg8::EpiQkvGqa, pg8::XcdOrder, true, true>(L + RING_OFF, g, S, E, wave0);
                }
        PHASE_END
        PHASE_BEGIN(pb + 1, 0) if (PH_EN(5)) {
                static_assert(attn_body::ATTN_LDS_BYTES <= RING_BYTES, "attention LDS inside the ring region");
                const float oml = __int_as_float(__builtin_amdgcn_readfirstlane(__float_as_int(1.0f - (0.8f - 0.6f * expf(-0.3f * (float)l))))), lam = __int_as_float(__builtin_amdgcn_readfirstlane(__float_as_int(diff ? TAB[T_LAM + j] : 0.f)));
                for (int u = vcu; u < 512; u += G) {
                    attn_body::AttnJob J; const bool lat = u < 256; const int uu = u & 255; int m0, k0; J.comb = 0; J.flag = nullptr; J.target = 0u; J.lam = lam; J.oml = oml; J.sw = args.in[I_SUBLN] + j * 128;
                    if (diff) { int b, h, p; if (lat) { b = uu >> 7; h = (uu >> 4) & 7; const int qb = (uu >> 1) & 7; p = uu & 1; m0 = NPROMPT + b * 2048 + qb * 256; k0 = NPROMPT + b * 2304; }
                                else { b = uu >> 4; h = (uu >> 1) & 7; p = uu & 1; m0 = b * 256; k0 = m0; }
                        J.Q = (const attn_body::bf16*)Qb + (size_t)m0 * DM + h * 128 + p * 64; J.QP = DM; J.K = (const attn_body::bf16*)Kb + (size_t)k0 * DM + h * 128 + p * 64; J.KP = DM;
                        J.V = (const attn_body::bf16*)Vb + (size_t)k0 * DM + h * 128; J.VP = DM; J.O = (attn_body::bf16*)Ob + (size_t)m0 * DM + h * 128; J.OP = DM; J.NT = lat ? 36 : 4;
                        J.comb = p; J.flag = (unsigned*)(ws + WS_CTL) + 8192 + (u >> 1); J.target = (unsigned)(j + 1);
                        attn_body::attn_unit<8, 128>(J, (char*)lds + RING_OFF, wave0); }
                    else { int b, hq; if (lat) { b = uu >> 7; hq = (uu >> 3) & 15; const int qb = uu & 7; m0 = NPROMPT + b * 2048 + qb * 256; k0 = NPROMPT + b * 2304; } else { b = uu >> 4; hq = uu & 15; m0 = b * 256; k0 = m0; }
                        J.Q = (const attn_body::bf16*)Qb + (size_t)m0 * DM + hq * 64; J.QP = DM; J.K = (const attn_body::bf16*)Kb + (size_t)k0 * 256 + (hq >> 2) * 64; J.KP = 256;
                        J.V = (const attn_body::bf16*)Vb + (size_t)k0 * 256 + (hq >> 2) * 64; J.VP = 256; J.O = (attn_body::bf16*)Ob + (size_t)m0 * DM + hq * 64; J.OP = DM; J.NT = lat ? 36 : 4;
                        attn_body::attn_unit<8, 64>(J, (char*)lds + RING_OFF, wave0); }
                }
        } PHASE_END
        PHASE_BEGIN(pb + 3, 0) if (PH_EN(7)) { XCD_IDS;
                pg8::Gemm g{Ob, (const bf16*)(ws + (diff ? W_OD : W_OG)) + (size_t)j * DM * DM, NTOK, DM, DM}; pg8::XcdOrder S{plo, pn16, 8, rk, nloc, 0};
                pg8::EpiResid E{X16, XG, TAB + T_MOD + (size_t)l * 3 * 6144 + 2048, 6144, TAB + T_GF + (size_t)l * 3 * 1024, rowss, (LAS float*)(L + RSTD_OFF)};
                const int ln_ = l + 1, jn_ = ln_ >> 1; const bool dn_ = (ln_ & 1) == 0; const int nit_ = ln_ < DEPTH ? (dn_ ? 2 * 8 * 256 * 32 : 2 * 4 * 256 * 16) : 0;
#define KV_ITEM(E_, SRC_, DST_) do { if (dn_) { const int d4 = (E_) & 31, p = ((E_) >> 5) & 255, h = ((E_) >> 13) & 7, b = (E_) >> 16; \
                        SRC_ = ((((size_t)b * 2 + jn_) * 8 + h) * 256 + p) * 128 + d4 * 4; DST_ = ((size_t)(4096 + b * 2304 + p)) * DM + h * 128 + d4 * 4; } \
                    else { const int d4 = (E_) & 15, p = ((E_) >> 4) & 255, h = ((E_) >> 12) & 3, b = (E_) >> 14; \
                        SRC_ = ((((size_t)b * 2 + jn_) * 4 + h) * 256 + p) * 64 + d4 * 4; DST_ = ((size_t)(4096 + b * 2304 + p)) * 256 + h * 64 + d4 * 4; } } while (0)
                const float* cks_ = args.in[dn_ ? I_CKD : I_CKG]; const float* cvs_ = args.in[dn_ ? I_CVD : I_CVG];
                f32x4 ck_ = {0.f, 0.f, 0.f, 0.f}, cv_ = ck_; size_t cdst_ = 0; const bool cok_ = gt < nit_;
                if (cok_) { size_t src_; KV_ITEM(gt, src_, cdst_); ck_ = *(const GAS f32x4*)(cks_ + src_); cv_ = *(const GAS f32x4*)(cvs_ + src_); }
                pg8::gemm_phase<pg8::EpiResid, pg8::XcdOrder, true, true, true>(L + RING_OFF, g, S, E, wave0);
                if (cok_) { u32x2v w; w.x = pk2(ck_[0], ck_[1]); w.y = pk2(ck_[2], ck_[3]); *(GAS u32x2v*)(Kb + cdst_) = w; w.x = pk2(cv_[0], cv_[1]); w.y = pk2(cv_[2], cv_[3]); *(GAS u32x2v*)(Vb + cdst_) = w; }
                for (int e = gt + NGT; e < nit_; e += NGT) { size_t src_, dst_; KV_ITEM(e, src_, dst_); const f32x4 k = *(const GAS f32x4*)(cks_ + src_), vv = *(const GAS f32x4*)(cvs_ + src_);
                    u32x2v w; w.x = pk2(k[0], k[1]); w.y = pk2(k[2], k[3]); *(GAS u32x2v*)(Kb + dst_) = w; w.x = pk2(vv[0], vv[1]); w.y = pk2(vv[2], vv[3]); *(GAS u32x2v*)(Vb + dst_) = w; }
#undef KV_ITEM
        } PHASE_END
        PHASE_BEGIN(pb + 4, 1) if (PH_EN(8)) { XCD_IDS;
                pg8::Gemm g{XG, (const bf16*)(ws + W_UP) + (size_t)l * NUP * DM, NTOK, NUP, DM}; pg8::XcdOrder S{plo, pn16, 22, rk, nloc, 0};
                FILL_RSTD(S);
                pg8::EpiUpConv E{Hb, TAB + T_BUP + (size_t)l * 3 * NUP, args.in[I_CONVW] + (size_t)l * 3 * NUP, args.in[I_CONVB] + (size_t)l * NUP, (const LAS float*)(L + RSTD_OFF), (LAS float*)(L + EDGE_OFF), (float*)Ub};
                pg8::gemm_phase<pg8::EpiUpConv, pg8::XcdOrder, true, true>(L + RING_OFF, g, S, E, wave0);
        } PHASE_END
        PHASE_BEGIN(pb + 6, (2 + l)) if (PH_EN(10)) { XCD_IDS;
                pg8::Gemm g{Hb, (const bf16*)(ws + W_DN) + (size_t)l * DM * DFF, NTOK, DM, DFF}; pg8::XcdOrder S{plo, pn16, 8, rk, nloc, 0};
                { pg8::Unit uu; const float* ue = (const float*)Ub; const float* cw = args.in[I_CONVW] + (size_t)l * 3 * NUP; const float* cb = args.in[I_CONVB] + (size_t)l * NUP;
                  for (int i = 0; S.next(i, uu); ++i) { if (uu.pm < 16) continue; const int qb = (uu.pm - 16) & 7;
                    u32x2v hq[3]; bool doit[3]; size_t hoff[3];
#pragma unroll
                    for (int k = 0; k < 3; ++k) { int idx = tid + NWAVES * 64 * k; const bool ok_ = idx < 2 * (DFF / 4); idx = ok_ ? idx : 2 * (DFF / 4) - 1;
                        const int which = idx >= DFF / 4 ? 1 : 0, c4 = 4 * (idx - (DFF / 4) * which);
                        doit[k] = ok_ && !(which == 0 ? qb == 0 : qb == 7);
                        const int pc = 256 * (c4 >> 7) + (c4 & 127);
                        const float* r0 = ue + ((size_t)(which == 0 ? (uu.pm - 1) * 4 + 3 : uu.pm * 4 + 2)) * NUP + pc;
                        const float* r1 = ue + ((size_t)(which == 0 ? uu.pm * 4 + 0 : uu.pm * 4 + 3)) * NUP + pc;
                        const float* r2 = ue + ((size_t)(which == 0 ? uu.pm * 4 + 1 : (uu.pm + 1) * 4 + 0)) * NUP + pc;
                        const f32x4 a0 = *(const f32x4*)r0, a1 = *(const f32x4*)r1, a2 = *(const f32x4*)r2, b0 = *(const f32x4*)(r0 + 128), b1 = *(const f32x4*)(r1 + 128), b2 = *(const f32x4*)(r2 + 128);
                        const f32x4 wg0 = *(const f32x4*)(cw + c4), wg1 = *(const f32x4*)(cw + NUP + c4), wg2 = *(const f32x4*)(cw + 2 * NUP + c4), cg = *(const f32x4*)(cb + c4);
                        const f32x4 wv0 = *(const f32x4*)(cw + DFF + c4), wv1 = *(const f32x4*)(cw + NUP + DFF + c4), wv2 = *(const f32x4*)(cw + 2 * NUP + DFF + c4), cv = *(const f32x4*)(cb + DFF + c4);
                        const f32x4 gg = a0 * wg0 + a1 * wg1 + a2 * wg2 + cg, vv = b0 * wv0 + b1 * wv1 + b2 * wv2 + cv;
                        hq[k].x = pk2(silu_f(gg[0]) * vv[0], silu_f(gg[1]) * vv[1]); hq[k].y = pk2(silu_f(gg[2]) * vv[2], silu_f(gg[3]) * vv[3]);
                        hoff[k] = (size_t)(uu.pm * 256 + (which ? 255 : 0)) * DFF + c4; }
#pragma unroll
                    for (int k = 0; k < 3; ++k) if (doit[k]) *(GAS u32x2v*)(Hb + hoff[k]) = hq[k]; }
                  VM_WAIT(); __syncthreads(); }
                pg8::EpiResid E{X16, XG, TAB + T_MOD + (size_t)l * 3 * 6144 + 5120, 6144, l + 1 < DEPTH ? TAB + T_GA + (size_t)(l + 1) * 3 * 1024 : nullptr, rowss, (LAS float*)(L + RSTD_OFF)};
                pg8::gemm_phase<pg8::EpiResid, pg8::XcdOrder, true, true, true>(L + RING_OFF, g, S, E, wave0);
        } PHASE_END
    }
    PHASE_BEGIN(PH_FINAL, 1) if (PH_EN(11)) { XCD_IDS;
            { const int nrow = 2 * pn16 * 256, st = nloc * NWAVES; f32x4 w4[4];
#pragma unroll
              for (int jj = 0; jj < 4; ++jj) w4[jj] = *(const f32x4*)(args.in[I_FNORM] + 256 * jj + 4 * lane);
              for (int rb = rk * NWAVES + wave; rb < nrow; rb += 4 * st) { float sv[4]; u32x2v xb[4][4]; int mr[4];
#pragma unroll
                for (int r = 0; r < 4; ++r) { const int ri = (rb + r * st < nrow) ? rb + r * st : rb; const int m = XCD_ROW(ri); mr[r] = m; sv[r] = lane < NPART ? rowss[(size_t)m * NPART + lane] : 0.f;
#pragma unroll
                    for (int jj = 0; jj < 4; ++jj) xb[r][jj] = *(const GAS u32x2v*)(X16 + (size_t)m * DM + 256 * jj + 4 * lane); }
#pragma unroll
                for (int r = 0; r < 4; ++r) { if (r > 0 && rb + r * st >= nrow) break; const float rs = __builtin_amdgcn_rsqf(wave_sum(sv[r]) * (1.0f / DM) + NORM_EPS);
#pragma unroll
                    for (int jj = 0; jj < 4; ++jj) { const f32x4 x = (f32x4){bf_lo(xb[r][jj].x), bf_hi(xb[r][jj].x), bf_lo(xb[r][jj].y), bf_hi(xb[r][jj].y)};
                        *(GAS f32x4*)(args.out + OUT_Y + (size_t)mr[r] * DM + 256 * jj + 4 * lane) = x * rs * w4[jj]; } } } }
    } PHASE_END
#undef PHASE_BEGIN
#undef PHASE_END
}
#ifndef MK_MULTI
#define MK_MULTI 0
#endif
extern "C" void kernel_launch(void* const* d_in, const int* in_sizes, int n_in, void* d_out, int out_size, void* d_ws, size_t ws_size, hipStream_t stream) {
    static int grid = 0;
    if (grid == 0) {
        if (n_in != N_IN || out_size != (int)OUT_TOTAL || ws_size < WS_END) { fprintf(stderr, "kernel_launch: unexpected problem: n_in %d out %d ws %zu (need %zu)\n", n_in, out_size, ws_size, (size_t)WS_END); grid = -1; return; }
        int dev = 0, cus = 0, per_cu = 0;
        if (hipGetDevice(&dev) != hipSuccess || hipDeviceGetAttribute(&cus, hipDeviceAttributeMultiprocessorCount, dev) != hipSuccess) { grid = -1; return; }
        if (hipFuncSetAttribute((const void*)skel_fwd, hipFuncAttributeMaxDynamicSharedMemorySize, LDS_BYTES) != hipSuccess) { fprintf(stderr, "kernel_launch: hipFuncSetAttribute failed\n"); grid = -1; return; }
        if (hipOccupancyMaxActiveBlocksPerMultiprocessor(&per_cu, (const void*)skel_fwd, NWAVES * 64, LDS_BYTES) != hipSuccess || per_cu < 1) { fprintf(stderr, "kernel_launch: occupancy query says %d\n", per_cu); per_cu = 1; }
        (void)hipGetLastError();
        grid = cus;
        if (grid % 8 != 0) grid -= grid % 8;
    }
    if (grid < 0) return;
    (void)hipMemsetAsync((char*)d_ws + WS_CTL, 0, CTL_ZERO_BYTES, stream);
    Args a{};
    for (int i = 0; i < N_IN; ++i) a.in[i] = (const float*)d_in[i];
    a.out = (float*)d_out; a.ws = (unsigned char*)d_ws;
#if MK_MULTI
    for (int ph = 0; ph < N_PHASES; ++ph) {
        if (ph >= PH_LAYER0 && ph < PH_FINAL) { const int l_ = (ph - PH_LAYER0) / PH_PER_LAYER, sub_ = (ph - PH_LAYER0) % PH_PER_LAYER; if (sub_ == 5 || sub_ == 2) continue; }
        a.ph_lo = ph; a.ph_hi = ph + 1;
        int nrep = 1;
        for (int rep = 0; rep < nrep; ++rep)
        hipLaunchKernelGGL(skel_fwd, dim3(grid), dim3(NWAVES * 64), LDS_BYTES, stream, a);
    }
#else
    a.ph_lo = 0; a.ph_hi = N_PHASES;
    hipLaunchKernelGGL(skel_fwd, dim3(grid), dim3(NWAVES * 64), LDS_BYTES, stream, a);
#endif
    const hipError_t le = hipPeekAtLastError();
    if (le != hipSuccess) fprintf(stderr, "kernel_launch: launch failed: %s\n", hipGetErrorName(le));
}
```
